# Optimizing an MI355X kernel written in HIP

```python
import math
import jax
import jax.numpy as jnp
from jax import lax
import numpy as np

D_MODEL = 1024
BATCH = 8
SEQ = 4096
DEPTH = 2

HEAD_DIM = 64
M_HEADS = 4
M_WIDTH = M_HEADS * HEAD_DIM
M_CONV = 4
M_CHUNK = 64
M_NORM_EPS = 1e-6
R_HEADS = 4
R_WIDTH = R_HEADS * HEAD_DIM
R_DECAY_LORA = 32
R_AAA_LORA = 32
R_GATE_LORA = 64
R_LN_EPS = 64e-5
A_HEADS = 4
A_QK_DIM = HEAD_DIM
A_V_DIM = 2 * HEAD_DIM
A_WIDTH = A_HEADS * A_V_DIM
A_BLOCK = 128
A_NORM_EPS = 1e-5

MIX_WIDTH = M_WIDTH + R_WIDTH + A_WIDTH
D_FF = 4 * D_MODEL
NORM_EPS = 1e-6

M_SEGS = (M_WIDTH, M_WIDTH, M_WIDTH, M_WIDTH, M_HEADS, M_HEADS)
R_SEGS = (R_WIDTH, R_WIDTH, R_WIDTH, R_DECAY_LORA, R_AAA_LORA, R_GATE_LORA)
A_SEGS = (A_HEADS * 2 * A_QK_DIM, A_HEADS * 2 * A_QK_DIM, A_WIDTH)
M_PROJ = sum(M_SEGS)
R_PROJ = sum(R_SEGS)
A_PROJ = sum(A_SEGS)
IN_PROJ = M_PROJ + R_PROJ + A_PROJ

kernel_name = 'hybrid_mlstm_rwkv7_diffattn'


def _split(t, sizes):
    idx = [int(i) for i in np.cumsum(sizes)[:-1]]
    return jnp.split(t, idx, axis=-1)


def _rms_norm(x, g, eps=NORM_EPS):
    xf = x.astype(jnp.float32)
    y = xf * lax.rsqrt(jnp.mean(jnp.square(xf), axis=-1, keepdims=True) + eps)
    return (y * g.astype(jnp.float32)).astype(x.dtype)


def _head_rms(h, g, eps):
    return h * lax.rsqrt(jnp.mean(jnp.square(h), axis=-1, keepdims=True) + eps) * g.astype(jnp.float32)


def _causal_dwconv(x, w, b):
    k = w.shape[0]
    y = lax.conv_general_dilated(x, w[:, None, :], window_strides=(1,), padding=[(k - 1, 0)],
                                 dimension_numbers=('NWC', 'WIO', 'NWC'),
                                 feature_group_count=x.shape[-1])
    return y + b


def _mlstm(q, k, v, o_pre, i_pre, f_pre, conv_w, conv_b, b_i, b_f, norm_g):
    B, S = q.shape[:2]
    qk = jax.nn.silu(_causal_dwconv(jnp.concatenate([q, k], axis=-1), conv_w, conv_b))
    q, k = jnp.split(qk.astype(jnp.float32), 2, axis=-1)

    def heads(t):
        return t.reshape(B, S, M_HEADS, HEAD_DIM).transpose(0, 2, 1, 3)

    q = heads(q)
    k = heads(k) * (HEAD_DIM ** -0.5)
    v = heads(v.astype(jnp.float32))
    ig = (i_pre.astype(jnp.float32) + b_i.astype(jnp.float32)).transpose(0, 2, 1)
    lf = jax.nn.log_sigmoid(f_pre.astype(jnp.float32) + b_f.astype(jnp.float32)).transpose(0, 2, 1)
    nc = S // M_CHUNK

    def chunks(t):
        t = t.reshape(B, M_HEADS, nc, M_CHUNK, *t.shape[3:])
        return jnp.moveaxis(t, 2, 0)

    tril = jnp.tril(jnp.ones((M_CHUNK, M_CHUNK), dtype=bool))

    def step(carry, xs):
        C, n, m = carry
        qc, kc, vc, igc, lfc = xs
        b = jnp.cumsum(lfc, axis=-1)
        D = jnp.where(tril, b[..., :, None] - b[..., None, :] + igc[..., None, :], -jnp.inf)
        inter = b + m[..., None]
        mt = jnp.maximum(inter, jnp.max(D, axis=-1))
        Dw = jnp.exp(D - mt[..., None])
        iw = jnp.exp(inter - mt)
        sqk = jnp.einsum('bhtd,bhsd->bhts', qc, kc) * Dw
        num = iw[..., None] * jnp.einsum('bhtd,bhde->bhte', qc, C) + jnp.einsum('bhts,bhse->bhte', sqk, vc)
        den = iw * jnp.einsum('bhtd,bhd->bht', qc, n) + jnp.sum(sqk, axis=-1)
        h = num / jnp.maximum(jnp.abs(den), jnp.exp(-mt))[..., None]
        bl = b[..., -1]
        g_end = bl[..., None] - b + igc
        m_new = jnp.maximum(bl + m, jnp.max(g_end, axis=-1))
        wk = jnp.exp(g_end - m_new[..., None])
        cs = jnp.exp(bl + m - m_new)
        C = cs[..., None, None] * C + jnp.einsum('bhs,bhsd,bhse->bhde', wk, kc, vc)
        n = cs[..., None] * n + jnp.einsum('bhs,bhsd->bhd', wk, kc)
        return (C, n, m_new), h

    init = (jnp.zeros((B, M_HEADS, HEAD_DIM, HEAD_DIM), jnp.float32),
            jnp.zeros((B, M_HEADS, HEAD_DIM), jnp.float32),
            jnp.zeros((B, M_HEADS), jnp.float32))
    _, h = lax.scan(step, init, (chunks(q), chunks(k), chunks(v), chunks(ig), chunks(lf)))
    h = jnp.moveaxis(h, 0, 2).reshape(B, M_HEADS, S, HEAD_DIM).transpose(0, 2, 1, 3)
    h = _head_rms(h, norm_g.reshape(M_HEADS, HEAD_DIM), M_NORM_EPS)
    return h.reshape(B, S, M_WIDTH) * jax.nn.sigmoid(o_pre.astype(jnp.float32))


def _rwkv7(p, mu, w0, w_up, a0, a_up, g_up, k_k, k_a, r_k, ln_g, ln_b):
    B, S = p.shape[:2]
    p = p.astype(jnp.float32)
    p_prev = jnp.pad(p, ((0, 0), (1, 0), (0, 0)))[:, :-1]
    p = p + (p_prev - p) * mu.astype(jnp.float32)
    r, k, v, wd, ad, gd = _split(p, R_SEGS)
    w_log = -jax.nn.softplus(-(w0 + jnp.tanh(wd) @ w_up.astype(jnp.float32))) - 0.5
    decay = jnp.exp(-jnp.exp(w_log))
    a = jax.nn.sigmoid(a0 + ad @ a_up.astype(jnp.float32))
    g = jax.nn.sigmoid(gd) @ g_up.astype(jnp.float32)

    def heads(t):
        return t.reshape(B, S, R_HEADS, HEAD_DIM)

    kk = heads(k * k_k)
    kk = kk / jnp.maximum(jnp.sqrt(jnp.sum(jnp.square(kk), axis=-1, keepdims=True)), 1e-12)
    k = k * (1.0 + (a - 1.0) * k_a)
    r, k, v, decay, a = heads(r), heads(k), heads(v), heads(decay), heads(a)

    def step(st, xs):
        rt, wt, kt, vt, kkt, at = xs
        sa = jnp.einsum('bhij,bhj->bhi', st, -kkt)
        st = (st * wt[:, :, None, :] + sa[..., :, None] * (kkt * at)[:, :, None, :]
              + vt[..., :, None] * kt[:, :, None, :])
        return st, jnp.einsum('bhij,bhj->bhi', st, rt)

    xs = tuple(jnp.moveaxis(t, 1, 0) for t in (r, decay, k, v, kk, a))
    _, y = lax.scan(step, jnp.zeros((B, R_HEADS, HEAD_DIM, HEAD_DIM), jnp.float32), xs)
    y = jnp.moveaxis(y, 0, 1)
    mean = jnp.mean(y, axis=-1, keepdims=True)
    var = jnp.mean(jnp.square(y - mean), axis=-1, keepdims=True)
    y = ((y - mean) * lax.rsqrt(var + R_LN_EPS) * ln_g.reshape(R_HEADS, HEAD_DIM)
         + ln_b.reshape(R_HEADS, HEAD_DIM))
    y = y + jnp.sum(r * k * r_k, axis=-1, keepdims=True) * v
    return y.reshape(B, S, R_WIDTH) * g


def _diff_attn(q, k, v, lq1, lk1, lq2, lk2, norm_g, lam_init):
    B, S = q.shape[:2]
    nb = S // A_BLOCK
    q = q.astype(jnp.float32).reshape(B, S, A_HEADS, 2, A_QK_DIM).transpose(0, 2, 3, 1, 4)
    k = k.astype(jnp.float32).reshape(B, S, A_HEADS, 2, A_QK_DIM).transpose(0, 2, 3, 1, 4)
    v = v.astype(jnp.float32).reshape(B, S, A_HEADS, A_V_DIM).transpose(0, 2, 1, 3)
    f32 = jnp.float32
    lam = (jnp.exp(jnp.sum(lq1.astype(f32) * lk1.astype(f32)))
           - jnp.exp(jnp.sum(lq2.astype(f32) * lk2.astype(f32))) + lam_init)
    q_blocks = jnp.moveaxis(q.reshape(B, A_HEADS, 2, nb, A_BLOCK, A_QK_DIM), 3, 0)
    key_pos = jnp.arange(S)
    scale = A_QK_DIM ** -0.5

    def block(args):
        qb, bi = args
        s = jnp.einsum('bhcqd,bhckd->bhcqk', qb, k) * scale
        q_pos = bi * A_BLOCK + jnp.arange(A_BLOCK)
        mask = key_pos[None, :] <= q_pos[:, None]
        pr = jax.nn.softmax(jnp.where(mask, s, -jnp.inf), axis=-1)
        attn = pr[:, :, 0] - lam * pr[:, :, 1]
        return jnp.einsum('bhqk,bhke->bhqe', attn, v)

    o = lax.map(block, (q_blocks, jnp.arange(nb)))
    o = jnp.moveaxis(o, 0, 2).reshape(B, A_HEADS, S, A_V_DIM).transpose(0, 2, 1, 3)
    o = _head_rms(o, norm_g.reshape(A_HEADS, A_V_DIM), A_NORM_EPS) * (1.0 - lam_init)
    return o.reshape(B, S, A_WIDTH)


def setup_inputs(seed: int = 0) -> dict:
    key = jax.random.key(seed)
    ks = list(jax.random.split(key, 32))
    L = DEPTH

    def nrm(i, shape, s):
        return jax.random.normal(ks[i], shape, jnp.float32) * s

    def uni(i, shape, lo, hi):
        return jax.random.uniform(ks[i], shape, jnp.float32, lo, hi)

    return {
        'x': nrm(0, (BATCH, SEQ, D_MODEL), 1.0),
        'norm1_g': 1.0 + nrm(1, (L, D_MODEL), 0.02),
        'w_in': nrm(2, (L, D_MODEL, IN_PROJ), D_MODEL ** -0.5),
        'm_conv_w': nrm(3, (L, M_CONV, 2 * M_WIDTH), M_CONV ** -0.5),
        'm_conv_b': nrm(4, (L, 2 * M_WIDTH), 0.02),
        'm_b_i': nrm(5, (L, M_HEADS), 0.1),
        'm_b_f': uni(6, (L, M_HEADS), 3.0, 6.0),
        'm_norm_g': 1.0 + nrm(7, (L, M_WIDTH), 0.02),
        'r_mu': uni(8, (L, R_PROJ), 0.0, 1.0),
        'r_w0': uni(9, (L, R_WIDTH), -6.0, -1.0),
        'r_w_up': nrm(10, (L, R_DECAY_LORA, R_WIDTH), R_DECAY_LORA ** -0.5),
        'r_a0': nrm(11, (L, R_WIDTH), 0.1),
        'r_a_up': nrm(12, (L, R_AAA_LORA, R_WIDTH), R_AAA_LORA ** -0.5),
        'r_g_up': nrm(13, (L, R_GATE_LORA, R_WIDTH), R_GATE_LORA ** -0.5),
        'r_k_k': 0.85 + nrm(14, (L, R_WIDTH), 0.02),
        'r_k_a': 1.0 + nrm(15, (L, R_WIDTH), 0.02),
        'r_r_k': nrm(16, (L, R_HEADS, HEAD_DIM), 0.1),
        'r_ln_g': 1.0 + nrm(17, (L, R_WIDTH), 0.02),
        'r_ln_b': nrm(18, (L, R_WIDTH), 0.02),
        'a_lq1': nrm(19, (L, A_QK_DIM), 0.1),
        'a_lk1': nrm(20, (L, A_QK_DIM), 0.1),
        'a_lq2': nrm(21, (L, A_QK_DIM), 0.1),
        'a_lk2': nrm(22, (L, A_QK_DIM), 0.1),
        'a_norm_g': 1.0 + nrm(23, (L, A_WIDTH), 0.02),
        'w_out': nrm(24, (L, MIX_WIDTH, D_MODEL), MIX_WIDTH ** -0.5),
        'norm2_g': 1.0 + nrm(25, (L, D_MODEL), 0.02),
        'w_ff_up': nrm(26, (L, D_MODEL, D_FF), D_MODEL ** -0.5),
        'w_ff_down': nrm(27, (L, D_FF, D_MODEL), D_FF ** -0.5),
        'final_g': 1.0 + nrm(28, (D_MODEL,), 0.02),
    }


def reference(x, norm1_g, w_in, m_conv_w, m_conv_b, m_b_i, m_b_f, m_norm_g,
              r_mu, r_w0, r_w_up, r_a0, r_a_up, r_g_up, r_k_k, r_k_a, r_r_k, r_ln_g, r_ln_b,
              a_lq1, a_lk1, a_lq2, a_lk2, a_norm_g, w_out, norm2_g, w_ff_up, w_ff_down, final_g):
    for l in range(DEPTH):
        h = _rms_norm(x, norm1_g[l])
        proj = h @ w_in[l]
        pm, pr, pa = _split(proj, (M_PROJ, R_PROJ, A_PROJ))
        mq, mk, mv, mo, mi, mf = _split(pm, M_SEGS)
        y_m = _mlstm(mq, mk, mv, mo, mi, mf, m_conv_w[l], m_conv_b[l], m_b_i[l], m_b_f[l], m_norm_g[l])
        y_r = _rwkv7(pr, r_mu[l], r_w0[l], r_w_up[l], r_a0[l], r_a_up[l], r_g_up[l],
                     r_k_k[l], r_k_a[l], r_r_k[l], r_ln_g[l], r_ln_b[l])
        aq, ak, av = _split(pa, A_SEGS)
        lam_init = 0.8 - 0.6 * math.exp(-0.3 * l)
        y_a = _diff_attn(aq, ak, av, a_lq1[l], a_lk1[l], a_lq2[l], a_lk2[l], a_norm_g[l], lam_init)
        mix = jnp.concatenate([y_m, y_r, y_a], axis=-1).astype(x.dtype)
        x = x + mix @ w_out[l]
        h = _rms_norm(x, norm2_g[l])
        x = x + jnp.square(jax.nn.relu(h @ w_ff_up[l])) @ w_ff_down[l]
    return _rms_norm(x, final_g)
```

```cpp
#include <hip/hip_runtime.h>
#include <hip/hip_cooperative_groups.h>
#include <cstdio>
#include <cstdint>
#include <cmath>
namespace pg8 {
#define PG8_LAS __attribute__((address_space(3)))
typedef unsigned short bf16_t;
typedef short bf16x8 __attribute__((ext_vector_type(8)));
typedef float f32x4 __attribute__((ext_vector_type(4)));
typedef unsigned u32x4 __attribute__((ext_vector_type(4)));
constexpr int BM = 256, BK = 64, HALF = 128, HTB = HALF * BK * 2  , STAGE_BYTES = 8 * HTB, NXCD = 8, WGM = 8;

__host__ __device__ __forceinline__ int lds_byte(int r, int c) { const int st = (r >> 4) * 2 + (c >> 5), rr = r & 15, cc = c & 31, ob = rr * 64 + cc * 2; return st * 1024 + (ob ^ (((ob >> 9) & 1) << 5)); }
__host__ __device__ __forceinline__ void stage_rc(int b, int& R, int& C) { const int st = b / 1024, sb = b % 1024, swz = sb ^ (((sb >> 9) & 1) << 5); R = (st >> 1) * 16 + swz / 64; C = (st & 1) * 32 + (swz % 64) / 2; }
__host__ __device__ __forceinline__ int perm32(int rho) { const int n = rho >> 4, i = rho & 15; return 8 * (i >> 2) + 4 * n + (i & 3); }

struct Unit { int pm, pn; };
struct Gemm { const bf16_t* A; const bf16_t* Bt; int M, N, K, pad; };

struct StaticOrder {
    int nM, nN, nwg, G, c;
    __host__ __device__ void init(int M, int N, int G_, int c_) { nM = M / BM; nN = N / BM; nwg = nM * nN; G = G_; c = c_; }
    __host__ __device__ bool next(int i, Unit& u) const {
        const long L = (long)i * G + c; if (L >= nwg) return false;
        int wgid = (int)L; { const int q = nwg / NXCD, r = nwg % NXCD, xcd = wgid % NXCD, off = wgid / NXCD; wgid = (xcd < r ? xcd * (q + 1) : r * (q + 1) + (xcd - r) * q) + off; }
        const int nig = WGM * nN, gid = wgid / nig, fm = gid * WGM, gsz = (nM - fm) < WGM ? (nM - fm) : WGM;
        u.pm = fm + ((wgid % nig) % gsz); u.pn = (wgid % nig) / gsz; return true;
    }
    __device__ __forceinline__ void a_ready(const Unit&) const {}
    __device__ __forceinline__ void done(const Unit&) const {}
};

__device__ __forceinline__ unsigned cvt_pk_bf16(float lo, float hi) { unsigned r; asm volatile("v_cvt_pk_bf16_f32 %0, %1, %2" : "=v"(r) : "v"(lo), "v"(hi)); return r; }
typedef float f32x2 __attribute__((ext_vector_type(2)));
template <int ACT> struct EpiBf16S {
    static constexpr bool PERM = true, AFTER_DRAIN = false;
    bf16_t* O; const float* rowscale; int ldc; int pad;
    __device__ __forceinline__ void operator()(const f32x4 (&acc)[2][2][4][2], const Unit& u, int wr, int wc, int fr, int fq) const {
        const int row0 = u.pm * BM + wr * 64 + fr; const int col0 = u.pn * BM + wc * 32 + 8 * fq;
#pragma unroll
        for (int ai = 0; ai < 2; ++ai)
#pragma unroll
            for (int m = 0; m < 4; ++m) { const int row = row0 + ai * HALF + m * 16; const float rs = rowscale ? rowscale[row] : 1.f; bf16_t* rowp = O + (size_t)row * ldc + col0;
#pragma unroll
                for (int bj = 0; bj < 2; ++bj) { f32x4 v0 = acc[ai][bj][m][0] * rs, v1 = acc[ai][bj][m][1] * rs;
                    if (ACT == 2) {
#pragma unroll
                        for (int e = 0; e < 4; ++e) { float a = fmaxf(v0[e], 0.f), b = fmaxf(v1[e], 0.f); v0[e] = a * a; v1[e] = b * b; } }
                    u32x4 w; w.x = cvt_pk_bf16(v0[0], v0[1]); w.y = cvt_pk_bf16(v0[2], v0[3]); w.z = cvt_pk_bf16(v1[0], v1[1]); w.w = cvt_pk_bf16(v1[2], v1[3]);
                    *(u32x4*)(rowp + bj * HALF) = w; } }
    }
};
struct EpiResF32 {
    static constexpr bool PERM = false, AFTER_DRAIN = false;
    const float* base; float* out; int ldc; int pad;
    __device__ __forceinline__ void operator()(const f32x4 (&acc)[2][2][4][2], const Unit& u, int wr, int wc, int fr, int fq) const {
        const int row0 = u.pm * BM + wr * 64 + fr; const int col0 = u.pn * BM + wc * 32 + 4 * fq;
#pragma unroll
        for (int ai = 0; ai < 2; ++ai)
#pragma unroll
            for (int m = 0; m < 4; ++m) { const size_t off = (size_t)(row0 + ai * HALF + m * 16) * ldc + col0;
#pragma unroll
                for (int bj = 0; bj < 2; ++bj)
#pragma unroll
                    for (int n = 0; n < 2; ++n) { const size_t o = off + bj * HALF + n * 16; *(f32x4*)(out + o) = *(const f32x4*)(base + o) + acc[ai][bj][m][n]; } }
    }
};
template <class Epi, class Sched, bool ALIGN_EPI = false, bool SP2 = false>
__device__ __forceinline__ void gemm_phase(PG8_LAS unsigned char* lds, const Gemm g, const Sched& S, const Epi& E) {
    const int tid = threadIdx.x, wid = __builtin_amdgcn_readfirstlane(tid >> 6), lane = tid & 63, wr = wid >> 2, wc = wid & 3, fr = lane & 15, fq = lane >> 4;
    const int K = g.K, nt = K / BK;
    unsigned voffA[2], voffB[2];
#pragma unroll
    for (int i = 0; i < 2; ++i) { int R, C; stage_rc(tid * 16 + i * 8192, R, C); const int Rb = Epi::PERM ? ((R & ~31) + perm32(R & 31)) : R;
        voffA[i] = (unsigned)(R * K + C) * 2u; voffB[i] = (unsigned)(Rb * K + C) * 2u; }
    const size_t kstep = (size_t)(BK * 2);
    const size_t hstep = (size_t)HALF * K * 2;
    const size_t tstep = 2 * hstep;
    const unsigned ldsw = (unsigned)wid * 1024u;
    const int aoff = lds_byte(wr * 64 + fr, fq * 8), boff = lds_byte(wc * 32 + fr, fq * 8);
#define PG8_SA(b, h) (((b) * 2 + (h)) * HTB)
#define PG8_SB(b, h) ((4 + (b) * 2 + (h)) * HTB)
#define PG8_STAGE(bufoff, gbase, voff) do { _Pragma("unroll") for (int _i = 0; _i < 2; ++_i) \
        __builtin_amdgcn_global_load_lds((const unsigned*)((const char*)(gbase) + (voff)[_i]), (PG8_LAS unsigned*)(lds + (bufoff) + ldsw + _i * 8192), 16, 0, 0); } while (0)
#define PG8_LDA(dst, b, h) do { _Pragma("unroll") for (int m = 0; m < 4; ++m) _Pragma("unroll") for (int k = 0; k < 2; ++k) dst[m][k] = *(const PG8_LAS bf16x8*)(lds + PG8_SA(b, h) + aoff + m * 2048 + k * 1024); } while (0)
#define PG8_LDB(dst, b, h) do { _Pragma("unroll") for (int n = 0; n < 2; ++n) _Pragma("unroll") for (int k = 0; k < 2; ++k) dst[n][k] = *(const PG8_LAS bf16x8*)(lds + PG8_SB(b, h) + boff + n * 2048 + k * 1024); } while (0)
#define PG8_MMA(ai, bj, At, Bt) do { __builtin_amdgcn_s_setprio(1); _Pragma("unroll") for (int m = 0; m < 4; ++m) _Pragma("unroll") for (int n = 0; n < 2; ++n) _Pragma("unroll") for (int k = 0; k < 2; ++k) \
        acc[ai][bj][m][n] = __builtin_amdgcn_mfma_f32_16x16x32_bf16(Bt[n][k], At[m][k], acc[ai][bj][m][n], 0, 0, 0); __builtin_amdgcn_s_setprio(0); } while (0)
#define PG8_WAIT_V(n) asm volatile("s_waitcnt vmcnt(" #n ")" ::: "memory")
#define PG8_WAIT_L(n) asm volatile("s_waitcnt lgkmcnt(" #n ")" ::: "memory")
#define PG8_BAR __builtin_amdgcn_s_barrier()
#define PG8_SCHED __builtin_amdgcn_sched_barrier(0)
    Unit cur, nxt; int ui = 0;
    if (!S.next(0, cur)) return;
    f32x4 acc[2][2][4][2];
#pragma unroll
    for (int a = 0; a < 2; ++a)
#pragma unroll
        for (int b = 0; b < 2; ++b)
#pragma unroll
            for (int m = 0; m < 4; ++m)
#pragma unroll
                for (int n = 0; n < 2; ++n) acc[a][b][m][n] = (f32x4){0.f, 0.f, 0.f, 0.f};
    bf16x8 At[4][2], B0[2][2], B1[2][2];
    const char* cA = (const char*)g.A + (size_t)cur.pm * tstep; const char* cB = (const char*)g.Bt + (size_t)cur.pn * tstep;
    S.a_ready(cur);
    if constexpr (SP2) {
        PG8_STAGE(PG8_SB(0, 0), cB, voffB); PG8_STAGE(PG8_SB(0, 1), cB + hstep, voffB); PG8_STAGE(PG8_SA(0, 0), cA, voffA); PG8_STAGE(PG8_SA(0, 1), cA + hstep, voffA);
        if (wr == 1) PG8_BAR;
        PG8_WAIT_V(2); PG8_BAR;
        PG8_STAGE(PG8_SB(1, 0), cB + kstep, voffB); PG8_STAGE(PG8_SA(1, 0), cA + kstep, voffA); PG8_STAGE(PG8_SB(1, 1), cB + hstep + kstep, voffB);
        PG8_WAIT_V(6); PG8_BAR;
    } else {
        PG8_STAGE(PG8_SB(0, 0), cB, voffB); PG8_STAGE(PG8_SA(0, 0), cA, voffA); PG8_STAGE(PG8_SB(0, 1), cB + hstep, voffB); PG8_STAGE(PG8_SA(0, 1), cA + hstep, voffA);
        if (wr == 1) PG8_BAR;
        PG8_WAIT_V(4); PG8_BAR;
        PG8_STAGE(PG8_SB(1, 0), cB + kstep, voffB); PG8_STAGE(PG8_SA(1, 0), cA + kstep, voffA); PG8_STAGE(PG8_SB(1, 1), cB + hstep + kstep, voffB);
        PG8_WAIT_V(6); PG8_BAR;
    }
    for (;;) {
        const bool has_next = S.next(ui + 1, nxt);
        const char* nA = has_next ? (const char*)g.A + (size_t)nxt.pm * tstep : cA; const char* nB = has_next ? (const char*)g.Bt + (size_t)nxt.pn * tstep : cB;
        for (int t = 0; t < nt; t += 2) {
            const bool last = (t == nt - 2);
            const char* a1 = cA + (size_t)(t + 1) * kstep;
            const char* a2 = last ? nA : cA + (size_t)(t + 2) * kstep; const char* b2 = last ? nB : cB + (size_t)(t + 2) * kstep;
            const char* a3 = a2 + kstep; const char* b3 = b2 + kstep;
            if (last && has_next) S.a_ready(nxt);
            if constexpr (SP2) {
            PG8_LDB(B0, 0, 0); PG8_LDB(B1, 0, 1); PG8_SCHED; PG8_LDA(At, 0, 0); PG8_STAGE(PG8_SA(1, 1), a1 + hstep, voffA);
            PG8_WAIT_V(8); PG8_WAIT_L(0); PG8_BAR; PG8_MMA(0, 0, At, B0); PG8_MMA(0, 1, At, B1); PG8_BAR; PG8_SCHED;
            PG8_LDA(At, 0, 1); PG8_STAGE(PG8_SB(0, 0), b2, voffB); PG8_STAGE(PG8_SB(0, 1), b2 + hstep, voffB); PG8_STAGE(PG8_SA(0, 0), a2, voffA);
            PG8_WAIT_V(8); PG8_WAIT_L(0); PG8_BAR; PG8_MMA(1, 0, At, B0); PG8_MMA(1, 1, At, B1); PG8_BAR; PG8_SCHED;
            PG8_LDB(B0, 1, 0); PG8_LDB(B1, 1, 1); PG8_SCHED; PG8_LDA(At, 1, 0); PG8_STAGE(PG8_SA(0, 1), a2 + hstep, voffA);
            PG8_WAIT_V(8); PG8_WAIT_L(0); PG8_BAR; PG8_MMA(0, 0, At, B0); PG8_MMA(0, 1, At, B1); PG8_BAR; PG8_SCHED;
            PG8_LDA(At, 1, 1); PG8_STAGE(PG8_SB(1, 0), b3, voffB); PG8_STAGE(PG8_SB(1, 1), b3 + hstep, voffB); PG8_STAGE(PG8_SA(1, 0), a3, voffA);
            PG8_WAIT_V(8); PG8_WAIT_L(0); PG8_BAR; PG8_MMA(1, 0, At, B0); PG8_MMA(1, 1, At, B1); PG8_BAR; PG8_SCHED;
            } else {
            PG8_LDB(B0, 0, 0); PG8_SCHED; PG8_LDA(At, 0, 0); PG8_STAGE(PG8_SA(1, 1), a1 + hstep, voffA);
            PG8_WAIT_L(8); PG8_BAR; PG8_WAIT_L(0); PG8_MMA(0, 0, At, B0); PG8_BAR; PG8_SCHED;
            PG8_LDB(B1, 0, 1); PG8_STAGE(PG8_SB(0, 0), b2, voffB);
            PG8_BAR; PG8_WAIT_L(0); PG8_MMA(0, 1, At, B1); PG8_BAR;
            PG8_LDA(At, 0, 1); PG8_STAGE(PG8_SA(0, 0), a2, voffA);
            PG8_BAR; PG8_WAIT_L(0); PG8_MMA(1, 0, At, B0); PG8_BAR; PG8_SCHED;
            PG8_STAGE(PG8_SB(0, 1), b2 + hstep, voffB);
            PG8_WAIT_V(6); PG8_BAR; PG8_MMA(1, 1, At, B1); PG8_BAR;
            PG8_LDB(B0, 1, 0); PG8_SCHED; PG8_LDA(At, 1, 0); PG8_STAGE(PG8_SA(0, 1), a2 + hstep, voffA);
            PG8_WAIT_L(8); PG8_BAR; PG8_WAIT_L(0); PG8_MMA(0, 0, At, B0); PG8_BAR; PG8_SCHED;
            PG8_LDB(B1, 1, 1); PG8_STAGE(PG8_SB(1, 0), b3, voffB);
            PG8_BAR; PG8_WAIT_L(0); PG8_MMA(0, 1, At, B1); PG8_BAR;
            PG8_LDA(At, 1, 1); PG8_STAGE(PG8_SA(1, 0), a3, voffA);
            PG8_BAR; PG8_WAIT_L(0); PG8_MMA(1, 0, At, B0); PG8_BAR; PG8_SCHED;
            PG8_STAGE(PG8_SB(1, 1), b3 + hstep, voffB);
            PG8_WAIT_V(6); PG8_BAR; PG8_MMA(1, 1, At, B1); PG8_BAR;
            }
        }
        if constexpr (ALIGN_EPI) { if (wr == 0) PG8_BAR; }
        if constexpr (!Epi::AFTER_DRAIN) { E(acc, cur, wr, wc, fr, fq); S.done(cur); }
        if (!has_next) break;
#pragma unroll
        for (int a = 0; a < 2; ++a)
#pragma unroll
            for (int b = 0; b < 2; ++b)
#pragma unroll
                for (int m = 0; m < 4; ++m)
#pragma unroll
                    for (int n = 0; n < 2; ++n) acc[a][b][m][n] = (f32x4){0.f, 0.f, 0.f, 0.f};
        cur = nxt; cA = nA; cB = nB; ++ui;
        if constexpr (ALIGN_EPI) { if (wr == 1) PG8_BAR; }
    }
    PG8_WAIT_V(0);
    if constexpr (!ALIGN_EPI) { if (wr == 0) PG8_BAR; }
    PG8_BAR;
    if constexpr (Epi::AFTER_DRAIN) { E.fused(acc, cur, wr, wc, fr, fq, lds, wid, lane); S.done(cur); }
#undef PG8_SA
#undef PG8_SB
#undef PG8_STAGE
#undef PG8_LDA
#undef PG8_LDB
#undef PG8_MMA
#undef PG8_WAIT_V
#undef PG8_WAIT_L
#undef PG8_BAR
#undef PG8_SCHED
}
}
constexpr int BATCH = 8, SEQ = 4096, DM = 1024, DEPTH = 2, T = BATCH * SEQ, FF = 4096;
constexpr int NP = 3584;
constexpr int MQ = 0, MK = 256, MV = 512, MO = 768, MI = 1024, MF = 1028;
constexpr int R0 = 1032;
constexpr int AQ = 1928, AK = 2440, AV = 2952, NREAL = 3464;
constexpr float C2 = 0.125f * 1.4426950408889634f;
typedef unsigned short bf16;
typedef float f32x4 __attribute__((ext_vector_type(4)));
typedef short bf16x8 __attribute__((ext_vector_type(8)));
typedef unsigned u32x4 __attribute__((ext_vector_type(4)));

__device__ __forceinline__ float bf2f(bf16 v) { return __uint_as_float(((unsigned)v) << 16); }
__device__ __forceinline__ unsigned f2bf(float f) { unsigned u = __float_as_uint(f); return (u + 0x7fffu + ((u >> 16) & 1u)) >> 16; }
__device__ __forceinline__ float wave_sum(float v) {
#pragma unroll
    for (int o = 1; o < 64; o <<= 1) v += __shfl_xor(v, o);
    return v;
}
__device__ __forceinline__ float wave_max(float v) {
#pragma unroll
    for (int o = 1; o < 64; o <<= 1) v = fmaxf(v, __shfl_xor(v, o));
    return v;
}
__device__ __forceinline__ float sigmoidf_(float x) { return 1.f / (1.f + __expf(-x)); }
__device__ __forceinline__ float softplusf_(float x) { return fmaxf(x, 0.f) + log1pf(__expf(-fabsf(x))); }

constexpr size_t MiB = 1u << 20;
constexpr size_t WS_CTL = 0;
constexpr size_t WS_WIN = 1 * MiB;
constexpr size_t WS_WOUT = WS_WIN + 14 * MiB;
constexpr size_t WS_WUP = WS_WOUT + 4 * MiB;
constexpr size_t WS_WDN = WS_WUP + 16 * MiB;
constexpr size_t WS_XB = 51 * MiB;
constexpr size_t WS_PROJ = 115 * MiB;
constexpr size_t WS_SCR = 339 * MiB;
constexpr size_t WS_HID = 115 * MiB;
constexpr size_t WS_END = 451 * MiB;

__global__ void __launch_bounds__(256) k_wt(const float* __restrict__ W, int K, int N, int Npad, bf16* __restrict__ Bt, const float* __restrict__ gain, int slo, int shi, float sc) {
    __shared__ float tile[32][33];
    const int n0 = blockIdx.x * 32, k0 = blockIdx.y * 32, tx = threadIdx.x & 31, ty = threadIdx.x >> 5;
#pragma unroll
    for (int j = 0; j < 4; ++j) { const int k = k0 + ty + 8 * j, n = n0 + tx; float v = 0.f; if (n < N) { v = W[(size_t)k * N + n]; if (gain) v *= gain[k]; if (n >= slo && n < shi) v *= sc; } tile[ty + 8 * j][tx] = v; }
    __syncthreads();
#pragma unroll
    for (int j = 0; j < 4; ++j) { const int n = n0 + ty + 8 * j, k = k0 + tx; Bt[(size_t)n * K + k] = (bf16)f2bf(tile[tx][ty + 8 * j]); }
}
__global__ void __launch_bounds__(256) k_rmsnorm(const float* __restrict__ x, bf16* __restrict__ xb) {
    const int lane = threadIdx.x & 63, row = blockIdx.x * 4 + (threadIdx.x >> 6);
    const f32x4* xr = (const f32x4*)(x + (size_t)row * DM) + lane;
    f32x4 v[4]; float s = 0.f;
#pragma unroll
    for (int j = 0; j < 4; ++j) { v[j] = xr[64 * j]; s += (v[j].x * v[j].x + v[j].y * v[j].y) + (v[j].z * v[j].z + v[j].w * v[j].w); }
    const float rstd = rsqrtf(wave_sum(s) * (1.f / DM) + 1e-6f);
    unsigned long long* o8 = (unsigned long long*)(xb + (size_t)row * DM) + lane;
#pragma unroll
    for (int j = 0; j < 4; ++j) o8[64 * j] = (unsigned long long)(f2bf(v[j].x * rstd) | (f2bf(v[j].y * rstd) << 16)) | ((unsigned long long)(f2bf(v[j].z * rstd) | (f2bf(v[j].w * rstd) << 16)) << 32);
}
__global__ void __launch_bounds__(256) k_final_norm(float* __restrict__ x, const float* __restrict__ g) {
    const int lane = threadIdx.x & 63, row = blockIdx.x * 4 + (threadIdx.x >> 6);
    f32x4* xr = (f32x4*)(x + (size_t)row * DM) + lane; const f32x4* gr = (const f32x4*)g + lane;
    f32x4 v[4]; float s = 0.f;
#pragma unroll
    for (int j = 0; j < 4; ++j) { v[j] = xr[64 * j]; s += (v[j].x * v[j].x + v[j].y * v[j].y) + (v[j].z * v[j].z + v[j].w * v[j].w); }
    const float rstd = rsqrtf(wave_sum(s) * (1.f / DM) + 1e-6f);
#pragma unroll
    for (int j = 0; j < 4; ++j) xr[64 * j] = v[j] * rstd * gr[64 * j];
}

template <class Epi> __global__ void __launch_bounds__(512, 2) k_gemm(pg8::Gemm g, Epi E) {
    extern __shared__ __attribute__((aligned(16))) unsigned char lds[];
    pg8::StaticOrder S; S.init(g.M, g.N, (int)gridDim.x, (int)blockIdx.x);
    pg8::gemm_phase<Epi, pg8::StaticOrder, true, true>((PG8_LAS unsigned char*)lds, g, S, E);
}

__global__ void __launch_bounds__(256) k_attn_naive(const bf16* __restrict__ proj, bf16* __restrict__ mix, const float* lq1, const float* lk1, const float* lq2, const float* lk2,
                                                   const float* __restrict__ norm_g, float lam_init) {
    const int lane = threadIdx.x & 63, wave = __builtin_amdgcn_readfirstlane(threadIdx.x >> 6);
    const int gw = blockIdx.x * 4 + wave, h = gw & 3, t = gw >> 2, b = t / SEQ, sq = t % SEQ;
    const float lam = __expf(wave_sum(lq1[lane] * lk1[lane])) - __expf(wave_sum(lq2[lane] * lk2[lane])) + lam_init;
    float q1[64], q2[64];
    { const bf16* qp = proj + (size_t)t * NP + AQ + h * 128;
#pragma unroll
      for (int d = 0; d < 64; ++d) { q1[d] = bf2f(qp[d]); q2[d] = bf2f(qp[64 + d]); } }
    float m1 = -INFINITY, m2 = -INFINITY, l1 = 0.f, l2 = 0.f, o0a = 0.f, o0b = 0.f, o1a = 0.f, o1b = 0.f;
    for (int kb = 0; kb <= sq; kb += 64) {
        const int key = kb + lane; const bool valid = key <= sq; const int keyc = valid ? key : sq;
        const bf16x8* kp = (const bf16x8*)(proj + (size_t)(b * SEQ + keyc) * NP + AK + h * 128);
        float s1 = 0.f, s2 = 0.f;
#pragma unroll
        for (int c8 = 0; c8 < 8; ++c8) { const bf16x8 a = kp[c8], bb = kp[8 + c8];
#pragma unroll
            for (int e = 0; e < 8; ++e) { s1 += q1[c8 * 8 + e] * bf2f((bf16)a[e]); s2 += q2[c8 * 8 + e] * bf2f((bf16)bb[e]); } }
        if (!valid) { s1 = -INFINITY; s2 = -INFINITY; }
        const float mn1 = fmaxf(m1, wave_max(s1)), mn2 = fmaxf(m2, wave_max(s2));
        const float al1 = exp2f(m1 - mn1), al2 = exp2f(m2 - mn2);
        const float p1 = exp2f(s1 - mn1), p2 = exp2f(s2 - mn2);
        l1 = l1 * al1 + wave_sum(p1); l2 = l2 * al2 + wave_sum(p2); m1 = mn1; m2 = mn2;
        o0a *= al1; o0b *= al1; o1a *= al2; o1b *= al2;
#pragma unroll 8
        for (int j = 0; j < 64; ++j) {
            const float pj1 = __shfl(p1, j), pj2 = __shfl(p2, j);
            const int kj = (kb + j <= sq) ? kb + j : sq;
            const bf16* vp = proj + (size_t)(b * SEQ + kj) * NP + AV + h * 128;
            const float va = bf2f(vp[lane]), vb = bf2f(vp[64 + lane]);
            o0a += pj1 * va; o0b += pj1 * vb; o1a += pj2 * va; o1b += pj2 * vb;
        }
    }
    const float oa = o0a / l1 - lam * o1a / l2, ob = o0b / l1 - lam * o1b / l2;
    const float r = rsqrtf(wave_sum(oa * oa + ob * ob) * (1.f / 128.f) + 1e-5f) * (1.f - lam_init);
    bf16* mp = mix + (size_t)t * DM + 512 + h * 128;
    mp[lane] = (bf16)f2bf(oa * r * norm_g[h * 128 + lane]); mp[64 + lane] = (bf16)f2bf(ob * r * norm_g[h * 128 + 64 + lane]);
}

__global__ void __launch_bounds__(256) k_rwkv_prep(const bf16* __restrict__ proj, int t0, int ntok, const float* __restrict__ mu, const float* __restrict__ w0, const float* __restrict__ w_up,
                                                  const float* __restrict__ a0, const float* __restrict__ a_up, const float* __restrict__ g_up, const float* __restrict__ k_k, const float* __restrict__ k_a,
                                                  const float* __restrict__ r_k, float* R, float* W, float* K, float* V, float* KK, float* A, float* G, float* BON) {
    __shared__ float lora[128];
    const int c = threadIdx.x;
    for (int tok = blockIdx.x; tok < ntok; tok += gridDim.x) {
        const int t = t0 + tok, s = t % SEQ;
        const bf16* pr = proj + (size_t)t * NP + R0; const bf16* pp = pr - NP;
        auto ld = [&](int col) { const float p = bf2f(pr[col]); const float q = s > 0 ? bf2f(pp[col]) : 0.f; return p + (q - p) * mu[col]; };
        const float r = ld(c), k = ld(256 + c), v = ld(512 + c);
        if (c < 128) { const float x = ld(768 + c); lora[c] = c < 32 ? tanhf(x) : (c < 64 ? x : sigmoidf_(x)); }
        __syncthreads();
        float wl = w0[c], al = a0[c], g = 0.f;
#pragma unroll 8
        for (int j = 0; j < 32; ++j) { wl += lora[j] * w_up[j * 256 + c]; al += lora[32 + j] * a_up[j * 256 + c]; }
#pragma unroll 8
        for (int j = 0; j < 64; ++j) g += lora[64 + j] * g_up[j * 256 + c];
        __syncthreads();
        const float wlog = -softplusf_(-wl) - 0.5f; const float decay = __expf(-__expf(wlog));
        const float a = sigmoidf_(al);
        float kk = k * k_k[c]; const float ss = wave_sum(kk * kk); kk = kk / fmaxf(sqrtf(ss), 1e-12f);
        const float k2 = k * (1.f + (a - 1.f) * k_a[c]);
        const float bon = wave_sum(r * k2 * r_k[c]);
        const size_t idx = (size_t)tok * 256 + c;
        R[idx] = r; W[idx] = decay; K[idx] = k2; V[idx] = v; KK[idx] = kk; A[idx] = kk * a; G[idx] = g; if ((c & 63) == 0) BON[(size_t)tok * 4 + (c >> 6)] = bon;
    }
}
__global__ void __launch_bounds__(64) k_rwkv_scan(const float* __restrict__ R, const float* __restrict__ W, const float* __restrict__ K, const float* __restrict__ V, const float* __restrict__ KK,
                                                 const float* __restrict__ A, const float* __restrict__ G, const float* __restrict__ BON, const float* __restrict__ ln_g, const float* __restrict__ ln_b,
                                                 bf16* __restrict__ mix, int t0) {
    const int lane = threadIdx.x, bl = blockIdx.x >> 2, h = blockIdx.x & 3;
    float st[64];
#pragma unroll
    for (int j = 0; j < 64; ++j) st[j] = 0.f;
    const float lg = ln_g[h * 64 + lane], lb = ln_b[h * 64 + lane];
    for (int s = 0; s < SEQ; ++s) {
        const size_t tok = (size_t)bl * SEQ + s, base = tok * 256 + h * 64;
        const float vi = V[base + lane];
        const float* kkp = KK + base; const float* wp = W + base; const float* ap = A + base; const float* kp = K + base; const float* rp = R + base;
        float sa = 0.f;
#pragma unroll
        for (int j = 0; j < 64; ++j) sa -= st[j] * kkp[j];
        float y = 0.f;
#pragma unroll
        for (int j = 0; j < 64; ++j) { st[j] = st[j] * wp[j] + sa * ap[j] + vi * kp[j]; y += st[j] * rp[j]; }
        const float mean = wave_sum(y) * (1.f / 64.f), d = y - mean, var = wave_sum(d * d) * (1.f / 64.f);
        float yn = d * rsqrtf(var + 64e-5f) * lg + lb;
        yn += BON[tok * 4 + h] * vi;
        mix[((size_t)t0 + tok) * DM + 256 + h * 64 + lane] = (bf16)f2bf(yn * G[base + lane]);
    }
}

__global__ void __launch_bounds__(256) k_mlstm_prep(const bf16* __restrict__ proj, const float* __restrict__ cw, const float* __restrict__ cb, float* __restrict__ QP, float* __restrict__ KP) {
    const size_t gid = (size_t)blockIdx.x * 256 + threadIdx.x; const int c = (int)(gid & 511); const int t = (int)(gid >> 9), s = t % SEQ;
    float y = cb[c];
#pragma unroll
    for (int kk = 0; kk < 4; ++kk) { const int ds = kk - 3; if (s + ds >= 0) y += bf2f(proj[(size_t)(t + ds) * NP + c]) * cw[kk * 512 + c]; }
    const float v = y * sigmoidf_(y);
    if (c < 256) QP[(size_t)t * 256 + c] = v; else KP[(size_t)t * 256 + (c - 256)] = v * 0.125f;
}
__global__ void __launch_bounds__(64) k_mlstm_scan(const bf16* __restrict__ proj, const float* __restrict__ QP, const float* __restrict__ KP, const float* __restrict__ b_i, const float* __restrict__ b_f,
                                                  const float* __restrict__ norm_g, bf16* __restrict__ mix) {
    const int lane = threadIdx.x, b = blockIdx.x >> 2, h = blockIdx.x & 3;
    float C[64], n[64];
#pragma unroll
    for (int d = 0; d < 64; ++d) { C[d] = 0.f; n[d] = 0.f; }
    float m = 0.f; const float bi = b_i[h], bfv = b_f[h], ng = norm_g[h * 64 + lane];
    for (int s = 0; s < SEQ; ++s) {
        const size_t tok = (size_t)b * SEQ + s; const bf16* pr = proj + tok * NP;
        const float ig = bf2f(pr[MI + h]) + bi, lf = -softplusf_(-(bf2f(pr[MF + h]) + bfv));
        const float mn = fmaxf(lf + m, ig), fp = __expf(lf + m - mn), ip = __expf(ig - mn); m = mn;
        const float v = bf2f(pr[MV + h * 64 + lane]);
        const float* qp = QP + tok * 256 + h * 64; const float* kp = KP + tok * 256 + h * 64;
        float num = 0.f, den = 0.f;
#pragma unroll
        for (int d = 0; d < 64; ++d) { const float kd = ip * kp[d]; C[d] = fp * C[d] + kd * v; n[d] = fp * n[d] + kd; num += qp[d] * C[d]; den += qp[d] * n[d]; }
        const float hv = num / fmaxf(fabsf(den), __expf(-m));
        const float hn = hv * rsqrtf(wave_sum(hv * hv) * (1.f / 64.f) + 1e-6f) * ng;
        mix[tok * DM + h * 64 + lane] = (bf16)f2bf(hn * sigmoidf_(bf2f(pr[MO + h * 64 + lane])));
    }
}

template <class Epi> static void launch_gemm(const bf16* A, const bf16* Bt, int N, int K, const Epi& E, hipStream_t st) {
    static bool attr = false;
    if (!attr) { (void)hipFuncSetAttribute((const void*)k_gemm<Epi>, hipFuncAttributeMaxDynamicSharedMemorySize, 131072); attr = true; }
    pg8::Gemm g{A, Bt, T, N, K, 0};
    hipLaunchKernelGGL(k_gemm<Epi>, dim3(256), dim3(512), 131072, st, g, E);
}
extern "C" void kernel_launch(void* const* d_in, const int* in_sizes, int n_in, void* d_out, int out_size, void* d_ws, size_t ws_size, hipStream_t stream) {
    if (n_in != 29 || out_size != T * DM || ws_size < WS_END) { fprintf(stderr, "kernel_launch: unexpected shapes n_in %d out %d ws %zu\n", n_in, out_size, ws_size); return; }
    const float* const* in = (const float* const*)d_in;
    unsigned char* ws = (unsigned char*)d_ws; float* out = (float*)d_out;
    bf16* Win = (bf16*)(ws + WS_WIN); bf16* Wout = (bf16*)(ws + WS_WOUT); bf16* Wup = (bf16*)(ws + WS_WUP); bf16* Wdn = (bf16*)(ws + WS_WDN);
    bf16* XB = (bf16*)(ws + WS_XB); bf16* PROJ = (bf16*)(ws + WS_PROJ); bf16* HID = (bf16*)(ws + WS_HID); float* SCR = (float*)(ws + WS_SCR);
    for (int l = 0; l < DEPTH; ++l) {
        hipLaunchKernelGGL(k_wt, dim3(NP / 32, DM / 32), dim3(256), 0, stream, in[2] + (size_t)l * DM * NREAL, DM, NREAL, NP, Win + (size_t)l * NP * DM, in[1] + l * DM, AQ, AK, C2);
        hipLaunchKernelGGL(k_wt, dim3(DM / 32, DM / 32), dim3(256), 0, stream, in[24] + (size_t)l * DM * DM, DM, DM, DM, Wout + (size_t)l * DM * DM, (const float*)nullptr, 0, 0, 1.f);
        hipLaunchKernelGGL(k_wt, dim3(FF / 32, DM / 32), dim3(256), 0, stream, in[26] + (size_t)l * DM * FF, DM, FF, FF, Wup + (size_t)l * FF * DM, in[25] + l * DM, 0, 0, 1.f);
        hipLaunchKernelGGL(k_wt, dim3(DM / 32, FF / 32), dim3(256), 0, stream, in[27] + (size_t)l * FF * DM, FF, DM, DM, Wdn + (size_t)l * DM * FF, (const float*)nullptr, 0, 0, 1.f);
    }
    for (int l = 0; l < DEPTH; ++l) {
        const float* xin = l == 0 ? in[0] : out;
        const float lam_init = 0.8f - 0.6f * expf(-0.3f * (float)l);
        hipLaunchKernelGGL(k_rmsnorm, dim3(T / 4), dim3(256), 0, stream, xin, XB);
        launch_gemm(XB, Win + (size_t)l * NP * DM, NP, DM, pg8::EpiBf16S<0>{PROJ, nullptr, NP, 0}, stream);
        bf16* MIX = XB;
        hipLaunchKernelGGL(k_attn_naive, dim3(T), dim3(256), 0, stream, PROJ, MIX, in[19] + l * 64, in[20] + l * 64, in[21] + l * 64, in[22] + l * 64, in[23] + l * 512, lam_init);
        { const int ntok = T / 2; const size_t A1 = (size_t)ntok * 256; float* R = SCR; float* W = R + A1; float* K = W + A1; float* V = K + A1; float* KK = V + A1; float* A = KK + A1; float* G = A + A1; float* BON = G + A1;
          for (int half = 0; half < 2; ++half) {
              hipLaunchKernelGGL(k_rwkv_prep, dim3(2048), dim3(256), 0, stream, PROJ, half * ntok, ntok, in[8] + l * 896, in[9] + l * 256, in[10] + l * 32 * 256, in[11] + l * 256, in[12] + l * 32 * 256, in[13] + l * 64 * 256,
                                 in[14] + l * 256, in[15] + l * 256, in[16] + l * 256, R, W, K, V, KK, A, G, BON);
              hipLaunchKernelGGL(k_rwkv_scan, dim3(16), dim3(64), 0, stream, R, W, K, V, KK, A, G, BON, in[17] + l * 256, in[18] + l * 256, MIX, half * ntok);
          } }
        { float* QP = SCR; float* KP = SCR + (size_t)T * 256;
          hipLaunchKernelGGL(k_mlstm_prep, dim3(T * 2), dim3(256), 0, stream, PROJ, in[3] + l * 4 * 512, in[4] + l * 512, QP, KP);
          hipLaunchKernelGGL(k_mlstm_scan, dim3(32), dim3(64), 0, stream, PROJ, QP, KP, in[5] + l * 4, in[6] + l * 4, in[7] + l * 256, MIX); }
        launch_gemm(MIX, Wout + (size_t)l * DM * DM, DM, DM, pg8::EpiResF32{xin, out, DM, 0}, stream);
        hipLaunchKernelGGL(k_rmsnorm, dim3(T / 4), dim3(256), 0, stream, out, XB);
        launch_gemm(XB, Wup + (size_t)l * FF * DM, FF, DM, pg8::EpiBf16S<2>{HID, nullptr, FF, 0}, stream);
        launch_gemm(HID, Wdn + (size_t)l * DM * FF, DM, FF, pg8::EpiResF32{out, out, DM, 0}, stream);
    }
    hipLaunchKernelGGL(k_final_norm, dim3(T / 4), dim3(256), 0, stream, out, in[28]);
}
```

```cpp
#include <hip/hip_runtime.h>
#include <hip/hip_cooperative_groups.h>
#include <cstdio>
#include <cstdint>
#include <cmath>
namespace pg8 {
#define PG8_LAS __attribute__((address_space(3)))
typedef unsigned short bf16_t;
typedef short bf16x8 __attribute__((ext_vector_type(8)));
typedef float f32x4 __attribute__((ext_vector_type(4)));
typedef unsigned u32x4 __attribute__((ext_vector_type(4)));
constexpr int BM = 256, BK = 64, HALF = 128, HTB = HALF * BK * 2  , STAGE_BYTES = 8 * HTB, NXCD = 8, WGM = 8;

__host__ __device__ __forceinline__ int lds_byte(int r, int c) { const int st = (r >> 4) * 2 + (c >> 5), rr = r & 15, cc = c & 31, ob = rr * 64 + cc * 2; return st * 1024 + (ob ^ (((ob >> 9) & 1) << 5)); }
__host__ __device__ __forceinline__ void stage_rc(int b, int& R, int& C) { const int st = b / 1024, sb = b % 1024, swz = sb ^ (((sb >> 9) & 1) << 5); R = (st >> 1) * 16 + swz / 64; C = (st & 1) * 32 + (swz % 64) / 2; }
__host__ __device__ __forceinline__ int perm32(int rho) { const int n = rho >> 4, i = rho & 15; return 8 * (i >> 2) + 4 * n + (i & 3); }

struct Unit { int pm, pn; };
struct Gemm { const bf16_t* A; const bf16_t* Bt; int M, N, K, pad; };

struct StaticOrder {
    int nM, nN, nwg, G, c;
    __host__ __device__ void init(int M, int N, int G_, int c_) { nM = M / BM; nN = N / BM; nwg = nM * nN; G = G_; c = c_; }
    __host__ __device__ bool next(int i, Unit& u) const {
        const long L = (long)i * G + c; if (L >= nwg) return false;
        int wgid = (int)L; { const int q = nwg / NXCD, r = nwg % NXCD, xcd = wgid % NXCD, off = wgid / NXCD; wgid = (xcd < r ? xcd * (q + 1) : r * (q + 1) + (xcd - r) * q) + off; }
        const int nig = WGM * nN, gid = wgid / nig, fm = gid * WGM, gsz = (nM - fm) < WGM ? (nM - fm) : WGM;
        u.pm = fm + ((wgid % nig) % gsz); u.pn = (wgid % nig) / gsz; return true;
    }
    __device__ __forceinline__ void a_ready(const Unit&) const {}
    __device__ __forceinline__ void done(const Unit&) const {}
};

__device__ __forceinline__ unsigned cvt_pk_bf16(float lo, float hi) { unsigned r; asm volatile("v_cvt_pk_bf16_f32 %0, %1, %2" : "=v"(r) : "v"(lo), "v"(hi)); return r; }
typedef float f32x2 __attribute__((ext_vector_type(2)));
__device__ __forceinline__ unsigned long long ssq_fix(float s) { const float h = floorf(s); const unsigned hi = (unsigned)h; const unsigned lo = (unsigned)((s - h) * 4294967296.f); return ((unsigned long long)hi << 32) | lo; }
__device__ __forceinline__ float ssq_val(unsigned long long v) { return (float)(unsigned)(v >> 32) + (float)(unsigned)v * (1.f / 4294967296.f); }
template <int ACT> struct EpiBf16S {
    static constexpr bool PERM = true, AFTER_DRAIN = false;
    bf16_t* O; const unsigned long long* rowssq; int ldc; int pad;
    __device__ __forceinline__ void operator()(const f32x4 (&acc)[2][2][4][2], const Unit& u, int wr, int wc, int fr, int fq) const {
        const int row0 = u.pm * BM + wr * 64 + fr; const int col0 = u.pn * BM + wc * 32 + 8 * fq;
        unsigned long long rsv[2][4];
#pragma unroll
        for (int ai = 0; ai < 2; ++ai)
#pragma unroll
            for (int m = 0; m < 4; ++m) rsv[ai][m] = rowssq[row0 + ai * HALF + m * 16];
#pragma unroll
        for (int ai = 0; ai < 2; ++ai)
#pragma unroll
            for (int m = 0; m < 4; ++m) { const int row = row0 + ai * HALF + m * 16; const float rs = rsqrtf(ssq_val(rsv[ai][m]) * (1.f / 1024.f) + 1e-6f); bf16_t* rowp = O + (size_t)row * ldc + col0;
#pragma unroll
                for (int bj = 0; bj < 2; ++bj) { f32x4 v0 = acc[ai][bj][m][0] * rs, v1 = acc[ai][bj][m][1] * rs;
                    if (ACT == 2) {
#pragma unroll
                        for (int e = 0; e < 4; ++e) { float a = fmaxf(v0[e], 0.f), b = fmaxf(v1[e], 0.f); v0[e] = a * a; v1[e] = b * b; } }
                    u32x4 w; w.x = cvt_pk_bf16(v0[0], v0[1]); w.y = cvt_pk_bf16(v0[2], v0[3]); w.z = cvt_pk_bf16(v1[0], v1[1]); w.w = cvt_pk_bf16(v1[2], v1[3]);
                    *(u32x4*)(rowp + bj * HALF) = w; } }
    }
};
struct EpiResBf {
    static constexpr bool PERM = true, AFTER_DRAIN = false;
    bf16_t* xb; unsigned long long* ssq; int ldc; int pad;
    __device__ __forceinline__ void operator()(const f32x4 (&acc)[2][2][4][2], const Unit& u, int wr, int wc, int fr, int fq) const {
        const int row0 = u.pm * BM + wr * 64 + fr; const int col0 = u.pn * BM + wc * 32 + 8 * fq;
#pragma unroll
        for (int ai = 0; ai < 2; ++ai) {
            u32x4 bv[4][2];
#pragma unroll
            for (int m = 0; m < 4; ++m)
#pragma unroll
                for (int bj = 0; bj < 2; ++bj) bv[m][bj] = *(const u32x4*)(xb + (size_t)(row0 + ai * HALF + m * 16) * ldc + col0 + bj * HALF);
            asm volatile("" ::: "memory");
#pragma unroll
            for (int m = 0; m < 4; ++m) { const int row = row0 + ai * HALF + m * 16; bf16_t* rowp = xb + (size_t)row * ldc + col0; float s = 0.f;
#pragma unroll
                for (int bj = 0; bj < 2; ++bj) { const u32x4 b = bv[m][bj]; f32x4 v0 = acc[ai][bj][m][0], v1 = acc[ai][bj][m][1];
                    v0[0] += __uint_as_float(b.x << 16); v0[1] += __uint_as_float(b.x & 0xffff0000u); v0[2] += __uint_as_float(b.y << 16); v0[3] += __uint_as_float(b.y & 0xffff0000u);
                    v1[0] += __uint_as_float(b.z << 16); v1[1] += __uint_as_float(b.z & 0xffff0000u); v1[2] += __uint_as_float(b.w << 16); v1[3] += __uint_as_float(b.w & 0xffff0000u);
                    s += ((v0[0] * v0[0] + v0[1] * v0[1]) + (v0[2] * v0[2] + v0[3] * v0[3])) + ((v1[0] * v1[0] + v1[1] * v1[1]) + (v1[2] * v1[2] + v1[3] * v1[3]));
                    u32x4 w; w.x = cvt_pk_bf16(v0[0], v0[1]); w.y = cvt_pk_bf16(v0[2], v0[3]); w.z = cvt_pk_bf16(v1[0], v1[1]); w.w = cvt_pk_bf16(v1[2], v1[3]);
                    *(u32x4*)(rowp + bj * HALF) = w; }
                s += __int_as_float(__builtin_amdgcn_ds_swizzle(__float_as_int(s), (16 << 10) | 0x1f));
                { auto rr = __builtin_amdgcn_permlane32_swap(__float_as_uint(s), __float_as_uint(s), false, false); s = __uint_as_float(rr[0]) + __uint_as_float(rr[1]); }
                if (fq == 0) atomicAdd(ssq + row, ssq_fix(s)); }
            asm volatile("" ::: "memory"); }
    }
};
__device__ __forceinline__ const char* uni_ptr(const char* p) {
    const unsigned long long v = (unsigned long long)p; const unsigned lo = __builtin_amdgcn_readfirstlane((unsigned)v), hi = __builtin_amdgcn_readfirstlane((unsigned)(v >> 32));
    return (const char*)(((unsigned long long)hi << 32) | lo); }
template <class Epi, class Sched, bool ALIGN_EPI = false, bool SP2 = false>
__device__ __forceinline__ void gemm_phase(PG8_LAS unsigned char* lds, const Gemm g, const Sched& S, const Epi& E) {
    int tid_ = threadIdx.x; asm volatile("" : "+v"(tid_));
    const int tid = tid_, wid = __builtin_amdgcn_readfirstlane(tid >> 6), lane = tid & 63, wr = wid >> 2, wc = wid & 3, fr = lane & 15, fq = lane >> 4;
    const int K = g.K, nt = K / BK;
    unsigned voffA[2], voffB[2];
#pragma unroll
    for (int i = 0; i < 2; ++i) { int R, C; stage_rc(tid * 16 + i * 8192, R, C); const int Rb = Epi::PERM ? ((R & ~31) + perm32(R & 31)) : R;
        voffA[i] = (unsigned)(R * K + C) * 2u; voffB[i] = (unsigned)(Rb * K + C) * 2u; }
    const size_t kstep = (size_t)(BK * 2);
    const size_t hstep = (size_t)HALF * K * 2;
    const size_t tstep = 2 * hstep;
    const unsigned ldsw = (unsigned)wid * 1024u;
    const int aoff = lds_byte(wr * 64 + fr, fq * 8), boff = lds_byte(wc * 32 + fr, fq * 8);
#define PG8_SA(b, h) (((b) * 2 + (h)) * HTB)
#define PG8_SB(b, h) ((4 + (b) * 2 + (h)) * HTB)
#define PG8_STAGE(bufoff, gbase, voff) do { _Pragma("unroll") for (int _i = 0; _i < 2; ++_i) \
        __builtin_amdgcn_global_load_lds((const unsigned*)((const char*)(gbase) + (voff)[_i]), (PG8_LAS unsigned*)(lds + (bufoff) + ldsw + _i * 8192), 16, 0, 0); } while (0)
#define PG8_LDA(dst, b, h) do { _Pragma("unroll") for (int m = 0; m < 4; ++m) _Pragma("unroll") for (int k = 0; k < 2; ++k) dst[m][k] = *(const PG8_LAS bf16x8*)(lds + PG8_SA(b, h) + aoff + m * 2048 + k * 1024); } while (0)
#define PG8_LDB(dst, b, h) do { _Pragma("unroll") for (int n = 0; n < 2; ++n) _Pragma("unroll") for (int k = 0; k < 2; ++k) dst[n][k] = *(const PG8_LAS bf16x8*)(lds + PG8_SB(b, h) + boff + n * 2048 + k * 1024); } while (0)
#define PG8_MMA(ai, bj, At, Bt) do { __builtin_amdgcn_s_setprio(1); _Pragma("unroll") for (int m = 0; m < 4; ++m) _Pragma("unroll") for (int n = 0; n < 2; ++n) _Pragma("unroll") for (int k = 0; k < 2; ++k) \
        acc[ai][bj][m][n] = __builtin_amdgcn_mfma_f32_16x16x32_bf16(Bt[n][k], At[m][k], acc[ai][bj][m][n], 0, 0, 0); __builtin_amdgcn_s_setprio(0); } while (0)
#define PG8_WAIT_V(n) asm volatile("s_waitcnt vmcnt(" #n ")" ::: "memory")
#define PG8_WAIT_L(n) asm volatile("s_waitcnt lgkmcnt(" #n ")" ::: "memory")
#define PG8_BAR __builtin_amdgcn_s_barrier()
#define PG8_SCHED __builtin_amdgcn_sched_barrier(0)
    Unit cur, nxt; int ui = 0;
    if (!S.next(0, cur)) return;
    f32x4 acc[2][2][4][2];
#pragma unroll
    for (int a = 0; a < 2; ++a)
#pragma unroll
        for (int b = 0; b < 2; ++b)
#pragma unroll
            for (int m = 0; m < 4; ++m)
#pragma unroll
                for (int n = 0; n < 2; ++n) acc[a][b][m][n] = (f32x4){0.f, 0.f, 0.f, 0.f};
    bf16x8 At[4][2], B0[2][2], B1[2][2];
    const char* cA = uni_ptr((const char*)g.A + (size_t)cur.pm * tstep); const char* cB = uni_ptr((const char*)g.Bt + (size_t)cur.pn * tstep);
    S.a_ready(cur);
    if constexpr (SP2) {
        PG8_STAGE(PG8_SB(0, 0), cB, voffB); PG8_STAGE(PG8_SB(0, 1), cB + hstep, voffB); PG8_STAGE(PG8_SA(0, 0), cA, voffA); PG8_STAGE(PG8_SA(0, 1), cA + hstep, voffA);
        if (wr == 1) PG8_BAR;
        PG8_WAIT_V(2); PG8_BAR;
        PG8_STAGE(PG8_SB(1, 0), cB + kstep, voffB); PG8_STAGE(PG8_SA(1, 0), cA + kstep, voffA); PG8_STAGE(PG8_SB(1, 1), cB + hstep + kstep, voffB);
        PG8_WAIT_V(6); PG8_BAR;
    } else {
        PG8_STAGE(PG8_SB(0, 0), cB, voffB); PG8_STAGE(PG8_SA(0, 0), cA, voffA); PG8_STAGE(PG8_SB(0, 1), cB + hstep, voffB); PG8_STAGE(PG8_SA(0, 1), cA + hstep, voffA);
        if (wr == 1) PG8_BAR;
        PG8_WAIT_V(4); PG8_BAR;
        PG8_STAGE(PG8_SB(1, 0), cB + kstep, voffB); PG8_STAGE(PG8_SA(1, 0), cA + kstep, voffA); PG8_STAGE(PG8_SB(1, 1), cB + hstep + kstep, voffB);
        PG8_WAIT_V(6); PG8_BAR;
    }
    for (;;) {
        const bool has_next = S.next(ui + 1, nxt);
        const char* nA = uni_ptr(has_next ? (const char*)g.A + (size_t)nxt.pm * tstep : cA); const char* nB = uni_ptr(has_next ? (const char*)g.Bt + (size_t)nxt.pn * tstep : cB);
        for (int t = 0; t < nt; t += 2) {
            const bool last = (t == nt - 2);
            const char* a1 = cA + (size_t)(t + 1) * kstep;
            const char* a2 = last ? nA : cA + (size_t)(t + 2) * kstep; const char* b2 = last ? nB : cB + (size_t)(t + 2) * kstep;
            const char* a3 = a2 + kstep; const char* b3 = b2 + kstep;
            if (last && has_next) S.a_ready(nxt);
            if constexpr (SP2) {
            PG8_LDB(B0, 0, 0); PG8_LDB(B1, 0, 1); PG8_SCHED; PG8_LDA(At, 0, 0); PG8_STAGE(PG8_SA(1, 1), a1 + hstep, voffA);
            PG8_WAIT_V(8); PG8_WAIT_L(0); PG8_BAR; PG8_MMA(0, 0, At, B0); PG8_MMA(0, 1, At, B1); PG8_BAR; PG8_SCHED;
            PG8_LDA(At, 0, 1); PG8_STAGE(PG8_SB(0, 0), b2, voffB); PG8_STAGE(PG8_SB(0, 1), b2 + hstep, voffB); PG8_STAGE(PG8_SA(0, 0), a2, voffA);
            PG8_WAIT_V(8); PG8_WAIT_L(0); PG8_BAR; PG8_MMA(1, 0, At, B0); PG8_MMA(1, 1, At, B1); PG8_BAR; PG8_SCHED;
            PG8_LDB(B0, 1, 0); PG8_LDB(B1, 1, 1); PG8_SCHED; PG8_LDA(At, 1, 0); PG8_STAGE(PG8_SA(0, 1), a2 + hstep, voffA);
            PG8_WAIT_V(8); PG8_WAIT_L(0); PG8_BAR; PG8_MMA(0, 0, At, B0); PG8_MMA(0, 1, At, B1); PG8_BAR; PG8_SCHED;
            PG8_LDA(At, 1, 1); PG8_STAGE(PG8_SB(1, 0), b3, voffB); PG8_STAGE(PG8_SB(1, 1), b3 + hstep, voffB); PG8_STAGE(PG8_SA(1, 0), a3, voffA);
            PG8_WAIT_V(8); PG8_WAIT_L(0); PG8_BAR; PG8_MMA(1, 0, At, B0); PG8_MMA(1, 1, At, B1); PG8_BAR; PG8_SCHED;
            } else {
            PG8_LDB(B0, 0, 0); PG8_SCHED; PG8_LDA(At, 0, 0); PG8_STAGE(PG8_SA(1, 1), a1 + hstep, voffA);
            PG8_WAIT_L(8); PG8_BAR; PG8_WAIT_L(0); PG8_MMA(0, 0, At, B0); PG8_BAR; PG8_SCHED;
            PG8_LDB(B1, 0, 1); PG8_STAGE(PG8_SB(0, 0), b2, voffB);
            PG8_BAR; PG8_WAIT_L(0); PG8_MMA(0, 1, At, B1); PG8_BAR;
            PG8_LDA(At, 0, 1); PG8_STAGE(PG8_SA(0, 0), a2, voffA);
            PG8_BAR; PG8_WAIT_L(0); PG8_MMA(1, 0, At, B0); PG8_BAR; PG8_SCHED;
            PG8_STAGE(PG8_SB(0, 1), b2 + hstep, voffB);
            PG8_WAIT_V(6); PG8_BAR; PG8_MMA(1, 1, At, B1); PG8_BAR;
            PG8_LDB(B0, 1, 0); PG8_SCHED; PG8_LDA(At, 1, 0); PG8_STAGE(PG8_SA(0, 1), a2 + hstep, voffA);
            PG8_WAIT_L(8); PG8_BAR; PG8_WAIT_L(0); PG8_MMA(0, 0, At, B0); PG8_BAR; PG8_SCHED;
            PG8_LDB(B1, 1, 1); PG8_STAGE(PG8_SB(1, 0), b3, voffB);
            PG8_BAR; PG8_WAIT_L(0); PG8_MMA(0, 1, At, B1); PG8_BAR;
            PG8_LDA(At, 1, 1); PG8_STAGE(PG8_SA(1, 0), a3, voffA);
            PG8_BAR; PG8_WAIT_L(0); PG8_MMA(1, 0, At, B0); PG8_BAR; PG8_SCHED;
            PG8_STAGE(PG8_SB(1, 1), b3 + hstep, voffB);
            PG8_WAIT_V(6); PG8_BAR; PG8_MMA(1, 1, At, B1); PG8_BAR;
            }
        }
        if constexpr (ALIGN_EPI) { if (wr == 0) PG8_BAR; }
        if constexpr (!Epi::AFTER_DRAIN) { E(acc, cur, wr, wc, fr, fq); S.done(cur); }
        if (!has_next) break;
#pragma unroll
        for (int a = 0; a < 2; ++a)
#pragma unroll
            for (int b = 0; b < 2; ++b)
#pragma unroll
                for (int m = 0; m < 4; ++m)
#pragma unroll
                    for (int n = 0; n < 2; ++n) acc[a][b][m][n] = (f32x4){0.f, 0.f, 0.f, 0.f};
        cur = nxt; cA = nA; cB = nB; ++ui;
        if constexpr (ALIGN_EPI) { if (wr == 1) PG8_BAR; }
    }
    PG8_WAIT_V(0);
    if constexpr (!ALIGN_EPI) { if (wr == 0) PG8_BAR; }
    PG8_BAR;
    if constexpr (Epi::AFTER_DRAIN) { E.fused(acc, cur, wr, wc, fr, fq, lds, wid, lane); S.done(cur); }
#undef PG8_SA
#undef PG8_SB
#undef PG8_STAGE
#undef PG8_LDA
#undef PG8_LDB
#undef PG8_MMA
#undef PG8_WAIT_V
#undef PG8_WAIT_L
#undef PG8_BAR
#undef PG8_SCHED
}
}
#include <hip/hip_bf16.h>
#include <cmath>
namespace attn_body {
using bf16=__hip_bfloat16;
using bf16x8=__attribute__((ext_vector_type(8)))short;
using s16x4=__attribute__((ext_vector_type(4)))short;
using f32x16=__attribute__((ext_vector_type(16)))float;
using u32x4=__attribute__((ext_vector_type(4)))unsigned;
constexpr int SEQ=4096,D=64,PQ=3584,PO=1024;
constexpr int NW=8,QBLK=32,QB=QBLK*NW,KVBLK=64,NQB=SEQ/QB;
constexpr int ATTN_UNIT_ROWS=QB;
__device__ __forceinline__ int crow(int r,int hi){return (r&3)+8*(r>>2)+4*hi;}
#define SBAR() __builtin_amdgcn_sched_barrier(0)
__device__ __forceinline__ void cmask(f32x16&p0,f32x16&p1,int jb,int qrel,int hi){
  const float NEG=-INFINITY; int kb=64*jb+4*hi;
  #pragma unroll
  for(int r=0;r<16;++r){int kv=kb+(r&3)+8*(r>>2); if(kv>qrel)p0[r]=NEG; if(kv+32>qrel)p1[r]=NEG;}
}

constexpr int NSLOT=3, SLOTB=8192;
constexpr int VSLOTB=2*SLOTB;
constexpr int LDS_K=0, LDS_V=NSLOT*SLOTB, LDS_WS=LDS_V+NSLOT*VSLOTB, LDS_OST=LDS_WS+NW*64*4, LDS_BYTES=LDS_OST+NW*4096;
constexpr float C2=0.125f*1.4426950408889634f;
__device__ __forceinline__ void glds16(const void*gsrc,unsigned lds_dst){unsigned keep;
  asm volatile("s_mov_b32 %0, m0\n\ts_mov_b32 m0, %2\n\ts_nop 0\n\tglobal_load_lds_dwordx4 %1, off\n\ts_mov_b32 m0, %0":"=&s"(keep):"v"(gsrc),"s"(lds_dst):"memory");}
__device__ __forceinline__ float max3f(float a,float b,float c){float r;asm("v_max3_f32 %0, %1, %2, %3":"=v"(r):"v"(a),"v"(b),"v"(c));return r;}
__device__ __forceinline__ float max2f(float a,float b){float r;asm("v_max_f32_e32 %0, %1, %2":"=v"(r):"v"(a),"v"(b));return r;}
__device__ __forceinline__ float fadd_s(float a,float b){float r;asm("v_add_f32_e32 %0, %1, %2":"=v"(r):"v"(a),"v"(b));return r;}
__device__ __forceinline__ float fsub_s(float a,float b){float r;asm("v_sub_f32_e32 %0, %1, %2":"=v"(r):"v"(a),"v"(b));return r;}
typedef float f32x2_t __attribute__((ext_vector_type(2))); typedef __bf16 bf16x2_t __attribute__((ext_vector_type(2)));
__device__ __forceinline__ unsigned cvtpk_s(float lo,float hi){f32x2_t v={lo,hi};bf16x2_t b=__builtin_convertvector(v,bf16x2_t);return __builtin_bit_cast(unsigned,b);}
#define WAIT_BAR(N) asm volatile("s_waitcnt vmcnt(" #N ") lgkmcnt(0)\n\ts_barrier":::"memory")

__device__ __forceinline__ void qkt(f32x16&p0,f32x16&p1,const char*Kslot,const bf16x8*qr,const f32x16&negm,int r32,int hi){
  const char*kb=Kslot+hi*1024+r32*16;
  #pragma unroll
  for(int d0=0;d0<4;++d0){
    const bf16x8 b0=*reinterpret_cast<const bf16x8*>(kb+d0*2048);
    const bf16x8 b1=*reinterpret_cast<const bf16x8*>(kb+d0*2048+512);
    if(d0==0){p0=__builtin_amdgcn_mfma_f32_32x32x16_bf16(b0,qr[0],negm,0,0,0);p1=__builtin_amdgcn_mfma_f32_32x32x16_bf16(b1,qr[0],negm,0,0,0);}
    else{p0=__builtin_amdgcn_mfma_f32_32x32x16_bf16(b0,qr[d0],p0,0,0,0);p1=__builtin_amdgcn_mfma_f32_32x32x16_bf16(b1,qr[d0],p1,0,0,0);}}
}
typedef __attribute__((address_space(3))) const char* lds_cptr;
typedef short v4i16_t __attribute__((ext_vector_type(4)));
__device__ __forceinline__ void kload8(bf16x8*kf,lds_cptr kp){
  kf[0]=*(const __attribute__((address_space(3))) bf16x8*)(kp);      kf[1]=*(const __attribute__((address_space(3))) bf16x8*)(kp+512);
  kf[2]=*(const __attribute__((address_space(3))) bf16x8*)(kp+2048); kf[3]=*(const __attribute__((address_space(3))) bf16x8*)(kp+2560);
  kf[4]=*(const __attribute__((address_space(3))) bf16x8*)(kp+4096); kf[5]=*(const __attribute__((address_space(3))) bf16x8*)(kp+4608);
  kf[6]=*(const __attribute__((address_space(3))) bf16x8*)(kp+6144); kf[7]=*(const __attribute__((address_space(3))) bf16x8*)(kp+6656);
}
__device__ __forceinline__ void kload2(bf16x8*kf,lds_cptr kp,int j){ kf[2*j]=*(const __attribute__((address_space(3))) bf16x8*)(kp+j*2048); kf[2*j+1]=*(const __attribute__((address_space(3))) bf16x8*)(kp+j*2048+512); }
__device__ __forceinline__ s16x4 vtr(lds_cptr p){ return __builtin_bit_cast(s16x4,__builtin_amdgcn_ds_read_tr16_b64_v4i16((__attribute__((address_space(3))) v4i16_t*)p)); }
__device__ __forceinline__ float rowmax(const f32x16&p0,const f32x16&p1){
  float a=max3f(p0[0],p0[1],p1[0]),b=max3f(p0[2],p0[3],p1[1]);a=max3f(a,p1[2],p1[3]);
  #pragma unroll
  for(int r=4;r<16;r+=4){a=max3f(a,p0[r],p0[r+1]);b=max3f(b,p0[r+2],p0[r+3]);a=max3f(a,p1[r],p1[r+1]);b=max3f(b,p1[r+2],p1[r+3]);}
  const float m=max2f(a,b);
  auto rr=__builtin_amdgcn_permlane32_swap(__float_as_uint(m),__float_as_uint(m),false,false);
  return max2f(__uint_as_float(rr[0]),__uint_as_float(rr[1]));
}
__device__ __forceinline__ void pv(f32x16*o,int vb,bf16x8 pa0,bf16x8 pa1,bf16x8 pa2,bf16x8 pa3){
  #pragma unroll
  for(int d0=0;d0<4;++d0){s16x4 lo[4],hi[4];
    #pragma unroll
    for(int ks=0;ks<4;++ks){
      asm volatile("ds_read_b64_tr_b16 %0,%1 offset:%c2":"=&v"(lo[ks]):"v"(vb),"i"(d0*4096+ks*1024):"memory");
      asm volatile("ds_read_b64_tr_b16 %0,%1 offset:%c2":"=&v"(hi[ks]):"v"(vb),"i"(d0*4096+ks*1024+512):"memory");}
    asm volatile("s_waitcnt lgkmcnt(0)":::"memory");SBAR();
    #define PK(k) (bf16x8){lo[k][0],lo[k][1],lo[k][2],lo[k][3],hi[k][0],hi[k][1],hi[k][2],hi[k][3]}
    o[d0]=__builtin_amdgcn_mfma_f32_32x32x16_bf16(pa0,PK(0),o[d0],0,0,0);
    o[d0]=__builtin_amdgcn_mfma_f32_32x32x16_bf16(pa1,PK(1),o[d0],0,0,0);
    o[d0]=__builtin_amdgcn_mfma_f32_32x32x16_bf16(pa2,PK(2),o[d0],0,0,0);
    o[d0]=__builtin_amdgcn_mfma_f32_32x32x16_bf16(pa3,PK(3),o[d0],0,0,0);
    #undef PK
  }
}

#ifndef ATTN_STORE16
#define ATTN_STORE16(p,v) (*(__attribute__((address_space(1))) u32x4*)(unsigned long long)(p)=(v))
#endif
struct DiffEpi { float lam, oscale; const float* g; unsigned short* mixh; };
template<int THRL> __device__ __forceinline__ void attn_unit(long rowbase,int qb,const bf16*Q,const bf16*__restrict__ K,const bf16*__restrict__ V,int c_head,const DiffEpi&E,char*shm){
  int tid_=threadIdx.x; asm volatile("":"+v"(tid_));
  const int tid=tid_,lane=tid&63,r32=lane&31,hi=lane>>5; const int wid=__builtin_amdgcn_readfirstlane(tid>>6);
  const int q0=qb*QB;
  const bf16*Qw=Q+(rowbase+q0+wid*QBLK)*PQ;
  const bf16*Kh=K+rowbase*PQ,*Vh=V+rowbase*PQ;
  const unsigned lds0=(unsigned)(uintptr_t)shm;
  float*wsf=(float*)(shm+LDS_WS)+wid*64;
  const bf16*ksrc=Kh+(long)lane*PQ+wid*8;
  const bf16*vsrc=Vh+(long)(16*(wid&3)+(lane>>2))*PQ+(wid>>2)*32+(lane&3)*8;
  const unsigned kdst=lds0+LDS_K+wid*1024, vdst=lds0+LDS_V+wid*1024;
  #define DMA_K(t,slot) glds16(ksrc+(long)(t)*KVBLK*PQ,(unsigned)__builtin_amdgcn_readfirstlane(kdst+(slot)))
  #define DMA_V(t,slot) do{ glds16(vsrc+(long)(t)*KVBLK*PQ,(unsigned)__builtin_amdgcn_readfirstlane(vdst+2*(slot))); glds16(vsrc+64+(long)(t)*KVBLK*PQ,(unsigned)__builtin_amdgcn_readfirstlane(vdst+2*(slot)+8192)); }while(0)
  const int vb0=(int)(lds0+LDS_V)+((lane>>4)&1)*32+(lane&3)*8+(4*hi+((lane&15)>>2))*64;
  const char*Kbase=shm+LDS_K; bf16x8 kf[8];
  const lds_cptr shm3=(lds_cptr)shm; const lds_cptr kp0=shm3+LDS_K+hi*1024+r32*16; const lds_cptr vp0=shm3+LDS_V+((lane>>4)&1)*32+(lane&3)*8+(4*hi+((lane&15)>>2))*64;
  const int NT=(q0+QB)/KVBLK;
  DMA_K(0,0);DMA_V(0,0);DMA_K(1,SLOTB);
  bf16x8 qr[4];
  #pragma unroll
  for(int d0=0;d0<4;++d0)qr[d0]=*(const __attribute__((address_space(1))) bf16x8*)(unsigned long long)(&Qw[(long)r32*PQ+d0*16+hi*8]);
  float mhat=0.f,l_reg=0.f;f32x16 o[4];o[0]=f32x16{};o[1]=f32x16{};o[2]=f32x16{};o[3]=f32x16{};const f32x16 ZC=f32x16{};
  const int qrel=wid*QBLK+r32;
  #define CMASK(P0,P1,t) do{int jb_=(t)-(NT-4); if(jb_>=0)cmask(P0,P1,jb_,qrel,hi);}while(0)
  bool resc=false;
  #define START(P0,P1) do{ const float rm=rowmax(P0,P1); resc=false; \
    { const float dl=rm; mhat=fadd_s(mhat,dl); \
      _Pragma("unroll") for(int r=0;r<16;++r){P0[r]=fsub_s(P0[r],dl);P1[r]=fsub_s(P1[r],dl);} \
      } \
    _Pragma("unroll") for(int r=0;r<16;++r)P0[r]=__builtin_amdgcn_exp2f(P0[r]); }while(0)
  #define RESC() do{ if(resc){ asm volatile("s_waitcnt lgkmcnt(0)":::"memory"); \
      _Pragma("unroll") for(int d_=0;d_<4;++d_) _Pragma("unroll") for(int r=0;r<16;++r)o[d_][r]*=wsf[crow(r,hi)]; } }while(0)
  f32x16 pA0,pA1,pB0,pB1;
  int sl_prev=0,sl_cur=0,sl_next=SLOTB;
  #define ROT() do{sl_prev=sl_cur;sl_cur=sl_next;sl_next=(sl_next==(NSLOT-1)*SLOTB)?0:sl_next+SLOTB;}while(0)
  DMA_K(2,2*SLOTB);
  WAIT_BAR(4);
  qkt(pA0,pA1,Kbase,qr,ZC,r32,hi);asm volatile("s_nop 15\n\ts_nop 7":"+v"(pA0),"+v"(pA1));CMASK(pA0,pA1,0);
  START(pA0,pA1);
  _Pragma("unroll") for(int r=0;r<16;++r)pA1[r]=__builtin_amdgcn_exp2f(pA1[r]);
  WAIT_BAR(0);
  DMA_K(3,0);DMA_V(1,SLOTB);
  ROT();
  kload8(kf,kp0+sl_cur);
  WAIT_BAR(3);
  s16x4 vlo[4],vhi[4]; u32x4 pw0,pw1,pw2,pw3;
  #define PKW(P,B) cvtpk_s(P[B],P[B+1])
  #define PAF(k) __builtin_bit_cast(bf16x8,pw##k)
  #define VFR(i) (bf16x8){vlo[i][0],vlo[i][1],vlo[i][2],vlo[i][3],vhi[i][0],vhi[i][1],vhi[i][2],vhi[i][3]}
  #define PIN(x) asm volatile("":"+v"(x))
  #define MX3(a,b,c) __builtin_fmaxf(__builtin_fmaxf((a),(b)),(c))
  #define GAPA(MF,A0,A1,A2,A3,W0,W1,PW) do{ MF; sacc+=A0; sacc+=A1; sacc+=A2; sacc+=A3; PIN(sacc); W0; W1; PIN(PW); SBAR(); }while(0)
  #define EX(v) __builtin_amdgcn_exp2f(v)
  #define GAPB(MF,X,B) do{ MF; X[B]=EX(X[B]); X[B+1]=EX(X[B+1]); PIN(X); SBAR(); }while(0)
  #define VRD(i,s) do{ vlo[s]=vtr(vp_+(((i)>>2)*4096+((i)&3)*1024)); vhi[s]=vtr(vp_+(((i)>>2)*4096+((i)&3)*1024+512)); }while(0)
  #define KRD(G,j) do{ if(G){ kload2(kf,kp0+sl_next,j); SBAR(); } }while(0)
  #define PVM(n,i) o[(i)>>2]=__builtin_amdgcn_mfma_f32_32x32x16_bf16(PAF_((i)&3),VFR((n)&3),o[(i)>>2],0,0,0)
  #define PAF_(k) ((k)==0?PAF(0):(k)==1?PAF(1):(k)==2?PAF(2):PAF(3))
  #define STEP(C0,C1,P0,P1,t,GK,GV,GL) do{ SBAR(); \
    const lds_cptr vp_=vp0+2*sl_prev; \
    VRD(0,0); SBAR(); float sacc=(P0[0]+P0[1]); \
    GAPA(C0=__builtin_amdgcn_mfma_f32_32x32x16_bf16(kf[0],qr[0],ZC,0,0,0), P0[2],P0[3],P0[4],P0[5],     pw0[0]=PKW(P0,0), pw0[1]=PKW(P0,2), pw0); \
    GAPA(C1=__builtin_amdgcn_mfma_f32_32x32x16_bf16(kf[1],qr[0],ZC,0,0,0), P0[6],P0[7],P0[8],P0[9],     pw0[2]=PKW(P0,4), pw0[3]=PKW(P0,6), pw0); \
    VRD(4,1); SBAR(); GAPA(C0=__builtin_amdgcn_mfma_f32_32x32x16_bf16(kf[2],qr[1],C0,0,0,0),   P0[10],P0[11],P0[12],P0[13], pw1[0]=PKW(P0,8), pw1[1]=PKW(P0,10), pw1); \
    GAPA(C1=__builtin_amdgcn_mfma_f32_32x32x16_bf16(kf[3],qr[1],C1,0,0,0),   P0[14],P0[15],P1[0],P1[1],   pw1[2]=PKW(P0,12),pw1[3]=PKW(P0,14), pw1); \
    VRD(1,2); SBAR(); GAPA(C0=__builtin_amdgcn_mfma_f32_32x32x16_bf16(kf[4],qr[2],C0,0,0,0),   P1[2],P1[3],P1[4],P1[5],     pw2[0]=PKW(P1,0), pw2[1]=PKW(P1,2), pw2); \
    GAPA(C1=__builtin_amdgcn_mfma_f32_32x32x16_bf16(kf[5],qr[2],C1,0,0,0),   P1[6],P1[7],P1[8],P1[9],     pw2[2]=PKW(P1,4), pw2[3]=PKW(P1,6), pw2); \
    VRD(5,3); SBAR(); GAPA(C0=__builtin_amdgcn_mfma_f32_32x32x16_bf16(kf[6],qr[3],C0,0,0,0),   P1[10],P1[11],P1[12],P1[13], pw3[0]=PKW(P1,8), pw3[1]=PKW(P1,10), pw3); \
    GAPA(C1=__builtin_amdgcn_mfma_f32_32x32x16_bf16(kf[7],qr[3],C1,0,0,0),   P1[14],P1[15],0.f,0.f,       pw3[2]=PKW(P1,12),pw3[3]=PKW(P1,14), pw3); \
    l_reg+=sacc; \
    if(GK){DMA_K((t)+3,sl_cur);} if(GV){DMA_V((t)+1,sl_next);} \
    _Pragma("unroll") for(int r=0;r<16;++r){C0[r]-=mhat;C1[r]-=mhat;} \
    CMASK(C0,C1,t); \
    { float a=MX3(C0[0],C0[1],C1[0]),b=MX3(C0[2],C0[3],C1[1]); a=MX3(a,C1[2],C1[3]); \
      _Pragma("unroll") for(int r=4;r<16;r+=4){a=MX3(a,C0[r],C0[r+1]);b=MX3(b,C0[r+2],C0[r+3]);a=MX3(a,C1[r],C1[r+1]);b=MX3(b,C1[r+2],C1[r+3]);} \
      float rm=__builtin_fmaxf(a,b); { auto rr=__builtin_amdgcn_permlane32_swap(__float_as_uint(rm),__float_as_uint(rm),false,false); rm=__builtin_fmaxf(__uint_as_float(rr[0]),__uint_as_float(rr[1])); } \
      resc=false; \
      if(__builtin_expect(__any(rm>(float)THRL),0)){ const float dl=__builtin_fmaxf(rm,0.f); mhat+=dl; \
        _Pragma("unroll") for(int r=0;r<16;++r){C0[r]-=dl;C1[r]-=dl;} \
        const float f=__builtin_amdgcn_exp2f(-dl); l_reg*=f; if(hi==0)wsf[r32]=f; resc=true; } } \
    SBAR(); \
    GAPB(PVM(0,0),C0,0);   VRD(2,0); SBAR(); \
    GAPB(PVM(1,4),C0,2);   VRD(6,1); SBAR(); \
    KRD(GL,0); GAPB(PVM(2,1),C0,4);   VRD(3,2); SBAR(); \
    KRD(GL,1); GAPB(PVM(3,5),C0,6);   VRD(7,3); SBAR(); \
    KRD(GL,2); GAPB(PVM(4,2),C0,8);   VRD(8,0); SBAR(); \
    KRD(GL,3); GAPB(PVM(5,6),C0,10);  VRD(12,1); SBAR(); \
    GAPB(PVM(6,3),C0,12);  VRD(9,2); SBAR(); \
    GAPB(PVM(7,7),C0,14);  VRD(13,3); SBAR(); \
    GAPB(PVM(8,8),C1,0);   VRD(10,0); SBAR(); \
    GAPB(PVM(9,12),C1,2);  VRD(14,1); SBAR(); \
    GAPB(PVM(10,9),C1,4);  VRD(11,2); SBAR(); \
    GAPB(PVM(11,13),C1,6); VRD(15,3); SBAR(); \
    GAPB(PVM(12,10),C1,8); \
    GAPB(PVM(13,14),C1,10); \
    GAPB(PVM(14,11),C1,12); \
    GAPB(PVM(15,15),C1,14); \
    }while(0)
  int t=1;
  #undef CMASK
  #define CMASK(P0,P1,t) do{}while(0)
  for(;t+5<NT;t+=2){
    STEP(pB0,pB1,pA0,pA1,t,true,true,true);     WAIT_BAR(3); RESC(); ROT();
    STEP(pA0,pA1,pB0,pB1,t+1,true,true,true);   WAIT_BAR(3); RESC(); ROT();
  }
  #undef CMASK
  #define CMASK(P0,P1,t) do{int jb_=(t)-(NT-4); if(jb_>=0)cmask(P0,P1,jb_,qrel,hi);}while(0)
  #define ENDW(tt) do{ if((tt)+3<NT){WAIT_BAR(3);} else if((tt)+2<NT){WAIT_BAR(2);} else {WAIT_BAR(0);} }while(0)
  for(;t+1<NT;t+=2){
    STEP(pB0,pB1,pA0,pA1,t,(t+3<NT),(t+1<NT),(t+1<NT));       ENDW(t);   RESC(); ROT();
    STEP(pA0,pA1,pB0,pB1,t+1,(t+4<NT),(t+2<NT),(t+2<NT));     ENDW(t+1); RESC(); ROT();
  }
  STEP(pB0,pB1,pA0,pA1,NT-1,false,false,false); RESC();
  { float sacc=pB0[0]+pB0[1]; _Pragma("unroll") for(int r=2;r<16;++r)sacc+=pB0[r]; _Pragma("unroll") for(int r=0;r<16;++r)sacc+=pB1[r]; l_reg+=sacc;
    pw0=(u32x4){PKW(pB0,0),PKW(pB0,2),PKW(pB0,4),PKW(pB0,6)};pw1=(u32x4){PKW(pB0,8),PKW(pB0,10),PKW(pB0,12),PKW(pB0,14)};pw2=(u32x4){PKW(pB1,0),PKW(pB1,2),PKW(pB1,4),PKW(pB1,6)};pw3=(u32x4){PKW(pB1,8),PKW(pB1,10),PKW(pB1,12),PKW(pB1,14)};
    SBAR(); pv(o,vb0+2*sl_cur,PAF(0),PAF(1),PAF(2),PAF(3)); }
  #undef PKW
  #undef PAF
  #undef VFR
  #undef PIN
  #undef MX3
  #undef GAPA
  #undef GAPB
  #undef EX
  #undef VRD
  #undef PVM
  #undef PAF_
  #undef KRD
  #undef STEP
  #undef ENDW
  {auto rr=__builtin_amdgcn_permlane32_swap(__float_as_uint(l_reg),__float_as_uint(l_reg),false,false);l_reg=__uint_as_float(rr[0])+__uint_as_float(rr[1]);}
  if(hi==0)wsf[32+r32]=l_reg;asm volatile("s_waitcnt lgkmcnt(0)":::"memory");
  float rli[16];
  #pragma unroll
  for(int r=0;r<16;++r)rli[r]=__builtin_amdgcn_rcpf(wsf[32+crow(r,hi)]);
  { bf16*stg=(bf16*)(shm+LDS_OST)+wid*2048;
    unsigned short*mbase=E.mixh+(rowbase+q0+wid*QBLK)*1024;
    if(c_head==0){
      #pragma unroll
      for(int hb=0;hb<2;++hb){
        #pragma unroll
        for(int r=0;r<16;++r){const int orow=crow(r,hi); stg[orow*64+r32]=__float2bfloat16(o[2*hb][r]*rli[r]); stg[orow*64+32+r32]=__float2bfloat16(o[2*hb+1][r]*rli[r]);}
        asm volatile("s_waitcnt lgkmcnt(0)":::"memory");
        #pragma unroll
        for(int i=0;i<4;++i){const int row=i*8+(lane>>3),ch=lane&7; const u32x4 v=*(const u32x4*)(stg+row*64+ch*8); ATTN_STORE16(mbase+(long)row*1024+hb*64+ch*8,v);}
        asm volatile("s_waitcnt lgkmcnt(0)":::"memory"); }
    } else {
      u32x4 v0[2][4];
      #pragma unroll
      for(int hb=0;hb<2;++hb)
        #pragma unroll
        for(int i=0;i<4;++i){const int row=i*8+(lane>>3),ch=lane&7; v0[hb][i]=*(const __attribute__((address_space(1))) u32x4*)(unsigned long long)(mbase+(long)row*1024+hb*64+ch*8);}
      float dv[2][4][8]; float ss[4]={0.f,0.f,0.f,0.f};
      #pragma unroll
      for(int hb=0;hb<2;++hb){
        #pragma unroll
        for(int r=0;r<16;++r){const int orow=crow(r,hi); stg[orow*64+r32]=__float2bfloat16(o[2*hb][r]*rli[r]); stg[orow*64+32+r32]=__float2bfloat16(o[2*hb+1][r]*rli[r]);}
        asm volatile("s_waitcnt lgkmcnt(0)":::"memory");
        #pragma unroll
        for(int i=0;i<4;++i){const int row=i*8+(lane>>3),ch=lane&7; const u32x4 v1=*(const u32x4*)(stg+row*64+ch*8);
          #pragma unroll
          for(int e=0;e<4;++e){const float dl=__uint_as_float(v0[hb][i][e]<<16)-E.lam*__uint_as_float(v1[e]<<16),dh=__uint_as_float(v0[hb][i][e]&0xffff0000u)-E.lam*__uint_as_float(v1[e]&0xffff0000u);
            dv[hb][i][2*e]=dl; dv[hb][i][2*e+1]=dh; ss[i]+=dl*dl+dh*dh;} }
        asm volatile("s_waitcnt lgkmcnt(0)":::"memory"); }
      #pragma unroll
      for(int i=0;i<4;++i){const int row=i*8+(lane>>3),ch=lane&7; float t=ss[i];
        t+=__int_as_float(__builtin_amdgcn_ds_swizzle(__float_as_int(t),(1<<10)|0x1f)); t+=__int_as_float(__builtin_amdgcn_ds_swizzle(__float_as_int(t),(2<<10)|0x1f)); t+=__int_as_float(__builtin_amdgcn_ds_swizzle(__float_as_int(t),(4<<10)|0x1f));
        const float rs=__builtin_amdgcn_rsqf(t*(1.f/128.f)+1e-5f)*E.oscale;
        #pragma unroll
        for(int hb=0;hb<2;++hb){const __attribute__((address_space(1))) float*gp=(const __attribute__((address_space(1))) float*)(unsigned long long)(E.g+hb*64+ch*8);
          u32x4 ov;
          #pragma unroll
          for(int e=0;e<4;++e)ov[e]=cvtpk_s(dv[hb][i][2*e]*rs*gp[2*e],dv[hb][i][2*e+1]*rs*gp[2*e+1]);
          ATTN_STORE16(mbase+(long)row*1024+hb*64+ch*8,ov);} } } }
  asm volatile("s_waitcnt lgkmcnt(0)\n\ts_barrier":::"memory");
  #undef DMA_K
  #undef DMA_V
  #undef CMASK
  #undef START
  #undef RESC
  #undef ROT
}
constexpr int ATTN_LDS_BYTES=LDS_BYTES;
struct StaticOrder {
  int vcu; int grid;
  __device__ __forceinline__ explicit StaticOrder(int grid_,int block):vcu(__builtin_amdgcn_readfirstlane((grid_%8==0)?(block%8)*(grid_/8)+block/8:block)),grid(grid_){}
};
__device__ __forceinline__ unsigned long long uni64(unsigned long long v){ const unsigned lo=__builtin_amdgcn_readfirstlane((unsigned)v),hi=__builtin_amdgcn_readfirstlane((unsigned)(v>>32)); return ((unsigned long long)hi<<32)|lo; }
template<int THRL=8> __device__ __forceinline__ void attn_phase(char*lds,const bf16*proj_,unsigned short*mix_,int aq,int ak,int av,float lam,float oscale,const float*norm_g_,const StaticOrder&S){
  const bf16*proj=(const bf16*)uni64((unsigned long long)proj_); unsigned short*mix=(unsigned short*)uni64((unsigned long long)mix_); const float*norm_g=(const float*)uni64((unsigned long long)norm_g_);
  const bool bal=(S.grid==256); const int xcd=S.vcu>>5,j=S.vcu&31;
  const int ntrip=bal?2:(S.vcu<512?(512-S.vcu+S.grid-1)/S.grid:0);
  for(int i=0;i<ntrip;++i){ const int u=S.vcu+i*S.grid;
    const int T_=j>>2,k_=j&3; const int sx_=(T_==0)?13:(T_==1)?9:(T_<5)?18-T_:17-T_, sy_=(T_==0)?1:(T_==1)?5:(T_<5)?T_:T_+1;
    const int bh=bal?xcd*4+2*i+(k_>>1):(u>>4),qb=bal?(((i^(k_&1))?sy_:sx_)-1):(u&15),b=bh>>2,h=bh&3;
    DiffEpi E; E.lam=__uint_as_float(__builtin_amdgcn_readfirstlane(__float_as_uint(lam))); E.oscale=oscale; E.g=(const float*)uni64((unsigned long long)(norm_g+h*128)); E.mixh=(unsigned short*)uni64((unsigned long long)(mix+512+h*128));
    for(int c=0;c<2;++c)
      attn_unit<THRL>((long)__builtin_amdgcn_readfirstlane(b*SEQ),__builtin_amdgcn_readfirstlane(qb),(const bf16*)uni64((unsigned long long)(proj+aq+h*128+c*64)),(const bf16*)uni64((unsigned long long)(proj+ak+h*128+c*64)),(const bf16*)uni64((unsigned long long)(proj+av+h*128)),c,E,lds); }
}
#undef SBAR
#undef WAIT_BAR
}
constexpr int BATCH = 8, SEQ = 4096, DM = 1024, DEPTH = 2, T = BATCH * SEQ, FF = 4096;
constexpr int NP = 3584;
constexpr int AQ = 0, AK = 512, AV = 1024;
constexpr int MB0 = 1536, MQ = MB0, MK = MB0 + 256, MV = MB0 + 512, MO = MB0 + 768, MI = MB0 + 1024, MF = MB0 + 1028;
constexpr int R0 = MB0 + 1032;
constexpr int NREAL = 3464;
__host__ __device__ __forceinline__ int proj_src_col(int n) { return n < 1536 ? 1928 + n : (n < 3464 ? n - 1536 : -1); }
constexpr float C2 = 0.125f * 1.4426950408889634f;
typedef unsigned short bf16;
typedef float f32x4 __attribute__((ext_vector_type(4)));
typedef short bf16x8 __attribute__((ext_vector_type(8)));
typedef unsigned u32x4 __attribute__((ext_vector_type(4)));

__device__ __forceinline__ float bf2f(bf16 v) { return __uint_as_float(((unsigned)v) << 16); }
__device__ __forceinline__ unsigned f2bf(float f) { unsigned u = __float_as_uint(f); return (u + 0x7fffu + ((u >> 16) & 1u)) >> 16; }
template <int X> __device__ __forceinline__ float xor_lane(float v) {
    if constexpr (X < 32) return __int_as_float(__builtin_amdgcn_ds_swizzle(__float_as_int(v), (X << 10) | 0x1f));
    else { auto rr = __builtin_amdgcn_permlane32_swap(__float_as_uint(v), __float_as_uint(v), false, false); return __uint_as_float((threadIdx.x & 32) ? rr[0] : rr[1]); }
}
#define DPP_F(old, src, ctrl, rmask, bctl) __int_as_float(__builtin_amdgcn_update_dpp(__float_as_int(old), __float_as_int(src), ctrl, rmask, 0xf, bctl))
__device__ __forceinline__ float wave_sum(float v) {
    v += DPP_F(0.f, v, 0x111, 0xf, true); v += DPP_F(0.f, v, 0x112, 0xf, true); v += DPP_F(0.f, v, 0x114, 0xf, true); v += DPP_F(0.f, v, 0x118, 0xf, true);
    v += DPP_F(0.f, v, 0x142, 0xa, true); v += DPP_F(0.f, v, 0x143, 0xc, true);
    return __int_as_float(__builtin_amdgcn_readlane(__float_as_int(v), 63));
}
__device__ __forceinline__ float wave_max(float v) {
    v = fmaxf(v, DPP_F(v, v, 0x111, 0xf, false)); v = fmaxf(v, DPP_F(v, v, 0x112, 0xf, false)); v = fmaxf(v, DPP_F(v, v, 0x114, 0xf, false)); v = fmaxf(v, DPP_F(v, v, 0x118, 0xf, false));
    v = fmaxf(v, DPP_F(v, v, 0x142, 0xa, false)); v = fmaxf(v, DPP_F(v, v, 0x143, 0xc, false));
    return __int_as_float(__builtin_amdgcn_readlane(__float_as_int(v), 63));
}
__device__ __forceinline__ float wave_scan_sum(float v) {
    v += DPP_F(0.f, v, 0x111, 0xf, true); v += DPP_F(0.f, v, 0x112, 0xf, true); v += DPP_F(0.f, v, 0x114, 0xf, true); v += DPP_F(0.f, v, 0x118, 0xf, true);
    v += DPP_F(0.f, v, 0x142, 0xa, true); v += DPP_F(0.f, v, 0x143, 0xc, true);
    return v;
}
__device__ __forceinline__ float wave_scan_max(float v) {
    v = fmaxf(v, DPP_F(v, v, 0x111, 0xf, false)); v = fmaxf(v, DPP_F(v, v, 0x112, 0xf, false)); v = fmaxf(v, DPP_F(v, v, 0x114, 0xf, false)); v = fmaxf(v, DPP_F(v, v, 0x118, 0xf, false));
    v = fmaxf(v, DPP_F(v, v, 0x142, 0xa, false)); v = fmaxf(v, DPP_F(v, v, 0x143, 0xc, false));
    return v;
}
__device__ __forceinline__ float sum_q4(float v) { v += xor_lane<16>(v);
    auto rr = __builtin_amdgcn_permlane32_swap(__float_as_uint(v), __float_as_uint(v), false, false); return __uint_as_float(rr[0]) + __uint_as_float(rr[1]); }
__device__ __forceinline__ float lane_up(float v, int lane, int o) { return __int_as_float(__builtin_amdgcn_ds_bpermute((lane - o) << 2, __float_as_int(v))); }
__device__ __forceinline__ float sigmoidf_(float x) { return 1.f / (1.f + __expf(-x)); }
__device__ __forceinline__ float softplusf_(float x) { return fmaxf(x, 0.f) + log1pf(__expf(-fabsf(x))); }
__device__ __forceinline__ float softplus_fast(float x) { return fmaxf(x, 0.f) + 0.6931471805599453f * __builtin_amdgcn_logf(1.f + __builtin_amdgcn_exp2f(-1.4426950408889634f * fabsf(x))); }

constexpr size_t MiB = 1u << 20;
constexpr size_t WS_CTL = 0;
constexpr size_t WS_WIN = 1 * MiB;
constexpr size_t WS_WOUT = WS_WIN + 14 * MiB;
constexpr size_t WS_WUP = WS_WOUT + 4 * MiB;
constexpr size_t WS_WDN = WS_WUP + 16 * MiB;
constexpr size_t WS_XB = 51 * MiB;
constexpr size_t WS_PROJ = 115 * MiB;
constexpr size_t WS_MIX = 339 * MiB;
constexpr size_t WS_RWG = 403 * MiB, WS_RWH = 419 * MiB, WS_RWRH = 435 * MiB, WS_RWYL = 451 * MiB, WS_GATE = 467 * MiB, WS_BON = 483 * MiB;
constexpr size_t WS_SCR = 51 * MiB;
constexpr size_t WS_HID = 115 * MiB;
constexpr size_t WS_MLC = 484 * MiB, WS_MLN = 500 * MiB, WS_MLS = 501 * MiB;
constexpr size_t WS_SSQ = 502 * MiB;
constexpr size_t WS_END = 504 * MiB;

#ifndef LAS
#define LAS __attribute__((address_space(3)))
#endif
#define XB_TMO      128
#define XB_XCNT(j)  (256  + 64 * (j))
#define XB_XSUB(j)  (1280 + 64 * (j))
#define XB_XGEN(j)  (2304 + 64 * (j))
#define XB_TOP      3328
#define XB_TOPGEN   3392
#define XCD_BAR_WORDS 3456
#define XB_SPIN_CAP (1u << 18)

__device__ __forceinline__ unsigned xb_ld(unsigned* p)              { return __hip_atomic_load(p, __ATOMIC_RELAXED, __HIP_MEMORY_SCOPE_AGENT); }
__device__ __forceinline__ unsigned xb_add(unsigned* p, unsigned v) { return __hip_atomic_fetch_add(p, v, __ATOMIC_RELAXED, __HIP_MEMORY_SCOPE_AGENT); }
__device__ __forceinline__ unsigned xb_xcc_id() { return (unsigned)__builtin_amdgcn_s_getreg((3 << 11) | 20) & 0xFu; }
#define XB_SPIN(cond, bar) do { unsigned _sp = 0; while (cond) { __builtin_amdgcn_s_sleep(1); \
    if ((++_sp & 255u) == 0u) { if (xb_ld(&(bar)[XB_TMO])) break; if (_sp > XB_SPIN_CAP) { atomicAdd(&(bar)[XB_TMO], 1u); break; } } } } while (0)

struct XcdBarrier {
    unsigned* bar; unsigned x;
    volatile LAS unsigned* st;
};

__device__ __forceinline__ XcdBarrier xcd_barrier_post(unsigned* bar, volatile LAS unsigned* st) {
    XcdBarrier b; b.bar = bar; b.x = xb_xcc_id(); b.st = st;
    if (threadIdx.x == 0) (void)xb_add(&bar[XB_XCNT(b.x)], 1u);
    return b;
}
__device__ __forceinline__ void xcd_barrier_complete(unsigned* bar, unsigned x, unsigned& nloc, unsigned& nx) {
    const unsigned G = gridDim.x * gridDim.y * gridDim.z;
    unsigned sum, cnt, mine, sp = 0u;
    for (;;) {
        sum = 0u; cnt = 0u; mine = 0u;
#pragma unroll
        for (unsigned j = 0; j < 16; ++j) { const unsigned c = xb_ld(&bar[XB_XCNT(j)]); sum += c; cnt += (c > 0u) ? 1u : 0u; mine = (j == x) ? c : mine; }
        if (sum == G) break;
        __builtin_amdgcn_s_sleep(1);
        if ((++sp & 255u) == 0u) { if (xb_ld(&bar[XB_TMO])) break; if (sp > XB_SPIN_CAP) { atomicAdd(&bar[XB_TMO], 1u); break; } }
    }
    nloc = mine > 0u ? mine : 1u; nx = cnt > 0u ? cnt : 1u;
}

__device__ __forceinline__ void xcd_barrier(const XcdBarrier& b) {
    asm volatile("s_waitcnt vmcnt(0)" ::: "memory");
    __syncthreads();
    if (threadIdx.x == 0) {
        unsigned* bar = b.bar;
        __builtin_amdgcn_s_waitcnt(0);
        unsigned nloc = b.st[0], nx = b.st[1];
        if (nloc == 0u) { xcd_barrier_complete(bar, b.x, nloc, nx); b.st[0] = nloc; b.st[1] = nx; }
        const unsigned old = xb_add(&bar[XB_XSUB(b.x)], 1u);
        const unsigned gen = old / nloc;
        if (old + 1u == (gen + 1u) * nloc) {
            __builtin_amdgcn_fence(__ATOMIC_RELEASE, "agent");
            asm volatile("s_waitcnt vmcnt(0)" ::: "memory");
            const unsigned og = xb_add(&bar[XB_TOP], 1u);
            const unsigned tg = og / nx;
            if (og + 1u == (tg + 1u) * nx) xb_add(&bar[XB_TOPGEN], 1u);
            else XB_SPIN(xb_ld(&bar[XB_TOPGEN]) == tg, bar);
            __builtin_amdgcn_fence(__ATOMIC_ACQUIRE, "agent");
            xb_add(&bar[XB_XGEN(b.x)], 1u);
            asm volatile("s_waitcnt vmcnt(0)" ::: "memory");
        } else {
            XB_SPIN(xb_ld(&bar[XB_XGEN(b.x)]) == gen, bar);
            __builtin_amdgcn_fence(__ATOMIC_ACQUIRE, "agent");
            asm volatile("s_waitcnt vmcnt(0)" ::: "memory");
        }
    }
    __syncthreads();
}

namespace rw {
typedef __attribute__((address_space(3))) unsigned char lds_u8;
typedef __attribute__((address_space(3))) unsigned short lds_bf;
typedef __attribute__((address_space(3))) float lds_f32;
constexpr int TS = 72, TILE_B = 64 * TS * 2;
constexpr int MISC_OFF = 15 * TILE_B;
__device__ __forceinline__ lds_bf* slot(lds_u8* lds, int i) { return (lds_bf*)(lds + i * TILE_B); }
typedef float f32x2_t __attribute__((ext_vector_type(2))); typedef __bf16 bf16x2_t __attribute__((ext_vector_type(2)));
__device__ __forceinline__ unsigned pk(float lo, float hi) { f32x2_t v = {lo, hi}; bf16x2_t b = __builtin_convertvector(v, bf16x2_t); return __builtin_bit_cast(unsigned, b); }
__device__ __forceinline__ unsigned short bf1(float x) { return (unsigned short)pk(x, x); }
__device__ __forceinline__ f32x4 mma64(const lds_bf* A, const lds_bf* Bt, int mt, int nt, int lane, f32x4 acc) {
    const int r = lane & 15, q = lane >> 4;
    const lds_bf* ap = A + (mt * 16 + r) * TS + q * 8; const lds_bf* bp = Bt + (nt * 16 + r) * TS + q * 8;
    const bf16x8 a0 = *(const __attribute__((address_space(3))) bf16x8*)ap, a1 = *(const __attribute__((address_space(3))) bf16x8*)(ap + 32);
    const bf16x8 b0 = *(const __attribute__((address_space(3))) bf16x8*)bp, b1 = *(const __attribute__((address_space(3))) bf16x8*)(bp + 32);
    acc = __builtin_amdgcn_mfma_f32_16x16x32_bf16(a0, b0, acc, 0, 0, 0);
    acc = __builtin_amdgcn_mfma_f32_16x16x32_bf16(a1, b1, acc, 0, 0, 0);
    return acc;
}
__device__ __forceinline__ void st_nm(lds_bf* tile, int mt, int nt, int lane, f32x4 v) {
    typedef unsigned u32x2 __attribute__((ext_vector_type(2)));
    u32x2 w; w.x = pk(v[0], v[1]); w.y = pk(v[2], v[3]);
    *(__attribute__((address_space(3))) u32x2*)(tile + (nt * 16 + (lane & 15)) * TS + mt * 16 + (lane >> 4) * 4) = w;
}
__device__ __forceinline__ f32x4 ld_nm(const lds_bf* tile, int mt, int nt, int lane) {
    typedef unsigned u32x2 __attribute__((ext_vector_type(2)));
    const u32x2 w = *(const __attribute__((address_space(3))) u32x2*)(tile + (nt * 16 + (lane & 15)) * TS + mt * 16 + (lane >> 4) * 4);
    return (f32x4){__uint_as_float(w.x << 16), __uint_as_float(w.x & 0xffff0000u), __uint_as_float(w.y << 16), __uint_as_float(w.y & 0xffff0000u)};
}
__device__ __forceinline__ void st_mn(lds_bf* tile, int mt, int nt, int lane, f32x4 v) {
    lds_bf* p = tile + (mt * 16 + (lane >> 4) * 4) * TS + nt * 16 + (lane & 15);
    const unsigned w01 = pk(v[0], v[1]), w23 = pk(v[2], v[3]);
    p[0] = (unsigned short)w01; p[TS] = (unsigned short)(w01 >> 16); p[2 * TS] = (unsigned short)w23; p[3 * TS] = (unsigned short)(w23 >> 16);
}
struct W { const float *mu, *w0, *w_up, *a0, *a_up, *g_up, *k_k, *k_a, *r_k, *ln_g, *ln_b; };
struct Buf { bf16* G; bf16* H; bf16* RH; bf16* YL; bf16* GATE; float* BON; };

}
namespace ml {
struct P { const float *cw, *cb, *b_i, *b_f, *norm_g; };
struct Buf { bf16* C; float* N; float* SC; };
__device__ void m1_gates(rw::lds_u8* lds, int unit, int lane, float igv, float fgv, const Buf& o);
__device__ void m1_tiles(rw::lds_u8* lds, int lane, int wv, const float (&xk)[11], const float (&cwv)[5], const float (&vv)[8], int s0);
__device__ void m1_product(rw::lds_u8* lds, int unit, int lane, int wv, const Buf& o); }
namespace rw {
#define RW_SYNC() asm volatile("s_waitcnt lgkmcnt(0)\n\ts_barrier" ::: "memory")
struct R1W { float muA, wuv[4], auv[4], guv[8], mur, muk, muv, w0, a0, kkc, kac, rkc, cwv[5], gbi, gbf; };
__device__ __forceinline__ void r1_load_w(R1W& Q, int h, const W& w, const ml::P& mp) {
    int tid_ = threadIdx.x; asm volatile("" : "+v"(tid_));
    const int tid = tid_, lane = tid & 63, wv = __builtin_amdgcn_readfirstlane(tid >> 6), colA = tid & 127, hc = h * 64 + lane;
    Q.muA = w.mu[768 + colA];
#pragma unroll
    for (int i = 0; i < 4; ++i) { Q.wuv[i] = w.w_up[(wv + 8 * i) * 256 + hc]; Q.auv[i] = w.a_up[(wv + 8 * i) * 256 + hc]; }
#pragma unroll
    for (int i = 0; i < 8; ++i) Q.guv[i] = w.g_up[(wv + 8 * i) * 256 + hc];
    Q.mur = w.mu[hc]; Q.muk = w.mu[256 + hc]; Q.muv = w.mu[512 + hc]; Q.w0 = w.w0[hc]; Q.a0 = w.a0[hc]; Q.kkc = w.k_k[hc]; Q.kac = w.k_a[hc]; Q.rkc = w.r_k[hc];
#pragma unroll
    for (int i = 0; i < 4; ++i) Q.cwv[i] = mp.cw[i * 512 + 256 + hc];
    Q.cwv[4] = mp.cb[256 + hc]; Q.gbi = mp.b_i[h]; Q.gbf = mp.b_f[h];
}
__device__ __forceinline__ void r1_unit(lds_u8* lds, int unit, const R1W& Q, const bf16* __restrict__ proj, const W& w, const Buf& o, const ml::P& mp, const ml::Buf& mo) {
    int tid_ = threadIdx.x; asm volatile("" : "+v"(tid_));
    const int tid = tid_, lane = tid & 63, wv = __builtin_amdgcn_readfirstlane(tid >> 6);
    const int ch = unit & 63, bh = unit >> 6, h = bh & 3, b = bh >> 2;
    const size_t t0 = (size_t)b * SEQ + ch * 64;
    lds_bf* S0 = slot(lds, 0); lds_bf* S1 = slot(lds, 1); lds_bf* S2 = slot(lds, 2); lds_bf* S3 = slot(lds, 3); lds_bf* S4 = slot(lds, 4); lds_bf* S5 = slot(lds, 5); lds_bf* S6 = slot(lds, 6);
    lds_bf* S7 = slot(lds, 7); lds_bf* S8 = slot(lds, 8); lds_bf* S9 = slot(lds, 9); lds_bf* S10 = slot(lds, 10); lds_bf* S11 = slot(lds, 11); lds_bf* S12 = slot(lds, 12);
    lds_f32* gamL = (lds_f32*)(lds + MISC_OFF); lds_f32* part = gamL + 64;
    const bool first = (ch == 0);
    const int colA = tid & 127, tgA = tid >> 7;
    const bf16* pcA = proj + (t0 + tgA * 16) * NP + R0 + 768 + colA;
    bf16 rA[17];
    rA[0] = pcA[-(long)NP];
#pragma unroll
    for (int i = 0; i < 16; ++i) rA[1 + i] = pcA[(size_t)i * NP];
    const float muA = Q.muA;
    float igv = 0.f, fgv = 0.f;
    if (wv == 7) { const bf16* pr = proj + (t0 + lane) * NP; const bf16 gi = pr[MI + h], gf = pr[MF + h]; igv = bf2f(gi) + Q.gbi; fgv = bf2f(gf) + Q.gbf; }
    const int hc = h * 64 + lane;
    const bf16* pcC = proj + (t0 + wv * 8) * NP + R0 + hc;
    bf16 rC[9][3];
#pragma unroll
    for (int j = 0; j < 3; ++j) rC[0][j] = pcC[-(long)NP + 256 * j];
#pragma unroll
    for (int i = 0; i < 8; ++i)
#pragma unroll
        for (int j = 0; j < 3; ++j) rC[1 + i][j] = pcC[(size_t)i * NP + 256 * j];
    const float mur = Q.mur, muk = Q.muk, muv = Q.muv, w0 = Q.w0, a0 = Q.a0, kkc = Q.kkc, kac = Q.kac, rkc = Q.rkc;
    float xk[11], cwv[5], mvv[8];
    { const bf16* pk_ = proj + (t0 + wv * 8) * NP + MK + hc; const bf16* pv = proj + (t0 + wv * 8) * NP + MV + hc; bf16 rk[11], rv[8];
#pragma unroll
      for (int i = 0; i < 11; ++i) rk[i] = pk_[((long)i - 3) * NP];
#pragma unroll
      for (int i = 0; i < 8; ++i) rv[i] = pv[(size_t)i * NP];
#pragma unroll
      for (int i = 0; i < 5; ++i) cwv[i] = Q.cwv[i];
#pragma unroll
      for (int i = 0; i < 11; ++i) xk[i] = bf2f(rk[i]);
#pragma unroll
      for (int i = 0; i < 8; ++i) mvv[i] = bf2f(rv[i]); }
    constexpr int LS = 136;
    lds_bf* Lt = S0;
    lds_bf* Wu = (lds_bf*)(lds + 2 * TILE_B);
    lds_bf* Au = Wu + 64 * 40;
    lds_bf* Gu = Au + 64 * 40;
    { const int col = colA, tg = tgA; const float mu = muA; const float esc = col < 32 ? 2.885390081777927f : -1.4426950408889634f;
      float prev = (first && tg == 0) ? 0.f : bf2f(rA[0]);
#pragma unroll
      for (int i = 0; i < 16; ++i) { const float p = bf2f(rA[1 + i]); const float x = p + (prev - p) * mu; prev = p;
          const float rc = __builtin_amdgcn_rcpf(1.f + __builtin_amdgcn_exp2f(x * esc));
          const float y = col < 32 ? 1.f - 2.f * rc : (col < 64 ? x : rc);
          Lt[(tg * 16 + i) * LS + col] = bf1(y); }
      const int c = lane;
#pragma unroll
      for (int i = 0; i < 4; ++i) { const int k = wv + 8 * i; Wu[c * 40 + k] = (unsigned short)f2bf(Q.wuv[i]); Au[c * 40 + k] = (unsigned short)f2bf(Q.auv[i]); }
#pragma unroll
      for (int i = 0; i < 8; ++i) { const int k = wv + 8 * i; Gu[c * TS + k] = (unsigned short)f2bf(Q.guv[i]); } }
    if (wv == 7) ml::m1_gates(lds, unit, lane, igv, fgv, mo);
    RW_SYNC();
    lds_f32* Fw = (lds_f32*)(lds + 8 * TILE_B); lds_f32* Fa = Fw + 4096; lds_bf* Fg = (lds_bf*)(Fa + 4096);
    { const int r = lane & 15, q = lane >> 4, mt = wv >> 1;
#pragma unroll
      for (int tt = 0; tt < 2; ++tt) { const int nt = (wv & 1) * 2 + tt;
          const bf16x8 aw = *(const __attribute__((address_space(3))) bf16x8*)(Lt + (mt * 16 + r) * LS + q * 8);
          const bf16x8 aa = *(const __attribute__((address_space(3))) bf16x8*)(Lt + (mt * 16 + r) * LS + 32 + q * 8);
          const bf16x8 ag0 = *(const __attribute__((address_space(3))) bf16x8*)(Lt + (mt * 16 + r) * LS + 64 + q * 8);
          const bf16x8 ag1 = *(const __attribute__((address_space(3))) bf16x8*)(Lt + (mt * 16 + r) * LS + 96 + q * 8);
          const bf16x8 bw = *(const __attribute__((address_space(3))) bf16x8*)(Wu + (nt * 16 + r) * 40 + q * 8);
          const bf16x8 ba = *(const __attribute__((address_space(3))) bf16x8*)(Au + (nt * 16 + r) * 40 + q * 8);
          const bf16x8 bg0 = *(const __attribute__((address_space(3))) bf16x8*)(Gu + (nt * 16 + r) * TS + q * 8);
          const bf16x8 bg1 = *(const __attribute__((address_space(3))) bf16x8*)(Gu + (nt * 16 + r) * TS + 32 + q * 8);
          const f32x4 z = {0.f, 0.f, 0.f, 0.f};
          const f32x4 fw = __builtin_amdgcn_mfma_f32_16x16x32_bf16(aw, bw, z, 0, 0, 0);
          const f32x4 fa = __builtin_amdgcn_mfma_f32_16x16x32_bf16(aa, ba, z, 0, 0, 0);
          f32x4 fg = __builtin_amdgcn_mfma_f32_16x16x32_bf16(ag0, bg0, z, 0, 0, 0); fg = __builtin_amdgcn_mfma_f32_16x16x32_bf16(ag1, bg1, fg, 0, 0, 0);
#pragma unroll
          for (int e = 0; e < 4; ++e) { const int t = mt * 16 + q * 4 + e, c = nt * 16 + r; Fw[t * 64 + c] = fw[e]; Fa[t * 64 + c] = fa[e]; Fg[t * TS + c] = bf1(fg[e]); } } }
    RW_SYNC();
    ml::m1_tiles(lds, lane, wv, xk, cwv, mvv, ch * 64 + wv * 8);
    { const int c = lane, tg = wv;
      float pr, pk_, pv; if (first && tg == 0) { pr = 0.f; pk_ = 0.f; pv = 0.f; } else { pr = bf2f(rC[0][0]); pk_ = bf2f(rC[0][1]); pv = bf2f(rC[0][2]); }
      float rr[8], k2[8], vv[8], ap[8], bp[8], lw[8];
#pragma unroll
      for (int i = 0; i < 8; ++i) { const int t = tg * 8 + i;
          const float xr = bf2f(rC[1 + i][0]), xk_ = bf2f(rC[1 + i][1]), xv = bf2f(rC[1 + i][2]);
          const float r = xr + (pr - xr) * mur, k = xk_ + (pk_ - xk_) * muk, v = xv + (pv - xv) * muv; pr = xr; pk_ = xk_; pv = xv;
          lw[i] = -0.8750440158f * __builtin_amdgcn_rcpf(1.f + __builtin_amdgcn_exp2f(-1.4426950408889634f * (w0 + Fw[t * 64 + c])));
          const float a = __builtin_amdgcn_rcpf(1.f + __builtin_amdgcn_exp2f(-1.4426950408889634f * (a0 + Fa[t * 64 + c])));
          float kk = k * kkc; const float ss = wave_sum(kk * kk); kk = kk * __builtin_amdgcn_rsqf(fmaxf(ss, 1e-24f));
          const float kx = k * (1.f + (a - 1.f) * kac);
          const float bon = wave_sum(r * kx * rkc);
          rr[i] = r; k2[i] = kx; vv[i] = v; ap[i] = -kk; bp[i] = kk * a;
          o.GATE[(t0 + t) * 256 + hc] = Fg[t * TS + c];
          if (c == 0) o.BON[(t0 + t) * 4 + h] = bon; }
      float cl[8]; float run = 0.f;
#pragma unroll
      for (int i = 0; i < 8; ++i) { run += lw[i]; cl[i] = run; }
      part[tg * 64 + c] = run;
      RW_SYNC();
      float off = 0.f, tot = 0.f;
#pragma unroll
      for (int g = 0; g < 8; ++g) { const float pgv = part[g * 64 + c]; if (g < tg) off += pgv; tot += pgv; }
      const float gtot = __builtin_amdgcn_exp2f(tot);
      if (tg == 0) gamL[c] = gtot;
      typedef unsigned u32x4v __attribute__((ext_vector_type(4)));
      float at[8], vt[8], bb[8], kb[8];
      float gp = __builtin_amdgcn_exp2f(off);
#pragma unroll
      for (int i = 0; i < 8; ++i) { const int t = tg * 8 + i;
          const float g = __builtin_amdgcn_exp2f(off + cl[i]), ig = __builtin_amdgcn_rcpf(g), gl = gtot * ig;
          at[i] = ap[i] * gp; vt[i] = vv[i]; bb[i] = bp[i] * gl; kb[i] = k2[i] * gl; gp = g;
          const unsigned w01 = pk(bp[i] * ig, k2[i] * ig), w23 = pk(at[i], rr[i] * g);
          S0[t * TS + c] = (unsigned short)w01; S1[t * TS + c] = (unsigned short)(w01 >> 16); S2[t * TS + c] = (unsigned short)w23; S3[t * TS + c] = (unsigned short)(w23 >> 16); }
      u32x4v x;
      x.x = pk(at[0], at[1]); x.y = pk(at[2], at[3]); x.z = pk(at[4], at[5]); x.w = pk(at[6], at[7]); *(__attribute__((address_space(3))) u32x4v*)(S4 + c * TS + tg * 8) = x;
      x.x = pk(vt[0], vt[1]); x.y = pk(vt[2], vt[3]); x.z = pk(vt[4], vt[5]); x.w = pk(vt[6], vt[7]); *(__attribute__((address_space(3))) u32x4v*)(S5 + c * TS + tg * 8) = x;
      x.x = pk(bb[0], bb[1]); x.y = pk(bb[2], bb[3]); x.z = pk(bb[4], bb[5]); x.w = pk(bb[6], bb[7]); *(__attribute__((address_space(3))) u32x4v*)(S6 + c * TS + tg * 8) = x;
      x.x = pk(kb[0], kb[1]); x.y = pk(kb[2], kb[3]); x.z = pk(kb[4], kb[5]); x.w = pk(kb[6], kb[7]); *(__attribute__((address_space(3))) u32x4v*)(S7 + c * TS + tg * 8) = x; }
    RW_SYNC();
    const int mt = wv >> 1, r16 = lane & 15, q4 = lane >> 4;
    const f32x4 Z = {0.f, 0.f, 0.f, 0.f};
    f32x4 mab[2], mkb[2], mbr[2], mkr[2];
#pragma unroll
    for (int tt = 0; tt < 2; ++tt) { const int nt = (wv & 1) * 2 + tt;
        mab[tt] = mma64(S0, S2, mt, nt, lane, Z); mkb[tt] = mma64(S1, S2, mt, nt, lane, Z); mbr[tt] = mma64(S0, S3, mt, nt, lane, Z); mkr[tt] = mma64(S1, S3, mt, nt, lane, Z);
#pragma unroll
        for (int e = 0; e < 4; ++e) { const int s = mt * 16 + q4 * 4 + e, t = nt * 16 + r16; if (!(s < t)) { mab[tt][e] = 0.f; mkb[tt][e] = 0.f; } if (!(s <= t)) { mbr[tt][e] = 0.f; mkr[tt][e] = 0.f; } } }
    ml::m1_product(lds, unit, lane, wv, mo);
    lds_bf* SA = (lds_bf*)(lds + MISC_OFF + 4608);
#pragma unroll
    for (int tt = 0; tt < 2; ++tt) { const int nt = (wv & 1) * 2 + tt;
        st_mn(S11, mt, nt, lane, mab[tt]); st_nm(S12, mt, nt, lane, mab[tt]);
        f32x4 ti = mab[tt];
#pragma unroll
        for (int e = 0; e < 4; ++e) if (mt * 16 + q4 * 4 + e == nt * 16 + r16) ti[e] += 1.f;
        st_nm(SA, mt, nt, lane, ti); st_nm(S8, mt, nt, lane, mkb[tt]); st_nm(S9, mt, nt, lane, mbr[tt]); st_nm(S10, mt, nt, lane, mkr[tt]); }
    RW_SYNC();
    { f32x4 pp[2], tn[2];
#define R1_E_STEP(PA, PB, TI, QA, QB, TO, SQUARE) do { \
      _Pragma("unroll") for (int tt = 0; tt < 2; ++tt) { const int nt = (wv & 1) * 2 + tt; tn[tt] = mma64(PA, TI, mt, nt, lane, ld_nm(TI, mt, nt, lane)); if (SQUARE) pp[tt] = mma64(PA, PB, mt, nt, lane, Z); } \
      _Pragma("unroll") for (int tt = 0; tt < 2; ++tt) { const int nt = (wv & 1) * 2 + tt; st_nm(TO, mt, nt, lane, tn[tt]); if (SQUARE) { st_mn(QA, mt, nt, lane, pp[tt]); st_nm(QB, mt, nt, lane, pp[tt]); } } \
      RW_SYNC(); } while (0)
#pragma unroll
      for (int tt = 0; tt < 2; ++tt) pp[tt] = mma64(S11, S12, mt, (wv & 1) * 2 + tt, lane, Z);
#pragma unroll
      for (int tt = 0; tt < 2; ++tt) { st_mn(S0, mt, (wv & 1) * 2 + tt, lane, pp[tt]); st_nm(S1, mt, (wv & 1) * 2 + tt, lane, pp[tt]); }
      RW_SYNC();
      R1_E_STEP(S0, S1, SA, S11, S12, S2, true);
      R1_E_STEP(S11, S12, S2, S0, S1, SA, true);
      R1_E_STEP(S0, S1, SA, S11, S12, S2, true);
      R1_E_STEP(S11, S12, S2, S0, S1, SA, true);
      R1_E_STEP(S0, S1, SA, S11, S12, S2, false);
#undef R1_E_STEP
    }
#pragma unroll
    for (int tt = 0; tt < 2; ++tt) { const int nt = (wv & 1) * 2 + tt; st_nm(S11, mt, nt, lane, mma64(S2, S4, mt, nt, lane, Z)); st_nm(S0, mt, nt, lane, mma64(S8, S5, mt, nt, lane, Z)); }
    RW_SYNC();
    { bf16* gG = o.G + (size_t)unit * 4096; bf16* gRH = o.RH + (size_t)unit * 4096;
      typedef unsigned u32x2 __attribute__((ext_vector_type(2)));
#pragma unroll
      for (int tt = 0; tt < 2; ++tt) { const int nt = (wv & 1) * 2 + tt;
          st_nm(S12, mt, nt, lane, mma64(S2, S0, mt, nt, lane, Z));
          f32x4 rh = mma64(S11, S9, mt, nt, lane, ld_nm(S3, mt, nt, lane));
          { u32x2 wv2; wv2.x = pk(rh[0], rh[1]); wv2.y = pk(rh[2], rh[3]); *(u32x2*)(gRH + (nt * 16 + r16) * 64 + mt * 16 + q4 * 4) = wv2; }
          f32x4 g = mma64(S11, S6, mt, nt, lane, Z);
#pragma unroll
          for (int e = 0; e < 4; ++e) if (mt * 16 + q4 * 4 + e == nt * 16 + r16) g[e] += gamL[nt * 16 + r16];
          { u32x2 wv2; wv2.x = pk(g[0], g[1]); wv2.y = pk(g[2], g[3]); *(u32x2*)(gG + ((nt * 2 + (mt >> 1)) * 64 + lane) * 8 + (mt & 1) * 4) = wv2; } } }
    RW_SYNC();
    { bf16* gH = o.H + (size_t)unit * 4096; bf16* gYL = o.YL + (size_t)unit * 4096;
      typedef unsigned u32x2 __attribute__((ext_vector_type(2)));
#pragma unroll
      for (int tt = 0; tt < 2; ++tt) { const int nt = (wv & 1) * 2 + tt;
          f32x4 y = mma64(S12, S9, mt, nt, lane, Z); y = mma64(S5, S10, mt, nt, lane, y);
          { u32x2 wv2; wv2.x = pk(y[0], y[1]); wv2.y = pk(y[2], y[3]); *(u32x2*)(gYL + ((mt * 4 + nt) * 64 + lane) * 4) = wv2; }
          f32x4 hh = mma64(S6, S12, mt, nt, lane, Z); hh = mma64(S7, S5, mt, nt, lane, hh);
          { u32x2 wv2; wv2.x = pk(hh[0], hh[1]); wv2.y = pk(hh[2], hh[3]); *(u32x2*)(gH + ((mt * 4 + nt) * 64 + lane) * 4) = wv2; } } }
    RW_SYNC();
}

struct ScanStage { bf16x8 g[4][2]; unsigned hx[4], hy[4]; };
__device__ __forceinline__ void scan_load(ScanStage& st, const bf16* gG, const bf16* gH, int c, int nt, int lane) {
    typedef unsigned u32x2 __attribute__((ext_vector_type(2)));
    const bf16* gn = gG + (size_t)c * 4096; const bf16* hn = gH + (size_t)c * 4096;
#pragma unroll
    for (int m = 0; m < 4; ++m) { st.g[m][0] = *(const bf16x8*)(gn + ((m * 2 + 0) * 64 + lane) * 8); st.g[m][1] = *(const bf16x8*)(gn + ((m * 2 + 1) * 64 + lane) * 8);
        const u32x2 h = *(const u32x2*)(hn + ((m * 4 + nt) * 64 + lane) * 4); st.hx[m] = h.x; st.hy[m] = h.y; }
}
__device__ __forceinline__ void scan_step(const ScanStage& st, f32x4 (&acc)[4], bf16* gH, int c, int nt, int lane) {
    typedef unsigned u32x2 __attribute__((ext_vector_type(2))); typedef unsigned u32x4v __attribute__((ext_vector_type(4)));
    f32x4 hin[4];
#pragma unroll
    for (int m = 0; m < 4; ++m) hin[m] = (f32x4){__uint_as_float(st.hx[m] << 16), __uint_as_float(st.hx[m] & 0xffff0000u), __uint_as_float(st.hy[m] << 16), __uint_as_float(st.hy[m] & 0xffff0000u)};
    u32x4v b0, b1;
    b0.x = pk(acc[0][0], acc[0][1]); b0.y = pk(acc[0][2], acc[0][3]); b0.z = pk(acc[1][0], acc[1][1]); b0.w = pk(acc[1][2], acc[1][3]);
    b1.x = pk(acc[2][0], acc[2][1]); b1.y = pk(acc[2][2], acc[2][3]); b1.z = pk(acc[3][0], acc[3][1]); b1.w = pk(acc[3][2], acc[3][3]);
    bf16* hc = gH + (size_t)c * 4096;
    *(u32x2*)(hc + ((0 * 4 + nt) * 64 + lane) * 4) = (u32x2){b0.x, b0.y}; *(u32x2*)(hc + ((1 * 4 + nt) * 64 + lane) * 4) = (u32x2){b0.z, b0.w};
    *(u32x2*)(hc + ((2 * 4 + nt) * 64 + lane) * 4) = (u32x2){b1.x, b1.y}; *(u32x2*)(hc + ((3 * 4 + nt) * 64 + lane) * 4) = (u32x2){b1.z, b1.w};
    const bf16x8 bf0 = __builtin_bit_cast(bf16x8, b0), bf1 = __builtin_bit_cast(bf16x8, b1);
#pragma unroll
    for (int m = 0; m < 4; ++m) { f32x4 a = hin[m]; a = __builtin_amdgcn_mfma_f32_16x16x32_bf16(st.g[m][0], bf0, a, 0, 0, 0); a = __builtin_amdgcn_mfma_f32_16x16x32_bf16(st.g[m][1], bf1, a, 0, 0, 0); acc[m] = a; }
}
__device__ __forceinline__ void scan_bh(int bh, int nt, int lane, const Buf& o) {
    f32x4 acc[4];
#pragma unroll
    for (int m = 0; m < 4; ++m) acc[m] = (f32x4){0.f, 0.f, 0.f, 0.f};
    const bf16* gG = o.G + (size_t)bh * 64 * 4096; bf16* gH = o.H + (size_t)bh * 64 * 4096;
    ScanStage s0, s1, s2, s3;
    scan_load(s0, gG, gH, 0, nt, lane); scan_load(s1, gG, gH, 1, nt, lane); scan_load(s2, gG, gH, 2, nt, lane); scan_load(s3, gG, gH, 3, nt, lane);
#pragma unroll 1
    for (int c = 0; c < 64; c += 4) {
        scan_step(s0, acc, gH, c, nt, lane);     if (c + 4 < 64) scan_load(s0, gG, gH, c + 4, nt, lane);
        scan_step(s1, acc, gH, c + 1, nt, lane); if (c + 5 < 64) scan_load(s1, gG, gH, c + 5, nt, lane);
        scan_step(s2, acc, gH, c + 2, nt, lane); if (c + 6 < 64) scan_load(s2, gG, gH, c + 6, nt, lane);
        scan_step(s3, acc, gH, c + 3, nt, lane); if (c + 7 < 64) scan_load(s3, gG, gH, c + 7, nt, lane);
    }
}

typedef unsigned u32x2r __attribute__((ext_vector_type(2)));
struct R3Raw { u32x2r rh[4], s[16], yl[4], pv[4], pp[4], gt[4]; float bon; f32x4 lg[4], lb[4], mu[4]; };
__device__ __forceinline__ void r3_load(R3Raw& R, int unit, int nt, int lane, const bf16* __restrict__ proj, const W& w, const Buf& o) {
    const int ch = unit & 63, bh = unit >> 6, h = bh & 3, b = bh >> 2, r16 = lane & 15, q4 = lane >> 4;
    const size_t t0 = (size_t)b * SEQ + ch * 64; const int tl = nt * 16 + r16; const size_t t = t0 + tl;
    const bf16* gS = o.H + (size_t)unit * 4096; const bf16* gRH = o.RH + (size_t)unit * 4096; const bf16* gYL = o.YL + (size_t)unit * 4096;
#pragma unroll
    for (int i = 0; i < 4; ++i) R.rh[i] = *(const u32x2r*)(gRH + tl * 64 + q4 * 4 + 16 * i);
#pragma unroll
    for (int m = 0; m < 4; ++m) {
#pragma unroll
        for (int i = 0; i < 4; ++i) R.s[m * 4 + i] = *(const u32x2r*)(gS + ((i * 4 + m) * 64 + lane) * 4);
        R.yl[m] = *(const u32x2r*)(gYL + ((m * 4 + nt) * 64 + lane) * 4); }
    R.bon = o.BON[t * 4 + h];
#pragma unroll
    for (int m = 0; m < 4; ++m) { const int hc = h * 64 + m * 16 + q4 * 4;
        R.pv[m] = *(const u32x2r*)(proj + t * NP + R0 + 512 + hc); R.pp[m] = *(const u32x2r*)(proj + ((long)t - 1) * NP + R0 + 512 + hc);
        R.gt[m] = *(const u32x2r*)(o.GATE + t * 256 + hc);
        R.lg[m] = *(const f32x4*)(w.ln_g + hc); R.lb[m] = *(const f32x4*)(w.ln_b + hc); R.mu[m] = *(const f32x4*)(w.mu + 512 + hc); }
}
__device__ __forceinline__ void r3_compute(const R3Raw& R, int unit, int nt, int lane, bf16* __restrict__ mix, int pitch, int coloff) {
    const int ch = unit & 63, bh = unit >> 6, h = bh & 3, b = bh >> 2, r16 = lane & 15, q4 = lane >> 4;
    const size_t t0 = (size_t)b * SEQ + ch * 64; const int tl = nt * 16 + r16; const size_t t = t0 + tl;
    typedef unsigned u32x4v __attribute__((ext_vector_type(4)));
    const bf16x8 bq0 = __builtin_bit_cast(bf16x8, ((u32x4v){R.rh[0].x, R.rh[0].y, R.rh[1].x, R.rh[1].y})), bq1 = __builtin_bit_cast(bf16x8, ((u32x4v){R.rh[2].x, R.rh[2].y, R.rh[3].x, R.rh[3].y}));
    f32x4 y[4];
#pragma unroll
    for (int m = 0; m < 4; ++m) {
        const u32x2r s0 = R.s[m * 4 + 0], s1 = R.s[m * 4 + 1], s2 = R.s[m * 4 + 2], s3 = R.s[m * 4 + 3];
        const bf16x8 a0 = __builtin_bit_cast(bf16x8, ((u32x4v){s0.x, s0.y, s1.x, s1.y})), a1 = __builtin_bit_cast(bf16x8, ((u32x4v){s2.x, s2.y, s3.x, s3.y}));
        const u32x2r yl = R.yl[m];
        f32x4 a = {__uint_as_float(yl.x << 16), __uint_as_float(yl.x & 0xffff0000u), __uint_as_float(yl.y << 16), __uint_as_float(yl.y & 0xffff0000u)};
        a = __builtin_amdgcn_mfma_f32_16x16x32_bf16(a0, bq0, a, 0, 0, 0); a = __builtin_amdgcn_mfma_f32_16x16x32_bf16(a1, bq1, a, 0, 0, 0); y[m] = a; }
    float s = 0.f;
#pragma unroll
    for (int m = 0; m < 4; ++m) s += (y[m][0] + y[m][1]) + (y[m][2] + y[m][3]);
    s = sum_q4(s);
    const float mean = s * (1.f / 64.f); float v2 = 0.f;
#pragma unroll
    for (int m = 0; m < 4; ++m)
#pragma unroll
        for (int e = 0; e < 4; ++e) { const float d = y[m][e] - mean; v2 += d * d; }
    v2 = sum_q4(v2);
    const float rstd = rsqrtf(v2 * (1.f / 64.f) + 64e-5f);
    const float bon = R.bon;
    const bool first = (ch == 0 && tl == 0);
#pragma unroll
    for (int m = 0; m < 4; ++m) { const int i0 = m * 16 + q4 * 4, hc = h * 64 + i0;
        const u32x2r pv = R.pv[m]; u32x2r pp = R.pp[m]; if (first) { pp.x = 0u; pp.y = 0u; }
        const u32x2r gt = R.gt[m];
        const f32x4 lg = R.lg[m], lb = R.lb[m], mu = R.mu[m];
        const float xv[4] = {__uint_as_float(pv.x << 16), __uint_as_float(pv.x & 0xffff0000u), __uint_as_float(pv.y << 16), __uint_as_float(pv.y & 0xffff0000u)};
        const float xp[4] = {__uint_as_float(pp.x << 16), __uint_as_float(pp.x & 0xffff0000u), __uint_as_float(pp.y << 16), __uint_as_float(pp.y & 0xffff0000u)};
        const float gg[4] = {__uint_as_float(gt.x << 16), __uint_as_float(gt.x & 0xffff0000u), __uint_as_float(gt.y << 16), __uint_as_float(gt.y & 0xffff0000u)};
        float ov[4];
#pragma unroll
        for (int e = 0; e < 4; ++e) { const float v = xv[e] + (xp[e] - xv[e]) * mu[e]; ov[e] = ((y[m][e] - mean) * rstd * lg[e] + lb[e] + bon * v) * gg[e]; }
        u32x2r wv2; wv2.x = pk(ov[0], ov[1]); wv2.y = pk(ov[2], ov[3]); *(u32x2r*)(mix + t * pitch + coloff + hc) = wv2; }
}
struct R3Ctx { const bf16* proj; const W* w; const Buf* o; bf16* mix;
    __device__ __forceinline__ void load(R3Raw& R, int unit, int nt, int lane) const { r3_load(R, unit, nt, lane, proj, *w, *o); }
    __device__ __forceinline__ void run(const R3Raw& R, int unit, int nt, int lane) const { r3_compute(R, unit, nt, lane, mix, DM, 256); } };
#undef RW_SYNC
}
namespace ml {
using rw::lds_u8; using rw::lds_bf; using rw::lds_f32; using rw::TS; using rw::TILE_B; using rw::slot; using rw::pk; using rw::mma64; using rw::st_nm;
__device__ __forceinline__ float wave_incl_sum(float v, int) { return wave_scan_sum(v); }
__device__ __forceinline__ float wave_incl_max(float v, int) { return wave_scan_max(v); }
__device__ __forceinline__ void conv8(const bf16* __restrict__ proj, size_t trow, int s0, int col, const float* __restrict__ cw, const float* __restrict__ cb, float scale, float* out) {
    const float w0 = cw[col], w1 = cw[512 + col], w2 = cw[1024 + col], w3 = cw[1536 + col], bb = cb[col];
    const bf16* p = proj + trow * NP + MB0 + col;
    float x0 = s0 >= 3 ? bf2f(p[-3 * (long)NP]) : 0.f, x1 = s0 >= 2 ? bf2f(p[-2 * (long)NP]) : 0.f, x2 = s0 >= 1 ? bf2f(p[-(long)NP]) : 0.f;
#pragma unroll
    for (int i = 0; i < 8; ++i) { const float x3 = bf2f(p[(size_t)i * NP]); const float y = bb + w0 * x0 + w1 * x1 + w2 * x2 + w3 * x3; out[i] = y * sigmoidf_(y) * scale; x0 = x1; x1 = x2; x2 = x3; }
}
__device__ __forceinline__ void m1_gates(lds_u8* lds, int unit, int lane, float igv, float fgv, const Buf& o) {
    lds_f32* wkp = (lds_f32*)(lds + rw::MISC_OFF + 2304);
    const float ig = igv, lf = -softplus_fast(-fgv);
    const float bt = wave_incl_sum(lf, lane), bL = __int_as_float(__builtin_amdgcn_readlane(__float_as_int(bt), 63));
    const float ge = bL - bt + ig, gmax = wave_max(ge);
    wkp[lane] = __expf(ge - gmax);
    if (lane == 0) { o.SC[(size_t)unit * 4 + 0] = bL; o.SC[(size_t)unit * 4 + 1] = gmax; }
}
__device__ __forceinline__ void m1_tiles(lds_u8* lds, int lane, int wv, const float (&xk)[11], const float (&cwv)[5], const float (&vv)[8], int s0) {
    lds_bf* Kw = slot(lds, 13); lds_bf* Vt = slot(lds, 14); lds_f32* wkp = (lds_f32*)(lds + rw::MISC_OFF + 2304); lds_f32* part = wkp + 64;
    const int c = lane, tg = wv; float kc[8];
    { float x0 = s0 >= 3 ? xk[0] : 0.f, x1 = s0 >= 2 ? xk[1] : 0.f, x2 = s0 >= 1 ? xk[2] : 0.f;
#pragma unroll
      for (int i = 0; i < 8; ++i) { const float x3 = xk[3 + i]; const float y = cwv[4] + cwv[0] * x0 + cwv[1] * x1 + cwv[2] * x2 + cwv[3] * x3; kc[i] = y * sigmoidf_(y) * 0.125f; x0 = x1; x1 = x2; x2 = x3; } }
    typedef unsigned u32x4v __attribute__((ext_vector_type(4)));
    float kw[8], dn = 0.f;
#pragma unroll
    for (int i = 0; i < 8; ++i) { const float wk = wkp[tg * 8 + i]; kw[i] = kc[i] * wk; dn += kw[i]; }
    u32x4v x; x.x = pk(kw[0], kw[1]); x.y = pk(kw[2], kw[3]); x.z = pk(kw[4], kw[5]); x.w = pk(kw[6], kw[7]); *(__attribute__((address_space(3))) u32x4v*)(Kw + c * TS + tg * 8) = x;
    x.x = pk(vv[0], vv[1]); x.y = pk(vv[2], vv[3]); x.z = pk(vv[4], vv[5]); x.w = pk(vv[6], vv[7]); *(__attribute__((address_space(3))) u32x4v*)(Vt + c * TS + tg * 8) = x;
    part[tg * 64 + c] = dn;
}
__device__ __forceinline__ void m1_product(lds_u8* lds, int unit, int lane, int wv, const Buf& o) {
    lds_bf* Kw = slot(lds, 13); lds_bf* Vt = slot(lds, 14); lds_f32* part = (lds_f32*)(lds + rw::MISC_OFF + 2304) + 64;
    const f32x4 Z = {0.f, 0.f, 0.f, 0.f}; const int mt = wv >> 1; bf16* gC = o.C + (size_t)unit * 4096;
    typedef unsigned u32x2 __attribute__((ext_vector_type(2)));
#pragma unroll
    for (int tt = 0; tt < 2; ++tt) { const int nt = (wv & 1) * 2 + tt; const f32x4 a = mma64(Kw, Vt, mt, nt, lane, Z);
        u32x2 w2; w2.x = pk(a[0], a[1]); w2.y = pk(a[2], a[3]); *(u32x2*)(gC + (nt * 16 + (lane & 15)) * 64 + mt * 16 + (lane >> 4) * 4) = w2; }
    if (wv == 0) { float s = 0.f;
#pragma unroll
        for (int g = 0; g < 8; ++g) s += part[g * 64 + lane];
        o.N[(size_t)unit * 64 + lane] = s; }
}
struct ScanStage { unsigned d[8]; float dn, bL, gmax; };
__device__ __forceinline__ void scan_load(ScanStage& st, const bf16* gc, const Buf& o, size_t u, int c, int lane) {
    typedef unsigned u32x4v __attribute__((ext_vector_type(4)));
    const bf16* cn = gc + (size_t)c * 4096; const u32x4v d0 = *(const u32x4v*)cn, d1 = *(const u32x4v*)(cn + 8);
    st.d[0] = d0.x; st.d[1] = d0.y; st.d[2] = d0.z; st.d[3] = d0.w; st.d[4] = d1.x; st.d[5] = d1.y; st.d[6] = d1.z; st.d[7] = d1.w;
    st.dn = o.N[(u + c) * 64 + lane]; st.bL = o.SC[(u + c) * 4]; st.gmax = o.SC[(u + c) * 4 + 1];
}
__device__ __forceinline__ void scan_step(const ScanStage& st, float (&C)[16], float& n, float& m, bf16* gc, const Buf& o, size_t u, int c, int w, int lane) {
    typedef unsigned u32x4v __attribute__((ext_vector_type(4)));
    float dC[16];
#pragma unroll
    for (int i = 0; i < 8; ++i) { dC[2 * i] = __uint_as_float(st.d[i] << 16); dC[2 * i + 1] = __uint_as_float(st.d[i] & 0xffff0000u); }
    const float dnc = st.dn, bLc = st.bL, gmc = st.gmax;
    bf16* cc = gc + (size_t)c * 4096;
    u32x4v s0, s1; s0.x = pk(C[0], C[1]); s0.y = pk(C[2], C[3]); s0.z = pk(C[4], C[5]); s0.w = pk(C[6], C[7]); s1.x = pk(C[8], C[9]); s1.y = pk(C[10], C[11]); s1.z = pk(C[12], C[13]); s1.w = pk(C[14], C[15]);
    const float mn = fmaxf(bLc + m, gmc), cs = __expf(bLc + m - mn), ee = __expf(gmc - mn);
    float keep = dC[0] + dnc; asm volatile("" : "+v"(keep));
    *(u32x4v*)cc = s0; *(u32x4v*)(cc + 8) = s1;
    if (w == 0) { o.N[(u + c) * 64 + lane] = n; if (lane == 0) o.SC[(u + c) * 4 + 2] = m; }
    m = mn;
#pragma unroll
    for (int i = 0; i < 16; ++i) C[i] = cs * C[i] + ee * dC[i];
    n = cs * n + ee * dnc;
}
__device__ __forceinline__ void scan_bh(int bh, int w, int lane, const Buf& o) {
    float C[16]; float n = 0.f, m = 0.f;
#pragma unroll
    for (int i = 0; i < 16; ++i) C[i] = 0.f;
    const size_t u0 = (size_t)bh * 64;
    bf16* gc = o.C + u0 * 4096 + (w * 16 + (lane >> 2)) * 64 + (lane & 3) * 16;
    ScanStage s0, s1, s2, s3;
    scan_load(s0, gc, o, u0, 0, lane); scan_load(s1, gc, o, u0, 1, lane); scan_load(s2, gc, o, u0, 2, lane); scan_load(s3, gc, o, u0, 3, lane);
#pragma unroll 1
    for (int c = 0; c < 64; c += 4) {
        scan_step(s0, C, n, m, gc, o, u0, c, w, lane);     if (c + 4 < 64) scan_load(s0, gc, o, u0, c + 4, lane);
        scan_step(s1, C, n, m, gc, o, u0, c + 1, w, lane); if (c + 5 < 64) scan_load(s1, gc, o, u0, c + 5, lane);
        scan_step(s2, C, n, m, gc, o, u0, c + 2, w, lane); if (c + 6 < 64) scan_load(s2, gc, o, u0, c + 6, lane);
        scan_step(s3, C, n, m, gc, o, u0, c + 3, w, lane); if (c + 7 < 64) scan_load(s3, gc, o, u0, c + 7, lane);
    }
}
template <class R3F> __device__ __forceinline__ void m3_unit(lds_u8* lds, int unit, const bf16* __restrict__ proj, const P& p, const Buf& o, bf16* __restrict__ mix, const R3F& r3) {
    int tid_ = threadIdx.x; asm volatile("" : "+v"(tid_));
    const int tid = tid_, lane = tid & 63, wv = __builtin_amdgcn_readfirstlane(tid >> 6), r16 = lane & 15, q4 = lane >> 4;
    const int ch = unit & 63, bh = unit >> 6, h = bh & 3, b = bh >> 2;
    const size_t t0 = (size_t)b * SEQ + ch * 64;
    lds_bf* Qt = slot(lds, 0); lds_bf* Kt = slot(lds, 1); lds_bf* Vt = slot(lds, 2); lds_bf* Cp = slot(lds, 3); lds_bf* Pt = slot(lds, 4);
    lds_f32* abt = (lds_f32*)(lds + 5 * TILE_B); lds_f32* aat = abt + 64; lds_f32* amt = aat + 64; lds_f32* aiw = amt + 64; lds_f32* aem = aiw + 64; lds_f32* anp = aem + 64;
    typedef unsigned u32x4v __attribute__((ext_vector_type(4))); typedef unsigned u32x2 __attribute__((ext_vector_type(2)));
    const int hcl = h * 64 + lane;
    bf16 rq[11], rk[11], rv[8]; float cq[5], ck[5];
    { const bf16* pq = proj + (t0 + wv * 8) * NP + MQ + hcl; const bf16* pk_ = proj + (t0 + wv * 8) * NP + MK + hcl; const bf16* pv = proj + (t0 + wv * 8) * NP + MV + hcl;
#pragma unroll
      for (int i = 0; i < 11; ++i) { rq[i] = pq[((long)i - 3) * NP]; rk[i] = pk_[((long)i - 3) * NP]; }
#pragma unroll
      for (int i = 0; i < 8; ++i) rv[i] = pv[(size_t)i * NP];
#pragma unroll
      for (int i = 0; i < 4; ++i) { cq[i] = p.cw[i * 512 + hcl]; ck[i] = p.cw[i * 512 + 256 + hcl]; }
      cq[4] = p.cb[hcl]; ck[4] = p.cb[256 + hcl]; }
    const int ce = tid >> 3, cd8 = (tid & 7) * 8;
    const u32x4v cprev = *(const u32x4v*)(o.C + (size_t)unit * 4096 + ce * 64 + cd8);
    float igv = 0.f, fgv = 0.f, mprev = 0.f, npv = 0.f;
    if (wv == 0) { const bf16* pr = proj + (t0 + lane) * NP; const bf16 gi = pr[MI + h], gf = pr[MF + h]; const float bi = p.b_i[h], bf_ = p.b_f[h];
        mprev = o.SC[(size_t)unit * 4 + 2]; npv = o.N[(size_t)unit * 64 + lane]; igv = bf2f(gi) + bi; fgv = bf2f(gf) + bf_; }
    u32x2 ovr[4]; f32x4 ng[4]; rw::R3Raw R3;
    if (wv < 4) { const size_t tr = t0 + wv * 16 + r16;
#pragma unroll
        for (int m = 0; m < 4; ++m) { const int hc = h * 64 + m * 16 + q4 * 4; ovr[m] = *(const u32x2*)(proj + tr * NP + MO + hc); ng[m] = *(const f32x4*)(p.norm_g + hc); } }
    else r3.load(R3, unit, wv - 4, lane);
    if (wv == 0) {
        const float ig = igv, lf = -softplus_fast(-fgv);
        const float bt = wave_incl_sum(lf, lane), at = ig - bt, cm = wave_incl_max(at, lane);
        const float mt = fmaxf(bt + mprev, bt + cm);
        abt[lane] = bt; aat[lane] = at; amt[lane] = mt; aiw[lane] = __expf(bt + mprev - mt); aem[lane] = __expf(-mt); anp[lane] = npv;
    }
    { const int c = lane, tg = wv; float qc[8], kc[8]; const int s0 = ch * 64 + tg * 8;
      { float x0 = s0 >= 3 ? bf2f(rq[0]) : 0.f, x1 = s0 >= 2 ? bf2f(rq[1]) : 0.f, x2 = s0 >= 1 ? bf2f(rq[2]) : 0.f;
#pragma unroll
        for (int i = 0; i < 8; ++i) { const float x3 = bf2f(rq[3 + i]); const float y = cq[4] + cq[0] * x0 + cq[1] * x1 + cq[2] * x2 + cq[3] * x3; qc[i] = y * sigmoidf_(y); x0 = x1; x1 = x2; x2 = x3; } }
      { float x0 = s0 >= 3 ? bf2f(rk[0]) : 0.f, x1 = s0 >= 2 ? bf2f(rk[1]) : 0.f, x2 = s0 >= 1 ? bf2f(rk[2]) : 0.f;
#pragma unroll
        for (int i = 0; i < 8; ++i) { const float x3 = bf2f(rk[3 + i]); const float y = ck[4] + ck[0] * x0 + ck[1] * x1 + ck[2] * x2 + ck[3] * x3; kc[i] = y * sigmoidf_(y) * 0.125f; x0 = x1; x1 = x2; x2 = x3; } }
      float vv[8];
#pragma unroll
      for (int i = 0; i < 8; ++i) { const int t = tg * 8 + i; { const unsigned wqk = pk(qc[i], kc[i]); Qt[t * TS + c] = (unsigned short)wqk; Kt[t * TS + c] = (unsigned short)(wqk >> 16); } vv[i] = bf2f(rv[i]); }
      u32x4v x; x.x = pk(vv[0], vv[1]); x.y = pk(vv[2], vv[3]); x.z = pk(vv[4], vv[5]); x.w = pk(vv[6], vv[7]); *(__attribute__((address_space(3))) u32x4v*)(Vt + c * TS + tg * 8) = x;
      *(__attribute__((address_space(3))) u32x4v*)(Cp + ce * TS + cd8) = cprev; }
    asm volatile("s_waitcnt lgkmcnt(0)\n\ts_barrier" ::: "memory");
    { const f32x4 Z = {0.f, 0.f, 0.f, 0.f}; const int mt = wv >> 1;
#pragma unroll
      for (int tt = 0; tt < 2; ++tt) { const int nt = (wv & 1) * 2 + tt; f32x4 sT = mma64(Kt, Qt, mt, nt, lane, Z);
          const int t = nt * 16 + r16; const float bm = abt[t] - amt[t];
#pragma unroll
          for (int e = 0; e < 4; ++e) { const int s = mt * 16 + q4 * 4 + e; sT[e] = (s <= t) ? sT[e] * __expf(bm + aat[s]) : 0.f; }
          st_nm(Pt, mt, nt, lane, sT); } }
    asm volatile("s_waitcnt lgkmcnt(0)\n\ts_barrier" ::: "memory");
    if (wv < 4) { const int nt = wv, t = nt * 16 + r16; const f32x4 Z = {0.f, 0.f, 0.f, 0.f};
        const float iw = aiw[t];
        f32x4 num[4];
#pragma unroll
        for (int m = 0; m < 4; ++m) { f32x4 a = mma64(Cp, Qt, m, nt, lane, Z); a = a * iw; num[m] = mma64(Vt, Pt, m, nt, lane, a); }
        float qn = 0.f, ps = 0.f;
#pragma unroll
        for (int i = 0; i < 16; ++i) { const int d = q4 * 16 + i; qn += anp[d] * bf2f(Qt[t * TS + d]); ps += bf2f(Pt[t * TS + d]); }
        qn = sum_q4(qn); ps = sum_q4(ps);
        const float den = iw * qn + ps, rden = 1.f / fmaxf(fabsf(den), aem[t]);
        float ss = 0.f;
#pragma unroll
        for (int m = 0; m < 4; ++m) { num[m] = num[m] * rden; ss += (num[m][0] * num[m][0] + num[m][1] * num[m][1]) + (num[m][2] * num[m][2] + num[m][3] * num[m][3]); }
        ss = sum_q4(ss);
        const float rstd = rsqrtf(ss * (1.f / 64.f) + 1e-6f);
        const size_t tr = t0 + t;
#pragma unroll
        for (int m = 0; m < 4; ++m) { const int hc = h * 64 + m * 16 + q4 * 4;
            const u32x2 ov = ovr[m]; const f32x4 g = ng[m];
            const float o0 = sigmoidf_(__uint_as_float(ov.x << 16)), o1 = sigmoidf_(__uint_as_float(ov.x & 0xffff0000u)), o2 = sigmoidf_(__uint_as_float(ov.y << 16)), o3 = sigmoidf_(__uint_as_float(ov.y & 0xffff0000u));
            u32x2 w2; w2.x = pk(num[m][0] * rstd * g[0] * o0, num[m][1] * rstd * g[1] * o1); w2.y = pk(num[m][2] * rstd * g[2] * o2, num[m][3] * rstd * g[3] * o3);
            *(u32x2*)(mix + tr * DM + hc) = w2; } }
    else r3.run(R3, unit, wv - 4, lane);
    asm volatile("s_waitcnt lgkmcnt(0)\n\ts_barrier" ::: "memory");
}
}
namespace cg = cooperative_groups;
#define LAS __attribute__((address_space(3)))
#define GASQ __attribute__((address_space(1)))
struct Params { const GASQ float* in[29]; GASQ float* out; GASQ unsigned char* ws; };
struct Ctx { int tid, lane, wave, gw, ngw; unsigned char* lds; };

template <bool GAIN, bool PERM> __device__ __forceinline__ void wt_load(float (&v)[16], int tl, int tn, int t, const float* __restrict__ W, int N, const float* __restrict__ gain, int slo, int shi, float sc) {
    const int n0 = (tl % tn) * 64, k0 = (tl / tn) * 64;
    const int n = n0 + (t & 63); const int ns = PERM ? proj_src_col(n) : (n < N ? n : -1); const int nsc = ns < 0 ? 0 : ns;
    const float* src = W + (size_t)(k0 + (t >> 6)) * N + nsc;
#pragma unroll
    for (int j = 0; j < 16; ++j) v[j] = src[(size_t)(4 * j) * N];
    if (GAIN) {
#pragma unroll
        for (int j = 0; j < 16; ++j) v[j] *= gain[k0 + (t >> 6) + 4 * j]; }
    const float m = ns < 0 ? 0.f : ((n >= slo && n < shi) ? sc : 1.f);
#pragma unroll
    for (int j = 0; j < 16; ++j) v[j] *= m;
}
template <bool GAIN, bool PERM> __device__ __forceinline__ void ph_wt(const Ctx& c, const float* __restrict__ W, int K, int N, int Npad, bf16* __restrict__ Bt, const float* __restrict__ gain, int slo, int shi, float sc, int b0 = 0) {
    if ((int)blockIdx.x < b0) return;
    const int half = c.tid >> 8, t = c.tid & 255;
    LAS float* tile = (LAS float*)((LAS unsigned char*)c.lds + half * 16640);
    const int tn = Npad / 64, ntile = tn * (K / 64), stride = ((int)gridDim.x - b0) * 2;
    int it = ((int)blockIdx.x - b0) * 2;
    float v[16];
    if (it < ntile) wt_load<GAIN, PERM>(v, it + half, tn, t, W, N, gain, slo, shi, sc);
    while (it < ntile) {
        const int tl = it + half; const int n0 = (tl % tn) * 64, k0 = (tl / tn) * 64;
#pragma unroll
        for (int j = 0; j < 16; ++j) tile[((t >> 6) + 4 * j) * 65 + (t & 63)] = v[j];
        it += stride;
        if (it < ntile) wt_load<GAIN, PERM>(v, it + half, tn, t, W, N, gain, slo, shi, sc);
        asm volatile("s_waitcnt lgkmcnt(0)\n\ts_barrier" ::: "memory");
#pragma unroll
        for (int p = 0; p < 2; ++p) { const int n = p * 32 + (t >> 3), ks = (t & 7) * 8; const LAS float* s = tile + ks * 65 + n;
            u32x4 o; o.x = f2bf(s[0]) | (f2bf(s[65]) << 16); o.y = f2bf(s[2 * 65]) | (f2bf(s[3 * 65]) << 16); o.z = f2bf(s[4 * 65]) | (f2bf(s[5 * 65]) << 16); o.w = f2bf(s[6 * 65]) | (f2bf(s[7 * 65]) << 16);
            *(u32x4*)(Bt + (size_t)(n0 + n) * K + k0 + ks) = o; }
        asm volatile("s_waitcnt lgkmcnt(0)\n\ts_barrier" ::: "memory");
    }
}
__device__ __forceinline__ void ph_x2bf(const Ctx& c, const float* __restrict__ x, bf16* __restrict__ xb, unsigned long long* __restrict__ ssq) {
    for (int row = c.gw; row < T; row += 4 * c.ngw) {
        f32x4 v[4][4]; float s[4];
#pragma unroll
        for (int k = 0; k < 4; ++k) { const f32x4* xr = (const f32x4*)(x + (size_t)(row + k * c.ngw) * DM) + c.lane;
#pragma unroll
            for (int j = 0; j < 4; ++j) v[k][j] = xr[64 * j]; }
#pragma unroll
        for (int k = 0; k < 4; ++k) { s[k] = 0.f;
#pragma unroll
            for (int j = 0; j < 4; ++j) s[k] += (v[k][j].x * v[k][j].x + v[k][j].y * v[k][j].y) + (v[k][j].z * v[k][j].z + v[k][j].w * v[k][j].w);
            s[k] = wave_sum(s[k]); if (c.lane < 5) ssq[(size_t)c.lane * 32768 + row + k * c.ngw] = c.lane == 0 ? pg8::ssq_fix(s[k]) : 0ull;
            unsigned long long* o8 = (unsigned long long*)(xb + (size_t)(row + k * c.ngw) * DM) + c.lane;
#pragma unroll
            for (int j = 0; j < 4; ++j) o8[64 * j] = (unsigned long long)(f2bf(v[k][j].x) | (f2bf(v[k][j].y) << 16)) | ((unsigned long long)(f2bf(v[k][j].z) | (f2bf(v[k][j].w) << 16)) << 32); }
    }
}
__device__ __forceinline__ void ph_final_norm(const Ctx& c, float* __restrict__ out, const float* __restrict__ g, const bf16* __restrict__ xb, const unsigned long long* __restrict__ ssq) {
    typedef unsigned u32x2_t __attribute__((ext_vector_type(2)));
    const f32x4* gr = (const f32x4*)g + c.lane; f32x4 gv[4];
#pragma unroll
    for (int j = 0; j < 4; ++j) gv[j] = gr[64 * j];
    for (int row = c.gw; row < T; row += 4 * c.ngw) {
        u32x2_t v[4][4]; unsigned long long q[4];
#pragma unroll
        for (int k = 0; k < 4; ++k) { const u32x2_t* xr = (const u32x2_t*)(xb + (size_t)(row + k * c.ngw) * DM) + c.lane;
#pragma unroll
            for (int j = 0; j < 4; ++j) v[k][j] = xr[64 * j];
            q[k] = ssq[row + k * c.ngw]; }
#pragma unroll
        for (int k = 0; k < 4; ++k) { const float rstd = rsqrtf(pg8::ssq_val(q[k]) * (1.f / DM) + 1e-6f);
            f32x4* xo = (f32x4*)(out + (size_t)(row + k * c.ngw) * DM) + c.lane;
#pragma unroll
            for (int j = 0; j < 4; ++j) { f32x4 t; t.x = __uint_as_float(v[k][j].x << 16); t.y = __uint_as_float(v[k][j].x & 0xffff0000u); t.z = __uint_as_float(v[k][j].y << 16); t.w = __uint_as_float(v[k][j].y & 0xffff0000u);
                xo[64 * j] = t * rstd * gv[j]; } }
    }
}
__device__ __forceinline__ void ph_attn_combine(const Ctx& c, const bf16* __restrict__ ot, bf16* __restrict__ mix, const float* lq1, const float* lk1, const float* lq2, const float* lk2,
                                                const float* __restrict__ norm_g, float lam_init) {
    const int lane = c.lane;
    const float lam = __expf(wave_sum(lq1[lane] * lk1[lane])) - __expf(wave_sum(lq2[lane] * lk2[lane])) + lam_init;
    for (int u0 = c.gw; u0 < T * 4; u0 += 4 * c.ngw) {
        unsigned a[4], b[4];
#pragma unroll
        for (int k = 0; k < 4; ++k) { const int u = u0 + k * c.ngw; const int h = u & 3, t = u >> 2;
            const unsigned* p0 = (const unsigned*)(ot + (size_t)t * 1024 + h * 256); a[k] = p0[lane]; b[k] = p0[64 + lane]; }
#pragma unroll
        for (int k = 0; k < 4; ++k) { const int u = u0 + k * c.ngw; const int h = u & 3, t = u >> 2;
            const float o0 = __uint_as_float(a[k] << 16) - lam * __uint_as_float(b[k] << 16), o1 = __uint_as_float(a[k] & 0xffff0000u) - lam * __uint_as_float(b[k] & 0xffff0000u);
            const float r = rsqrtf(wave_sum(o0 * o0 + o1 * o1) * (1.f / 128.f) + 1e-5f) * (1.f - lam_init);
            const float g0 = norm_g[h * 128 + 2 * lane], g1 = norm_g[h * 128 + 2 * lane + 1];
            ((unsigned*)(mix + (size_t)t * DM + 512 + h * 128))[lane] = f2bf(o0 * r * g0) | (f2bf(o1 * r * g1) << 16); }
    }
}
template <class Epi> __device__ __forceinline__ void ph_gemm(const Ctx& c, const bf16* A, const bf16* Bt, int N, int K, const Epi& E) {
    asm volatile("" : "+s"(N), "+s"(K));
    pg8::Gemm g{A, Bt, T, N, K, 0};
    pg8::StaticOrder S; S.init(T, N, (int)gridDim.x, (int)blockIdx.x);
    pg8::gemm_phase<Epi, pg8::StaticOrder, true, true>((PG8_LAS unsigned char*)c.lds, g, S, E);
}

#define GSYNC() xcd_barrier(xbar)
#define GSYNC_CG() do { asm volatile("s_waitcnt vmcnt(0)" ::: "memory"); grid.sync(); } while (0)
#define FRESH() asm volatile("" : "+s"(kp) :: "memory"); Ctx c; { int t_ = threadIdx.x; asm volatile("" : "+v"(t_)); c.tid = t_; c.lane = t_ & 63; c.wave = __builtin_amdgcn_readfirstlane(t_ >> 6); c.gw = blockIdx.x * 8 + c.wave; c.ngw = gridDim.x * 8; c.lds = lds; }
#define IN(i) ((const float*)(kp->in[i]))
#define WSP(off) ((unsigned char*)(kp->ws + (off)))
#define OUTP ((float*)(kp->out))
#define SSQ(i) ((unsigned long long*)WSP(WS_SSQ + (size_t)(i) * 262144))
#define XBp ((bf16*)WSP(WS_XB))
#define OTp ((bf16*)WSP(WS_XB))
#define MIXp ((bf16*)WSP(WS_MIX))
#define PROJp ((bf16*)WSP(WS_PROJ))
#define HIDp ((bf16*)WSP(WS_HID))
#define SCRp ((float*)WSP(WS_SCR))

template <int l> __device__ __forceinline__ void layer_body(const Params*& kp, unsigned char* lds, cg::grid_group& grid, const XcdBarrier& xbar) {
        const float lam_init = 0.8f - 0.6f * __expf(-0.3f * (float)l);
        { FRESH(); ph_gemm(c, XBp, (bf16*)WSP(WS_WIN) + (size_t)l * NP * DM, NP, DM, pg8::EpiBf16S<0>{PROJp, SSQ(2 * l), NP, 0}); }
        GSYNC();
        {
            { FRESH(); (void)c; rw::W w{IN(8) + l * 896, IN(9) + l * 256, IN(10) + l * 32 * 256, IN(11) + l * 256, IN(12) + l * 32 * 256, IN(13) + l * 64 * 256, IN(14) + l * 256, IN(15) + l * 256, IN(16) + l * 256, IN(17) + l * 256, IN(18) + l * 256};
              rw::Buf o{(bf16*)WSP(WS_RWG), (bf16*)WSP(WS_RWH), (bf16*)WSP(WS_RWRH), (bf16*)WSP(WS_RWYL), (bf16*)WSP(WS_GATE), (float*)WSP(WS_BON)};
              ml::P mp{IN(3) + l * 4 * 512, IN(4) + l * 512, IN(5) + l * 4, IN(6) + l * 4, IN(7) + l * 256}; ml::Buf mo{(bf16*)WSP(WS_MLC), (float*)WSP(WS_MLN), (float*)WSP(WS_MLS)};
              const bool hfix = ((int)gridDim.x & 255) == 0;
              rw::R1W wts; rw::r1_load_w(wts, ((int)blockIdx.x >> 6) & 3, w, mp);
              for (int unit = blockIdx.x; unit < 2048; unit += gridDim.x) { if (!hfix) rw::r1_load_w(wts, (unit >> 6) & 3, w, mp); rw::r1_unit((rw::lds_u8*)lds, unit, wts, PROJp, w, o, mp, mo); } }
            GSYNC();
            { FRESH(); rw::Buf o{(bf16*)WSP(WS_RWG), (bf16*)WSP(WS_RWH), (bf16*)WSP(WS_RWRH), (bf16*)WSP(WS_RWYL), (bf16*)WSP(WS_GATE), (float*)WSP(WS_BON)};
              if (blockIdx.x < 32 && c.wave < 4) rw::scan_bh((int)blockIdx.x, c.wave, c.lane, o);
              ml::Buf mo{(bf16*)WSP(WS_MLC), (float*)WSP(WS_MLN), (float*)WSP(WS_MLS)};
              if (blockIdx.x >= 32 && blockIdx.x < 64 && c.wave < 4) ml::scan_bh((int)blockIdx.x - 32, c.wave, c.lane, mo); }
            __syncthreads();
        { FRESH(); const float lam = __expf(wave_sum(IN(19)[l * 64 + c.lane] * IN(20)[l * 64 + c.lane])) - __expf(wave_sum(IN(21)[l * 64 + c.lane] * IN(22)[l * 64 + c.lane])) + lam_init;
          attn_body::attn_phase<8>((char*)lds, (const attn_body::bf16*)PROJp, (unsigned short*)MIXp, AQ, AK, AV, lam, 1.f - lam_init, IN(23) + l * 512, attn_body::StaticOrder((int)gridDim.x, (int)blockIdx.x)); }
            __syncthreads();
            {
                { FRESH(); ph_wt<false, false>(c, IN(24) + (size_t)l * DM * DM, DM, DM, DM, (bf16*)WSP(WS_WOUT) + (size_t)l * DM * DM, nullptr, 0, 0, 1.f); }
                { FRESH(); ph_wt<true, false>(c, IN(26) + (size_t)l * DM * FF, DM, FF, FF, (bf16*)WSP(WS_WUP) + (size_t)l * FF * DM, IN(25) + l * DM, 0, 0, 1.f); }
                { FRESH(); ph_wt<false, false>(c, IN(27) + (size_t)l * FF * DM, FF, DM, DM, (bf16*)WSP(WS_WDN) + (size_t)l * DM * FF, nullptr, 0, 0, 1.f); }
                if (l + 1 < DEPTH) { FRESH(); ph_wt<true, true>(c, IN(2) + (size_t)(l + 1) * DM * NREAL, DM, NREAL, NP, (bf16*)WSP(WS_WIN) + (size_t)(l + 1) * NP * DM, IN(1) + (l + 1) * DM, AQ, AK, C2); }
            }
            GSYNC();
            { FRESH(); (void)c; rw::W w{IN(8) + l * 896, IN(9) + l * 256, IN(10) + l * 32 * 256, IN(11) + l * 256, IN(12) + l * 32 * 256, IN(13) + l * 64 * 256, IN(14) + l * 256, IN(15) + l * 256, IN(16) + l * 256, IN(17) + l * 256, IN(18) + l * 256};
              rw::Buf ro{(bf16*)WSP(WS_RWG), (bf16*)WSP(WS_RWH), (bf16*)WSP(WS_RWRH), (bf16*)WSP(WS_RWYL), (bf16*)WSP(WS_GATE), (float*)WSP(WS_BON)};
              ml::P p{IN(3) + l * 4 * 512, IN(4) + l * 512, IN(5) + l * 4, IN(6) + l * 4, IN(7) + l * 256}; ml::Buf o{(bf16*)WSP(WS_MLC), (float*)WSP(WS_MLN), (float*)WSP(WS_MLS)};
              const bf16* projp = PROJp; bf16* mixp = MIXp;
              const rw::R3Ctx r3{projp, &w, &ro, mixp};
              for (int unit = blockIdx.x; unit < 2048; unit += gridDim.x) ml::m3_unit((rw::lds_u8*)lds, unit, projp, p, o, mixp, r3); }
        }
        GSYNC();
        { FRESH(); ph_gemm(c, MIXp, (bf16*)WSP(WS_WOUT) + (size_t)l * DM * DM, DM, DM, pg8::EpiResBf{XBp, SSQ(2 * l + 1), DM, 0}); }
        GSYNC();
        { FRESH(); ph_gemm(c, XBp, (bf16*)WSP(WS_WUP) + (size_t)l * FF * DM, FF, DM, pg8::EpiBf16S<2>{HIDp, SSQ(2 * l + 1), FF, 0}); }
        GSYNC();
        { FRESH(); ph_gemm(c, HIDp, (bf16*)WSP(WS_WDN) + (size_t)l * DM * FF, DM, FF, pg8::EpiResBf{XBp, SSQ(2 * l + 2), DM, 0}); }
        GSYNC();
}

constexpr int LDS_BYTES = 163840;
__global__ void __launch_bounds__(512, 2) mega(Params p) {
    extern __shared__ __attribute__((aligned(16))) unsigned char lds[];
    cg::grid_group grid = cg::this_grid();
    volatile LAS unsigned* xst = (volatile LAS unsigned*)((LAS unsigned char*)lds + 163776);
    if (threadIdx.x < 2) xst[threadIdx.x] = 0u;
    __syncthreads();
    XcdBarrier xbar = xcd_barrier_post((unsigned*)(((const Params*)__builtin_amdgcn_kernarg_segment_ptr())->ws + 16384), xst);
    const Params* kp = (const Params*)__builtin_amdgcn_kernarg_segment_ptr();
    { FRESH(); ph_wt<true, true>(c, IN(2), DM, NREAL, NP, (bf16*)WSP(WS_WIN), IN(1), AQ, AK, C2); }
    { FRESH(); ph_x2bf(c, IN(0), XBp, SSQ(0)); }
    GSYNC_CG();
    layer_body<0>(kp, lds, grid, xbar);
    layer_body<1>(kp, lds, grid, xbar);
    { FRESH(); ph_final_norm(c, OUTP, IN(28), XBp, SSQ(2 * DEPTH)); }
}

extern "C" void kernel_launch(void* const* d_in, const int* in_sizes, int n_in, void* d_out, int out_size, void* d_ws, size_t ws_size, hipStream_t stream) {
    static int grid_blocks = 0;
    if (grid_blocks == 0) {
        if (n_in != 29 || out_size != T * DM || ws_size < WS_END) { fprintf(stderr, "kernel_launch: unexpected shapes n_in %d out %d ws %zu\n", n_in, out_size, ws_size); grid_blocks = -1; return; }
        int dev = 0, cus = 0, per_cu = 0;
        (void)hipGetDevice(&dev); (void)hipDeviceGetAttribute(&cus, hipDeviceAttributeMultiprocessorCount, dev);
        (void)hipFuncSetAttribute((const void*)mega, hipFuncAttributeMaxDynamicSharedMemorySize, LDS_BYTES);
        (void)hipOccupancyMaxActiveBlocksPerMultiprocessor(&per_cu, (const void*)mega, 512, LDS_BYTES);
        fprintf(stderr, "kernel_launch: cus %d per_cu %d ws %zu\n", cus, per_cu, ws_size);
        grid_blocks = (per_cu >= 1) ? cus : -1;
    }
    if (grid_blocks < 0) return;
    if (hipMemsetAsync(d_ws, 0, 1u << 17, stream) != hipSuccess) { fprintf(stderr, "kernel_launch: memset of the control words failed\n"); return; }
    Params p{};
    for (int i = 0; i < 29; ++i) p.in[i] = (const GASQ float*)d_in[i];
    p.out = (GASQ float*)d_out; p.ws = (GASQ unsigned char*)d_ws;
    void* args[] = {&p};
    hipError_t e = hipLaunchCooperativeKernel((void*)mega, dim3(grid_blocks), dim3(512), args, LDS_BYTES, stream);
    if (e != hipSuccess) fprintf(stderr, "cooperative launch failed: %s (grid %d)\n", hipGetErrorString(e), grid_blocks);
}
```

```cpp
#include <hip/hip_runtime.h>
#include <hip/hip_cooperative_groups.h>
#include <cstdio>
#include <cstdint>
#include <cmath>
namespace pg8 {
#define PG8_LAS __attribute__((address_space(3)))
typedef unsigned short bf16_t;
typedef short bf16x8 __attribute__((ext_vector_type(8)));
typedef float f32x4 __attribute__((ext_vector_type(4)));
typedef unsigned u32x4 __attribute__((ext_vector_type(4)));
constexpr int BM = 256, BK = 64, HALF = 128, HTB = HALF * BK * 2  , STAGE_BYTES = 8 * HTB, NXCD = 8, WGM = 8;

__host__ __device__ __forceinline__ int lds_byte(int r, int c) { const int st = (r >> 4) * 2 + (c >> 5), rr = r & 15, cc = c & 31, ob = rr * 64 + cc * 2; return st * 1024 + (ob ^ (((ob >> 9) & 1) << 5)); }
__host__ __device__ __forceinline__ void stage_rc(int b, int& R, int& C) { const int st = b / 1024, sb = b % 1024, swz = sb ^ (((sb >> 9) & 1) << 5); R = (st >> 1) * 16 + swz / 64; C = (st & 1) * 32 + (swz % 64) / 2; }
__host__ __device__ __forceinline__ int perm32(int rho) { const int n = rho >> 4, i = rho & 15; return 8 * (i >> 2) + 4 * n + (i & 3); }

struct Unit { int pm, pn; };
struct Gemm { const bf16_t* A; const bf16_t* Bt; int M, N, K, pad; };

struct StaticOrder {
    int nM, nN, nwg, G, c;
    __host__ __device__ void init(int M, int N, int G_, int c_) { nM = M / BM; nN = N / BM; nwg = nM * nN; G = G_; c = c_; }
    __host__ __device__ bool next(int i, Unit& u) const {
        const long L = (long)i * G + c; if (L >= nwg) return false;
        int wgid = (int)L; { const int q = nwg / NXCD, r = nwg % NXCD, xcd = wgid % NXCD, off = wgid / NXCD; wgid = (xcd < r ? xcd * (q + 1) : r * (q + 1) + (xcd - r) * q) + off; }
        const int nig = WGM * nN, gid = wgid / nig, fm = gid * WGM, gsz = (nM - fm) < WGM ? (nM - fm) : WGM;
        u.pm = fm + ((wgid % nig) % gsz); u.pn = (wgid % nig) / gsz; return true;
    }
    __device__ __forceinline__ void a_ready(const Unit&) const {}
    __device__ __forceinline__ void done(const Unit&) const {}
};

__device__ __forceinline__ unsigned cvt_pk_bf16(float lo, float hi) { unsigned r; asm volatile("v_cvt_pk_bf16_f32 %0, %1, %2" : "=v"(r) : "v"(lo), "v"(hi)); return r; }
typedef float f32x2 __attribute__((ext_vector_type(2)));
__device__ __forceinline__ unsigned long long ssq_fix(float s) { const float h = floorf(s); const unsigned hi = (unsigned)h; const unsigned lo = (unsigned)((s - h) * 4294967296.f); return ((unsigned long long)hi << 32) | lo; }
__device__ __forceinline__ float ssq_val(unsigned long long v) { return (float)(unsigned)(v >> 32) + (float)(unsigned)v * (1.f / 4294967296.f); }
template <int ACT> struct EpiBf16S {
    static constexpr bool PERM = true, AFTER_DRAIN = false;
    bf16_t* O; const unsigned long long* rowssq; int ldc; int pad;
    __device__ __forceinline__ void operator()(const f32x4 (&acc)[2][2][4][2], const Unit& u, int wr, int wc, int fr, int fq) const {
        const int row0 = u.pm * BM + wr * 64 + fr; const int col0 = u.pn * BM + wc * 32 + 8 * fq;
        unsigned long long rsv[2][4];
#pragma unroll
        for (int ai = 0; ai < 2; ++ai)
#pragma unroll
            for (int m = 0; m < 4; ++m) rsv[ai][m] = rowssq[row0 + ai * HALF + m * 16];
#pragma unroll
        for (int ai = 0; ai < 2; ++ai)
#pragma unroll
            for (int m = 0; m < 4; ++m) { const int row = row0 + ai * HALF + m * 16; const float rs = rsqrtf(ssq_val(rsv[ai][m]) * (1.f / 1024.f) + 1e-6f); bf16_t* rowp = O + (size_t)row * ldc + col0;
#pragma unroll
                for (int bj = 0; bj < 2; ++bj) { f32x4 v0 = acc[ai][bj][m][0] * rs, v1 = acc[ai][bj][m][1] * rs;
                    if (ACT == 2) {
#pragma unroll
                        for (int e = 0; e < 4; ++e) { float a = fmaxf(v0[e], 0.f), b = fmaxf(v1[e], 0.f); v0[e] = a * a; v1[e] = b * b; } }
                    u32x4 w; w.x = cvt_pk_bf16(v0[0], v0[1]); w.y = cvt_pk_bf16(v0[2], v0[3]); w.z = cvt_pk_bf16(v1[0], v1[1]); w.w = cvt_pk_bf16(v1[2], v1[3]);
                    *(u32x4*)(rowp + bj * HALF) = w; } }
    }
};
struct EpiResBf {
    static constexpr bool PERM = true, AFTER_DRAIN = false;
    bf16_t* xb; unsigned long long* ssq; int ldc; int pad;
    __device__ __forceinline__ void operator()(const f32x4 (&acc)[2][2][4][2], const Unit& u, int wr, int wc, int fr, int fq) const {
        const int row0 = u.pm * BM + wr * 64 + fr; const int col0 = u.pn * BM + wc * 32 + 8 * fq;
#pragma unroll
        for (int ai = 0; ai < 2; ++ai) {
            u32x4 bv[4][2];
#pragma unroll
            for (int m = 0; m < 4; ++m)
#pragma unroll
                for (int bj = 0; bj < 2; ++bj) bv[m][bj] = *(const u32x4*)(xb + (size_t)(row0 + ai * HALF + m * 16) * ldc + col0 + bj * HALF);
            asm volatile("" ::: "memory");
#pragma unroll
            for (int m = 0; m < 4; ++m) { const int row = row0 + ai * HALF + m * 16; bf16_t* rowp = xb + (size_t)row * ldc + col0; float s = 0.f;
#pragma unroll
                for (int bj = 0; bj < 2; ++bj) { const u32x4 b = bv[m][bj]; f32x4 v0 = acc[ai][bj][m][0], v1 = acc[ai][bj][m][1];
                    v0[0] += __uint_as_float(b.x << 16); v0[1] += __uint_as_float(b.x & 0xffff0000u); v0[2] += __uint_as_float(b.y << 16); v0[3] += __uint_as_float(b.y & 0xffff0000u);
                    v1[0] += __uint_as_float(b.z << 16); v1[1] += __uint_as_float(b.z & 0xffff0000u); v1[2] += __uint_as_float(b.w << 16); v1[3] += __uint_as_float(b.w & 0xffff0000u);
                    s += ((v0[0] * v0[0] + v0[1] * v0[1]) + (v0[2] * v0[2] + v0[3] * v0[3])) + ((v1[0] * v1[0] + v1[1] * v1[1]) + (v1[2] * v1[2] + v1[3] * v1[3]));
                    u32x4 w; w.x = cvt_pk_bf16(v0[0], v0[1]); w.y = cvt_pk_bf16(v0[2], v0[3]); w.z = cvt_pk_bf16(v1[0], v1[1]); w.w = cvt_pk_bf16(v1[2], v1[3]);
                    *(u32x4*)(rowp + bj * HALF) = w; }
                s += __int_as_float(__builtin_amdgcn_ds_swizzle(__float_as_int(s), (16 << 10) | 0x1f));
                { auto rr = __builtin_amdgcn_permlane32_swap(__float_as_uint(s), __float_as_uint(s), false, false); s = __uint_as_float(rr[0]) + __uint_as_float(rr[1]); }
                if (fq == 0) atomicAdd(ssq + row, ssq_fix(s)); }
            asm volatile("" ::: "memory"); }
    }
};
__device__ __forceinline__ const char* uni_ptr(const char* p) {
    const unsigned long long v = (unsigned long long)p; const unsigned lo = __builtin_amdgcn_readfirstlane((unsigned)v), hi = __builtin_amdgcn_readfirstlane((unsigned)(v >> 32));
    return (const char*)(((unsigned long long)hi << 32) | lo); }
template <class Epi, class Sched, bool ALIGN_EPI = false, bool SP2 = false>
__device__ __forceinline__ void gemm_phase(PG8_LAS unsigned char* lds, const Gemm g, const Sched& S, const Epi& E) {
    int tid_ = threadIdx.x; asm volatile("" : "+v"(tid_));
    const int tid = tid_, wid = __builtin_amdgcn_readfirstlane(tid >> 6), lane = tid & 63, wr = wid >> 2, wc = wid & 3, fr = lane & 15, fq = lane >> 4;
    const int K = g.K, nt = K / BK;
    unsigned voffA[2], voffB[2];
#pragma unroll
    for (int i = 0; i < 2; ++i) { int R, C; stage_rc(tid * 16 + i * 8192, R, C); const int Rb = Epi::PERM ? ((R & ~31) + perm32(R & 31)) : R;
        voffA[i] = (unsigned)(R * K + C) * 2u; voffB[i] = (unsigned)(Rb * K + C) * 2u; }
    const size_t kstep = (size_t)(BK * 2);
    const size_t hstep = (size_t)HALF * K * 2;
    const size_t tstep = 2 * hstep;
    const unsigned ldsw = (unsigned)wid * 1024u;
    const int aoff = lds_byte(wr * 64 + fr, fq * 8), boff = lds_byte(wc * 32 + fr, fq * 8);
#define PG8_SA(b, h) (((b) * 2 + (h)) * HTB)
#define PG8_SB(b, h) ((4 + (b) * 2 + (h)) * HTB)
#define PG8_STAGE(bufoff, gbase, voff) do { _Pragma("unroll") for (int _i = 0; _i < 2; ++_i) \
        __builtin_amdgcn_global_load_lds((const unsigned*)((const char*)(gbase) + (voff)[_i]), (PG8_LAS unsigned*)(lds + (bufoff) + ldsw + _i * 8192), 16, 0, 0); } while (0)
#define PG8_LDA(dst, b, h) do { _Pragma("unroll") for (int m = 0; m < 4; ++m) _Pragma("unroll") for (int k = 0; k < 2; ++k) dst[m][k] = *(const PG8_LAS bf16x8*)(lds + PG8_SA(b, h) + aoff + m * 2048 + k * 1024); } while (0)
#define PG8_LDB(dst, b, h) do { _Pragma("unroll") for (int n = 0; n < 2; ++n) _Pragma("unroll") for (int k = 0; k < 2; ++k) dst[n][k] = *(const PG8_LAS bf16x8*)(lds + PG8_SB(b, h) + boff + n * 2048 + k * 1024); } while (0)
#define PG8_MMA(ai, bj, At, Bt) do { __builtin_amdgcn_s_setprio(1); _Pragma("unroll") for (int m = 0; m < 4; ++m) _Pragma("unroll") for (int n = 0; n < 2; ++n) _Pragma("unroll") for (int k = 0; k < 2; ++k) \
        acc[ai][bj][m][n] = __builtin_amdgcn_mfma_f32_16x16x32_bf16(Bt[n][k], At[m][k], acc[ai][bj][m][n], 0, 0, 0); __builtin_amdgcn_s_setprio(0); } while (0)
#define PG8_WAIT_V(n) asm volatile("s_waitcnt vmcnt(" #n ")" ::: "memory")
#define PG8_WAIT_L(n) asm volatile("s_waitcnt lgkmcnt(" #n ")" ::: "memory")
#define PG8_BAR __builtin_amdgcn_s_barrier()
#define PG8_SCHED __builtin_amdgcn_sched_barrier(0)
    Unit cur, nxt; int ui = 0;
    if (!S.next(0, cur)) return;
    f32x4 acc[2][2][4][2];
#pragma unroll
    for (int a = 0; a < 2; ++a)
#pragma unroll
        for (int b = 0; b < 2; ++b)
#pragma unroll
            for (int m = 0; m < 4; ++m)
#pragma unroll
                for (int n = 0; n < 2; ++n) acc[a][b][m][n] = (f32x4){0.f, 0.f, 0.f, 0.f};
    bf16x8 At[4][2], B0[2][2], B1[2][2];
    const char* cA = uni_ptr((const char*)g.A + (size_t)cur.pm * tstep); const char* cB = uni_ptr((const char*)g.Bt + (size_t)cur.pn * tstep);
    S.a_ready(cur);
    if constexpr (SP2) {
        PG8_STAGE(PG8_SB(0, 0), cB, voffB); PG8_STAGE(PG8_SB(0, 1), cB + hstep, voffB); PG8_STAGE(PG8_SA(0, 0), cA, voffA); PG8_STAGE(PG8_SA(0, 1), cA + hstep, voffA);
        if (wr == 1) PG8_BAR;
        PG8_WAIT_V(2); PG8_BAR;
        PG8_STAGE(PG8_SB(1, 0), cB + kstep, voffB); PG8_STAGE(PG8_SA(1, 0), cA + kstep, voffA); PG8_STAGE(PG8_SB(1, 1), cB + hstep + kstep, voffB);
        PG8_WAIT_V(6); PG8_BAR;
    } else {
        PG8_STAGE(PG8_SB(0, 0), cB, voffB); PG8_STAGE(PG8_SA(0, 0), cA, voffA); PG8_STAGE(PG8_SB(0, 1), cB + hstep, voffB); PG8_STAGE(PG8_SA(0, 1), cA + hstep, voffA);
        if (wr == 1) PG8_BAR;
        PG8_WAIT_V(4); PG8_BAR;
        PG8_STAGE(PG8_SB(1, 0), cB + kstep, voffB); PG8_STAGE(PG8_SA(1, 0), cA + kstep, voffA); PG8_STAGE(PG8_SB(1, 1), cB + hstep + kstep, voffB);
        PG8_WAIT_V(6); PG8_BAR;
    }
    for (;;) {
        const bool has_next = S.next(ui + 1, nxt);
        const char* nA = uni_ptr(has_next ? (const char*)g.A + (size_t)nxt.pm * tstep : cA); const char* nB = uni_ptr(has_next ? (const char*)g.Bt + (size_t)nxt.pn * tstep : cB);
        for (int t = 0; t < nt; t += 2) {
            const bool last = (t == nt - 2);
            const char* a1 = cA + (size_t)(t + 1) * kstep;
            const char* a2 = last ? nA : cA + (size_t)(t + 2) * kstep; const char* b2 = last ? nB : cB + (size_t)(t + 2) * kstep;
            const char* a3 = a2 + kstep; const char* b3 = b2 + kstep;
            if (last && has_next) S.a_ready(nxt);
            if constexpr (SP2) {
            PG8_LDB(B0, 0, 0); PG8_LDB(B1, 0, 1); PG8_SCHED; PG8_LDA(At, 0, 0); PG8_STAGE(PG8_SA(1, 1), a1 + hstep, voffA);
            PG8_WAIT_V(8); PG8_WAIT_L(0); PG8_BAR; PG8_MMA(0, 0, At, B0); PG8_MMA(0, 1, At, B1); PG8_BAR; PG8_SCHED;
            PG8_LDA(At, 0, 1); PG8_STAGE(PG8_SB(0, 0), b2, voffB); PG8_STAGE(PG8_SB(0, 1), b2 + hstep, voffB); PG8_STAGE(PG8_SA(0, 0), a2, voffA);
            PG8_WAIT_V(8); PG8_WAIT_L(0); PG8_BAR; PG8_MMA(1, 0, At, B0); PG8_MMA(1, 1, At, B1); PG8_BAR; PG8_SCHED;
            PG8_LDB(B0, 1, 0); PG8_LDB(B1, 1, 1); PG8_SCHED; PG8_LDA(At, 1, 0); PG8_STAGE(PG8_SA(0, 1), a2 + hstep, voffA);
            PG8_WAIT_V(8); PG8_WAIT_L(0); PG8_BAR; PG8_MMA(0, 0, At, B0); PG8_MMA(0, 1, At, B1); PG8_BAR; PG8_SCHED;
            PG8_LDA(At, 1, 1); PG8_STAGE(PG8_SB(1, 0), b3, voffB); PG8_STAGE(PG8_SB(1, 1), b3 + hstep, voffB); PG8_STAGE(PG8_SA(1, 0), a3, voffA);
            PG8_WAIT_V(8); PG8_WAIT_L(0); PG8_BAR; PG8_MMA(1, 0, At, B0); PG8_MMA(1, 1, At, B1); PG8_BAR; PG8_SCHED;
            } else {
            PG8_LDB(B0, 0, 0); PG8_SCHED; PG8_LDA(At, 0, 0); PG8_STAGE(PG8_SA(1, 1), a1 + hstep, voffA);
            PG8_WAIT_L(8); PG8_BAR; PG8_WAIT_L(0); PG8_MMA(0, 0, At, B0); PG8_BAR; PG8_SCHED;
            PG8_LDB(B1, 0, 1); PG8_STAGE(PG8_SB(0, 0), b2, voffB);
            PG8_BAR; PG8_WAIT_L(0); PG8_MMA(0, 1, At, B1); PG8_BAR;
            PG8_LDA(At, 0, 1); PG8_STAGE(PG8_SA(0, 0), a2, voffA);
            PG8_BAR; PG8_WAIT_L(0); PG8_MMA(1, 0, At, B0); PG8_BAR; PG8_SCHED;
            PG8_STAGE(PG8_SB(0, 1), b2 + hstep, voffB);
            PG8_WAIT_V(6); PG8_BAR; PG8_MMA(1, 1, At, B1); PG8_BAR;
            PG8_LDB(B0, 1, 0); PG8_SCHED; PG8_LDA(At, 1, 0); PG8_STAGE(PG8_SA(0, 1), a2 + hstep, voffA);
            PG8_WAIT_L(8); PG8_BAR; PG8_WAIT_L(0); PG8_MMA(0, 0, At, B0); PG8_BAR; PG8_SCHED;
            PG8_LDB(B1, 1, 1); PG8_STAGE(PG8_SB(1, 0), b3, voffB);
            PG8_BAR; PG8_WAIT_L(0); PG8_MMA(0, 1, At, B1); PG8_BAR;
            PG8_LDA(At, 1, 1); PG8_STAGE(PG8_SA(1, 0), a3, voffA);
            PG8_BAR; PG8_WAIT_L(0); PG8_MMA(1, 0, At, B0); PG8_BAR; PG8_SCHED;
            PG8_STAGE(PG8_SB(1, 1), b3 + hstep, voffB);
            PG8_WAIT_V(6); PG8_BAR; PG8_MMA(1, 1, At, B1); PG8_BAR;
            }
        }
        if constexpr (ALIGN_EPI) { if (wr == 0) PG8_BAR; }
        if constexpr (!Epi::AFTER_DRAIN) { E(acc, cur, wr, wc, fr, fq); S.done(cur); }
        if (!has_next) break;
#pragma unroll
        for (int a = 0; a < 2; ++a)
#pragma unroll
            for (int b = 0; b < 2; ++b)
#pragma unroll
                for (int m = 0; m < 4; ++m)
#pragma unroll
                    for (int n = 0; n < 2; ++n) acc[a][b][m][n] = (f32x4){0.f, 0.f, 0.f, 0.f};
        cur = nxt; cA = nA; cB = nB; ++ui;
        if constexpr (ALIGN_EPI) { if (wr == 1) PG8_BAR; }
    }
    PG8_WAIT_V(0);
    if constexpr (!ALIGN_EPI) { if (wr == 0) PG8_BAR; }
    PG8_BAR;
    if constexpr (Epi::AFTER_DRAIN) { E.fused(acc, cur, wr, wc, fr, fq, lds, wid, lane); S.done(cur); }
#undef PG8_SA
#undef PG8_SB
#undef PG8_STAGE
#undef PG8_LDA
#undef PG8_LDB
#undef PG8_MMA
#undef PG8_WAIT_V
#undef PG8_WAIT_L
#undef PG8_BAR
#undef PG8_SCHED
}
}
#include <hip/hip_bf16.h>
#include <cmath>
namespace attn_body {
using bf16=__hip_bfloat16;
using bf16x8=__attribute__((ext_vector_type(8)))short;
using s16x4=__attribute__((ext_vector_type(4)))short;
using f32x16=__attribute__((ext_vector_type(16)))float;
using u32x4=__attribute__((ext_vector_type(4)))unsigned;
constexpr int SEQ=4096,D=64,PQ=3584,PO=1024;
constexpr int NW=8,QBLK=32,QB=QBLK*NW,KVBLK=64,NQB=SEQ/QB;
constexpr int ATTN_UNIT_ROWS=QB;
__device__ __forceinline__ int crow(int r,int hi){return (r&3)+8*(r>>2)+4*hi;}
#define SBAR() __builtin_amdgcn_sched_barrier(0)
__device__ __forceinline__ void cmask(f32x16&p0,f32x16&p1,int jb,int qrel,int hi){
  const float NEG=-INFINITY; int kb=64*jb+4*hi;
  #pragma unroll
  for(int r=0;r<16;++r){int kv=kb+(r&3)+8*(r>>2); if(kv>qrel)p0[r]=NEG; if(kv+32>qrel)p1[r]=NEG;}
}

constexpr int NSLOT=3, SLOTB=8192;
constexpr int VSLOTB=2*SLOTB;
constexpr int LDS_K=0, LDS_V=NSLOT*SLOTB, LDS_WS=LDS_V+NSLOT*VSLOTB, LDS_OST=LDS_WS+NW*64*4, LDS_BYTES=LDS_OST+NW*4096;
constexpr float C2=0.125f*1.4426950408889634f;
__device__ __forceinline__ void glds16(const void*gsrc,unsigned lds_dst){unsigned keep;
  asm volatile("s_mov_b32 %0, m0\n\ts_mov_b32 m0, %2\n\ts_nop 0\n\tglobal_load_lds_dwordx4 %1, off\n\ts_mov_b32 m0, %0":"=&s"(keep):"v"(gsrc),"s"(lds_dst):"memory");}
__device__ __forceinline__ float max3f(float a,float b,float c){float r;asm("v_max3_f32 %0, %1, %2, %3":"=v"(r):"v"(a),"v"(b),"v"(c));return r;}
__device__ __forceinline__ float max2f(float a,float b){float r;asm("v_max_f32_e32 %0, %1, %2":"=v"(r):"v"(a),"v"(b));return r;}
__device__ __forceinline__ float fadd_s(float a,float b){float r;asm("v_add_f32_e32 %0, %1, %2":"=v"(r):"v"(a),"v"(b));return r;}
__device__ __forceinline__ float fsub_s(float a,float b){float r;asm("v_sub_f32_e32 %0, %1, %2":"=v"(r):"v"(a),"v"(b));return r;}
typedef float f32x2_t __attribute__((ext_vector_type(2))); typedef __bf16 bf16x2_t __attribute__((ext_vector_type(2)));
__device__ __forceinline__ unsigned cvtpk_s(float lo,float hi){f32x2_t v={lo,hi};bf16x2_t b=__builtin_convertvector(v,bf16x2_t);return __builtin_bit_cast(unsigned,b);}
#define WAIT_BAR(N) asm volatile("s_waitcnt vmcnt(" #N ") lgkmcnt(0)\n\ts_barrier":::"memory")

__device__ __forceinline__ void qkt(f32x16&p0,f32x16&p1,const char*Kslot,const bf16x8*qr,const f32x16&negm,int r32,int hi){
  const char*kb=Kslot+hi*1024+r32*16;
  #pragma unroll
  for(int d0=0;d0<4;++d0){
    const bf16x8 b0=*reinterpret_cast<const bf16x8*>(kb+d0*2048);
    const bf16x8 b1=*reinterpret_cast<const bf16x8*>(kb+d0*2048+512);
    if(d0==0){p0=__builtin_amdgcn_mfma_f32_32x32x16_bf16(b0,qr[0],negm,0,0,0);p1=__builtin_amdgcn_mfma_f32_32x32x16_bf16(b1,qr[0],negm,0,0,0);}
    else{p0=__builtin_amdgcn_mfma_f32_32x32x16_bf16(b0,qr[d0],p0,0,0,0);p1=__builtin_amdgcn_mfma_f32_32x32x16_bf16(b1,qr[d0],p1,0,0,0);}}
}
typedef __attribute__((address_space(3))) const char* lds_cptr;
typedef short v4i16_t __attribute__((ext_vector_type(4)));
__device__ __forceinline__ void kload8(bf16x8*kf,lds_cptr kp){
  kf[0]=*(const __attribute__((address_space(3))) bf16x8*)(kp);      kf[1]=*(const __attribute__((address_space(3))) bf16x8*)(kp+512);
  kf[2]=*(const __attribute__((address_space(3))) bf16x8*)(kp+2048); kf[3]=*(const __attribute__((address_space(3))) bf16x8*)(kp+2560);
  kf[4]=*(const __attribute__((address_space(3))) bf16x8*)(kp+4096); kf[5]=*(const __attribute__((address_space(3))) bf16x8*)(kp+4608);
  kf[6]=*(const __attribute__((address_space(3))) bf16x8*)(kp+6144); kf[7]=*(const __attribute__((address_space(3))) bf16x8*)(kp+6656);
}
__device__ __forceinline__ void kload2(bf16x8*kf,lds_cptr kp,int j){ kf[2*j]=*(const __attribute__((address_space(3))) bf16x8*)(kp+j*2048); kf[2*j+1]=*(const __attribute__((address_space(3))) bf16x8*)(kp+j*2048+512); }
__device__ __forceinline__ s16x4 vtr(lds_cptr p){ return __builtin_bit_cast(s16x4,__builtin_amdgcn_ds_read_tr16_b64_v4i16((__attribute__((address_space(3))) v4i16_t*)p)); }
__device__ __forceinline__ float rowmax(const f32x16&p0,const f32x16&p1){
  float a=max3f(p0[0],p0[1],p1[0]),b=max3f(p0[2],p0[3],p1[1]);a=max3f(a,p1[2],p1[3]);
  #pragma unroll
  for(int r=4;r<16;r+=4){a=max3f(a,p0[r],p0[r+1]);b=max3f(b,p0[r+2],p0[r+3]);a=max3f(a,p1[r],p1[r+1]);b=max3f(b,p1[r+2],p1[r+3]);}
  const float m=max2f(a,b);
  auto rr=__builtin_amdgcn_permlane32_swap(__float_as_uint(m),__float_as_uint(m),false,false);
  return max2f(__uint_as_float(rr[0]),__uint_as_float(rr[1]));
}
__device__ __forceinline__ void pv(f32x16*o,int vb,bf16x8 pa0,bf16x8 pa1,bf16x8 pa2,bf16x8 pa3){
  #pragma unroll
  for(int d0=0;d0<4;++d0){s16x4 lo[4],hi[4];
    #pragma unroll
    for(int ks=0;ks<4;++ks){
      asm volatile("ds_read_b64_tr_b16 %0,%1 offset:%c2":"=&v"(lo[ks]):"v"(vb),"i"(d0*4096+ks*1024):"memory");
      asm volatile("ds_read_b64_tr_b16 %0,%1 offset:%c2":"=&v"(hi[ks]):"v"(vb),"i"(d0*4096+ks*1024+512):"memory");}
    asm volatile("s_waitcnt lgkmcnt(0)":::"memory");SBAR();
    #define PK(k) (bf16x8){lo[k][0],lo[k][1],lo[k][2],lo[k][3],hi[k][0],hi[k][1],hi[k][2],hi[k][3]}
    o[d0]=__builtin_amdgcn_mfma_f32_32x32x16_bf16(pa0,PK(0),o[d0],0,0,0);
    o[d0]=__builtin_amdgcn_mfma_f32_32x32x16_bf16(pa1,PK(1),o[d0],0,0,0);
    o[d0]=__builtin_amdgcn_mfma_f32_32x32x16_bf16(pa2,PK(2),o[d0],0,0,0);
    o[d0]=__builtin_amdgcn_mfma_f32_32x32x16_bf16(pa3,PK(3),o[d0],0,0,0);
    #undef PK
  }
}

#ifndef ATTN_STORE16
#define ATTN_STORE16(p,v) (*(__attribute__((address_space(1))) u32x4*)(unsigned long long)(p)=(v))
#endif
struct DiffEpi { float lam, oscale; const float* g; unsigned short* mixh; };
template<int THRL> __device__ __forceinline__ void attn_unit(long rowbase,int qb,const bf16*Q,const bf16*__restrict__ K,const bf16*__restrict__ V,int c_head,const DiffEpi&E,char*shm){
  int tid_=threadIdx.x; asm volatile("":"+v"(tid_));
  const int tid=tid_,lane=tid&63,r32=lane&31,hi=lane>>5; const int wid=__builtin_amdgcn_readfirstlane(tid>>6);
  const int q0=qb*QB;
  const bf16*Qw=Q+(rowbase+q0+wid*QBLK)*PQ;
  const bf16*Kh=K+rowbase*PQ,*Vh=V+rowbase*PQ;
  const unsigned lds0=(unsigned)(uintptr_t)shm;
  float*wsf=(float*)(shm+LDS_WS)+wid*64;
  const bf16*ksrc=Kh+(long)lane*PQ+wid*8;
  const bf16*vsrc=Vh+(long)(16*(wid&3)+(lane>>2))*PQ+(wid>>2)*32+(lane&3)*8;
  const unsigned kdst=lds0+LDS_K+wid*1024, vdst=lds0+LDS_V+wid*1024;
  #define DMA_K(t,slot) glds16(ksrc+(long)(t)*KVBLK*PQ,(unsigned)__builtin_amdgcn_readfirstlane(kdst+(slot)))
  #define DMA_V(t,slot) do{ glds16(vsrc+(long)(t)*KVBLK*PQ,(unsigned)__builtin_amdgcn_readfirstlane(vdst+2*(slot))); glds16(vsrc+64+(long)(t)*KVBLK*PQ,(unsigned)__builtin_amdgcn_readfirstlane(vdst+2*(slot)+8192)); }while(0)
  const int vb0=(int)(lds0+LDS_V)+((lane>>4)&1)*32+(lane&3)*8+(4*hi+((lane&15)>>2))*64;
  const char*Kbase=shm+LDS_K; bf16x8 kf[8];
  const lds_cptr shm3=(lds_cptr)shm; const lds_cptr kp0=shm3+LDS_K+hi*1024+r32*16; const lds_cptr vp0=shm3+LDS_V+((lane>>4)&1)*32+(lane&3)*8+(4*hi+((lane&15)>>2))*64;
  const int NT=(q0+QB)/KVBLK;
  DMA_K(0,0);DMA_V(0,0);DMA_K(1,SLOTB);
  bf16x8 qr[4];
  #pragma unroll
  for(int d0=0;d0<4;++d0)qr[d0]=*(const __attribute__((address_space(1))) bf16x8*)(unsigned long long)(&Qw[(long)r32*PQ+d0*16+hi*8]);
  float mhat=0.f,l_reg=0.f;f32x16 o[4];o[0]=f32x16{};o[1]=f32x16{};o[2]=f32x16{};o[3]=f32x16{};const f32x16 ZC=f32x16{};
  const int qrel=wid*QBLK+r32;
  #define CMASK(P0,P1,t) do{int jb_=(t)-(NT-4); if(jb_>=0)cmask(P0,P1,jb_,qrel,hi);}while(0)
  bool resc=false;
  #define START(P0,P1) do{ const float rm=rowmax(P0,P1); resc=false; \
    { const float dl=rm; mhat=fadd_s(mhat,dl); \
      _Pragma("unroll") for(int r=0;r<16;++r){P0[r]=fsub_s(P0[r],dl);P1[r]=fsub_s(P1[r],dl);} \
      } \
    _Pragma("unroll") for(int r=0;r<16;++r)P0[r]=__builtin_amdgcn_exp2f(P0[r]); }while(0)
  #define RESC() do{ if(resc){ asm volatile("s_waitcnt lgkmcnt(0)":::"memory"); \
      _Pragma("unroll") for(int d_=0;d_<4;++d_) _Pragma("unroll") for(int r=0;r<16;++r)o[d_][r]*=wsf[crow(r,hi)]; } }while(0)
  f32x16 pA0,pA1,pB0,pB1;
  int sl_prev=0,sl_cur=0,sl_next=SLOTB;
  #define ROT() do{sl_prev=sl_cur;sl_cur=sl_next;sl_next=(sl_next==(NSLOT-1)*SLOTB)?0:sl_next+SLOTB;}while(0)
  DMA_K(2,2*SLOTB);
  WAIT_BAR(4);
  qkt(pA0,pA1,Kbase,qr,ZC,r32,hi);asm volatile("s_nop 15\n\ts_nop 7":"+v"(pA0),"+v"(pA1));CMASK(pA0,pA1,0);
  START(pA0,pA1);
  _Pragma("unroll") for(int r=0;r<16;++r)pA1[r]=__builtin_amdgcn_exp2f(pA1[r]);
  WAIT_BAR(0);
  DMA_K(3,0);DMA_V(1,SLOTB);
  ROT();
  kload8(kf,kp0+sl_cur);
  WAIT_BAR(3);
  s16x4 vlo[4],vhi[4]; u32x4 pw0,pw1,pw2,pw3;
  #define PKW(P,B) cvtpk_s(P[B],P[B+1])
  #define PAF(k) __builtin_bit_cast(bf16x8,pw##k)
  #define VFR(i) (bf16x8){vlo[i][0],vlo[i][1],vlo[i][2],vlo[i][3],vhi[i][0],vhi[i][1],vhi[i][2],vhi[i][3]}
  #define PIN(x) asm volatile("":"+v"(x))
  #define MX3(a,b,c) __builtin_fmaxf(__builtin_fmaxf((a),(b)),(c))
  #define GAPA(MF,A0,A1,A2,A3,W0,W1,PW) do{ MF; sacc+=A0; sacc+=A1; sacc+=A2; sacc+=A3; PIN(sacc); W0; W1; PIN(PW); SBAR(); }while(0)
  #define EX(v) __builtin_amdgcn_exp2f(v)
  #define GAPB(MF,X,B) do{ MF; X[B]=EX(X[B]); X[B+1]=EX(X[B+1]); PIN(X); SBAR(); }while(0)
  #define VRD(i,s) do{ vlo[s]=vtr(vp_+(((i)>>2)*4096+((i)&3)*1024)); vhi[s]=vtr(vp_+(((i)>>2)*4096+((i)&3)*1024+512)); }while(0)
  #define KRD(G,j) do{ if(G){ kload2(kf,kp0+sl_next,j); SBAR(); } }while(0)
  #define PVM(n,i) o[(i)>>2]=__builtin_amdgcn_mfma_f32_32x32x16_bf16(PAF_((i)&3),VFR((n)&3),o[(i)>>2],0,0,0)
  #define PAF_(k) ((k)==0?PAF(0):(k)==1?PAF(1):(k)==2?PAF(2):PAF(3))
  #define STEP(C0,C1,P0,P1,t,GK,GV,GL) do{ SBAR(); \
    const lds_cptr vp_=vp0+2*sl_prev; \
    VRD(0,0); SBAR(); float sacc=(P0[0]+P0[1]); \
    GAPA(C0=__builtin_amdgcn_mfma_f32_32x32x16_bf16(kf[0],qr[0],ZC,0,0,0), P0[2],P0[3],P0[4],P0[5],     pw0[0]=PKW(P0,0), pw0[1]=PKW(P0,2), pw0); \
    GAPA(C1=__builtin_amdgcn_mfma_f32_32x32x16_bf16(kf[1],qr[0],ZC,0,0,0), P0[6],P0[7],P0[8],P0[9],     pw0[2]=PKW(P0,4), pw0[3]=PKW(P0,6), pw0); \
    VRD(4,1); SBAR(); GAPA(C0=__builtin_amdgcn_mfma_f32_32x32x16_bf16(kf[2],qr[1],C0,0,0,0),   P0[10],P0[11],P0[12],P0[13], pw1[0]=PKW(P0,8), pw1[1]=PKW(P0,10), pw1); \
    GAPA(C1=__builtin_amdgcn_mfma_f32_32x32x16_bf16(kf[3],qr[1],C1,0,0,0),   P0[14],P0[15],P1[0],P1[1],   pw1[2]=PKW(P0,12),pw1[3]=PKW(P0,14), pw1); \
    VRD(1,2); SBAR(); GAPA(C0=__builtin_amdgcn_mfma_f32_32x32x16_bf16(kf[4],qr[2],C0,0,0,0),   P1[2],P1[3],P1[4],P1[5],     pw2[0]=PKW(P1,0), pw2[1]=PKW(P1,2), pw2); \
    GAPA(C1=__builtin_amdgcn_mfma_f32_32x32x16_bf16(kf[5],qr[2],C1,0,0,0),   P1[6],P1[7],P1[8],P1[9],     pw2[2]=PKW(P1,4), pw2[3]=PKW(P1,6), pw2); \
    VRD(5,3); SBAR(); GAPA(C0=__builtin_amdgcn_mfma_f32_32x32x16_bf16(kf[6],qr[3],C0,0,0,0),   P1[10],P1[11],P1[12],P1[13], pw3[0]=PKW(P1,8), pw3[1]=PKW(P1,10), pw3); \
    GAPA(C1=__builtin_amdgcn_mfma_f32_32x32x16_bf16(kf[7],qr[3],C1,0,0,0),   P1[14],P1[15],0.f,0.f,       pw3[2]=PKW(P1,12),pw3[3]=PKW(P1,14), pw3); \
    l_reg+=sacc; \
    if(GK){DMA_K((t)+3,sl_cur);} if(GV){DMA_V((t)+1,sl_next);} \
    _Pragma("unroll") for(int r=0;r<16;++r){C0[r]-=mhat;C1[r]-=mhat;} \
    CMASK(C0,C1,t); \
    { float a=MX3(C0[0],C0[1],C1[0]),b=MX3(C0[2],C0[3],C1[1]); a=MX3(a,C1[2],C1[3]); \
      _Pragma("unroll") for(int r=4;r<16;r+=4){a=MX3(a,C0[r],C0[r+1]);b=MX3(b,C0[r+2],C0[r+3]);a=MX3(a,C1[r],C1[r+1]);b=MX3(b,C1[r+2],C1[r+3]);} \
      float rm=__builtin_fmaxf(a,b); { auto rr=__builtin_amdgcn_permlane32_swap(__float_as_uint(rm),__float_as_uint(rm),false,false); rm=__builtin_fmaxf(__uint_as_float(rr[0]),__uint_as_float(rr[1])); } \
      resc=false; \
      if(__builtin_expect(__any(rm>(float)THRL),0)){ const float dl=__builtin_fmaxf(rm,0.f); mhat+=dl; \
        _Pragma("unroll") for(int r=0;r<16;++r){C0[r]-=dl;C1[r]-=dl;} \
        const float f=__builtin_amdgcn_exp2f(-dl); l_reg*=f; if(hi==0)wsf[r32]=f; resc=true; } } \
    SBAR(); \
    GAPB(PVM(0,0),C0,0);   VRD(2,0); SBAR(); \
    GAPB(PVM(1,4),C0,2);   VRD(6,1); SBAR(); \
    KRD(GL,0); GAPB(PVM(2,1),C0,4);   VRD(3,2); SBAR(); \
    KRD(GL,1); GAPB(PVM(3,5),C0,6);   VRD(7,3); SBAR(); \
    KRD(GL,2); GAPB(PVM(4,2),C0,8);   VRD(8,0); SBAR(); \
    KRD(GL,3); GAPB(PVM(5,6),C0,10);  VRD(12,1); SBAR(); \
    GAPB(PVM(6,3),C0,12);  VRD(9,2); SBAR(); \
    GAPB(PVM(7,7),C0,14);  VRD(13,3); SBAR(); \
    GAPB(PVM(8,8),C1,0);   VRD(10,0); SBAR(); \
    GAPB(PVM(9,12),C1,2);  VRD(14,1); SBAR(); \
    GAPB(PVM(10,9),C1,4);  VRD(11,2); SBAR(); \
    GAPB(PVM(11,13),C1,6); VRD(15,3); SBAR(); \
    GAPB(PVM(12,10),C1,8); \
    GAPB(PVM(13,14),C1,10); \
    GAPB(PVM(14,11),C1,12); \
    GAPB(PVM(15,15),C1,14); \
    }while(0)
  int t=1;
  #undef CMASK
  #define CMASK(P0,P1,t) do{}while(0)
  for(;t+5<NT;t+=2){
    STEP(pB0,pB1,pA0,pA1,t,true,true,true);     WAIT_BAR(3); RESC(); ROT();
    STEP(pA0,pA1,pB0,pB1,t+1,true,true,true);   WAIT_BAR(3); RESC(); ROT();
  }
  #undef CMASK
  #define CMASK(P0,P1,t) do{int jb_=(t)-(NT-4); if(jb_>=0)cmask(P0,P1,jb_,qrel,hi);}while(0)
  #define ENDW(tt) do{ if((tt)+3<NT){WAIT_BAR(3);} else if((tt)+2<NT){WAIT_BAR(2);} else {WAIT_BAR(0);} }while(0)
  for(;t+1<NT;t+=2){
    STEP(pB0,pB1,pA0,pA1,t,(t+3<NT),(t+1<NT),(t+1<NT));       ENDW(t);   RESC(); ROT();
    STEP(pA0,pA1,pB0,pB1,t+1,(t+4<NT),(t+2<NT),(t+2<NT));     ENDW(t+1); RESC(); ROT();
  }
  STEP(pB0,pB1,pA0,pA1,NT-1,false,false,false); RESC();
  { float sacc=pB0[0]+pB0[1]; _Pragma("unroll") for(int r=2;r<16;++r)sacc+=pB0[r]; _Pragma("unroll") for(int r=0;r<16;++r)sacc+=pB1[r]; l_reg+=sacc;
    pw0=(u32x4){PKW(pB0,0),PKW(pB0,2),PKW(pB0,4),PKW(pB0,6)};pw1=(u32x4){PKW(pB0,8),PKW(pB0,10),PKW(pB0,12),PKW(pB0,14)};pw2=(u32x4){PKW(pB1,0),PKW(pB1,2),PKW(pB1,4),PKW(pB1,6)};pw3=(u32x4){PKW(pB1,8),PKW(pB1,10),PKW(pB1,12),PKW(pB1,14)};
    SBAR(); pv(o,vb0+2*sl_cur,PAF(0),PAF(1),PAF(2),PAF(3)); }
  #undef PKW
  #undef PAF
  #undef VFR
  #undef PIN
  #undef MX3
  #undef GAPA
  #undef GAPB
  #undef EX
  #undef VRD
  #undef PVM
  #undef PAF_
  #undef KRD
  #undef STEP
  #undef ENDW
  {auto rr=__builtin_amdgcn_permlane32_swap(__float_as_uint(l_reg),__float_as_uint(l_reg),false,false);l_reg=__uint_as_float(rr[0])+__uint_as_float(rr[1]);}
  if(hi==0)wsf[32+r32]=l_reg;asm volatile("s_waitcnt lgkmcnt(0)":::"memory");
  float rli[16];
  #pragma unroll
  for(int r=0;r<16;++r)rli[r]=__builtin_amdgcn_rcpf(wsf[32+crow(r,hi)]);
  { bf16*stg=(bf16*)(shm+LDS_OST)+wid*2048;
    unsigned short*mbase=E.mixh+(rowbase+q0+wid*QBLK)*1024;
    if(c_head==0){
      #pragma unroll
      for(int hb=0;hb<2;++hb){
        #pragma unroll
        for(int r=0;r<16;++r){const int orow=crow(r,hi); stg[orow*64+r32]=__float2bfloat16(o[2*hb][r]*rli[r]); stg[orow*64+32+r32]=__float2bfloat16(o[2*hb+1][r]*rli[r]);}
        asm volatile("s_waitcnt lgkmcnt(0)":::"memory");
        #pragma unroll
        for(int i=0;i<4;++i){const int row=i*8+(lane>>3),ch=lane&7; const u32x4 v=*(const u32x4*)(stg+row*64+ch*8); ATTN_STORE16(mbase+(long)row*1024+hb*64+ch*8,v);}
        asm volatile("s_waitcnt lgkmcnt(0)":::"memory"); }
    } else {
      u32x4 v0[2][4];
      #pragma unroll
      for(int hb=0;hb<2;++hb)
        #pragma unroll
        for(int i=0;i<4;++i){const int row=i*8+(lane>>3),ch=lane&7; v0[hb][i]=*(const __attribute__((address_space(1))) u32x4*)(unsigned long long)(mbase+(long)row*1024+hb*64+ch*8);}
      float dv[2][4][8]; float ss[4]={0.f,0.f,0.f,0.f};
      #pragma unroll
      for(int hb=0;hb<2;++hb){
        #pragma unroll
        for(int r=0;r<16;++r){const int orow=crow(r,hi); stg[orow*64+r32]=__float2bfloat16(o[2*hb][r]*rli[r]); stg[orow*64+32+r32]=__float2bfloat16(o[2*hb+1][r]*rli[r]);}
        asm volatile("s_waitcnt lgkmcnt(0)":::"memory");
        #pragma unroll
        for(int i=0;i<4;++i){const int row=i*8+(lane>>3),ch=lane&7; const u32x4 v1=*(const u32x4*)(stg+row*64+ch*8);
          #pragma unroll
          for(int e=0;e<4;++e){const float dl=__uint_as_float(v0[hb][i][e]<<16)-E.lam*__uint_as_float(v1[e]<<16),dh=__uint_as_float(v0[hb][i][e]&0xffff0000u)-E.lam*__uint_as_float(v1[e]&0xffff0000u);
            dv[hb][i][2*e]=dl; dv[hb][i][2*e+1]=dh; ss[i]+=dl*dl+dh*dh;} }
        asm volatile("s_waitcnt lgkmcnt(0)":::"memory"); }
      #pragma unroll
      for(int i=0;i<4;++i){const int row=i*8+(lane>>3),ch=lane&7; float t=ss[i];
        t+=__int_as_float(__builtin_amdgcn_ds_swizzle(__float_as_int(t),(1<<10)|0x1f)); t+=__int_as_float(__builtin_amdgcn_ds_swizzle(__float_as_int(t),(2<<10)|0x1f)); t+=__int_as_float(__builtin_amdgcn_ds_swizzle(__float_as_int(t),(4<<10)|0x1f));
        const float rs=__builtin_amdgcn_rsqf(t*(1.f/128.f)+1e-5f)*E.oscale;
        #pragma unroll
        for(int hb=0;hb<2;++hb){const __attribute__((address_space(1))) float*gp=(const __attribute__((address_space(1))) float*)(unsigned long long)(E.g+hb*64+ch*8);
          u32x4 ov;
          #pragma unroll
          for(int e=0;e<4;++e)ov[e]=cvtpk_s(dv[hb][i][2*e]*rs*gp[2*e],dv[hb][i][2*e+1]*rs*gp[2*e+1]);
          ATTN_STORE16(mbase+(long)row*1024+hb*64+ch*8,ov);} } } }
  asm volatile("s_waitcnt lgkmcnt(0)\n\ts_barrier":::"memory");
  #undef DMA_K
  #undef DMA_V
  #undef CMASK
  #undef START
  #undef RESC
  #undef ROT
}
constexpr int ATTN_LDS_BYTES=LDS_BYTES;
struct StaticOrder {
  int vcu; int grid;
  __device__ __forceinline__ explicit StaticOrder(int grid_,int block):vcu(__builtin_amdgcn_readfirstlane((grid_%8==0)?(block%8)*(grid_/8)+block/8:block)),grid(grid_){}
};
__device__ __forceinline__ unsigned long long uni64(unsigned long long v){ const unsigned lo=__builtin_amdgcn_readfirstlane((unsigned)v),hi=__builtin_amdgcn_readfirstlane((unsigned)(v>>32)); return ((unsigned long long)hi<<32)|lo; }
template<int THRL=8> __device__ __forceinline__ void attn_phase(char*lds,const bf16*proj_,unsigned short*mix_,int aq,int ak,int av,float lam,float oscale,const float*norm_g_,const StaticOrder&S){
  const bf16*proj=(const bf16*)uni64((unsigned long long)proj_); unsigned short*mix=(unsigned short*)uni64((unsigned long long)mix_); const float*norm_g=(const float*)uni64((unsigned long long)norm_g_);
  const bool bal=(S.grid==256); const int xcd=S.vcu>>5,j=S.vcu&31;
  const int ntrip=bal?2:(S.vcu<512?(512-S.vcu+S.grid-1)/S.grid:0);
  for(int i=0;i<ntrip;++i){ const int u=S.vcu+i*S.grid;
    const int T_=j>>2,k_=j&3; const int sx_=(T_==0)?13:(T_==1)?9:(T_<5)?18-T_:17-T_, sy_=(T_==0)?1:(T_==1)?5:(T_<5)?T_:T_+1;
    const int bh=bal?xcd*4+2*i+(k_>>1):(u>>4),qb=bal?(((i^(k_&1))?sy_:sx_)-1):(u&15),b=bh>>2,h=bh&3;
    DiffEpi E; E.lam=__uint_as_float(__builtin_amdgcn_readfirstlane(__float_as_uint(lam))); E.oscale=oscale; E.g=(const float*)uni64((unsigned long long)(norm_g+h*128)); E.mixh=(unsigned short*)uni64((unsigned long long)(mix+512+h*128));
    for(int c=0;c<2;++c)
      attn_unit<THRL>((long)__builtin_amdgcn_readfirstlane(b*SEQ),__builtin_amdgcn_readfirstlane(qb),(const bf16*)uni64((unsigned long long)(proj+aq+h*128+c*64)),(const bf16*)uni64((unsigned long long)(proj+ak+h*128+c*64)),(const bf16*)uni64((unsigned long long)(proj+av+h*128)),c,E,lds); }
}
#undef SBAR
#undef WAIT_BAR
}
constexpr int BATCH = 8, SEQ = 4096, DM = 1024, DEPTH = 2, T = BATCH * SEQ, FF = 4096;
constexpr int NP = 3584;
constexpr int AQ = 0, AK = 512, AV = 1024;
constexpr int MB0 = 1536, MQ = MB0, MK = MB0 + 256, MV = MB0 + 512, MO = MB0 + 768, MI = MB0 + 1024, MF = MB0 + 1028;
constexpr int R0 = MB0 + 1032;
constexpr int NREAL = 3464;
__host__ __device__ __forceinline__ int proj_src_col(int n) { return n < 1536 ? 1928 + n : (n < 3464 ? n - 1536 : -1); }
constexpr float C2 = 0.125f * 1.4426950408889634f;
typedef unsigned short bf16;
typedef float f32x4 __attribute__((ext_vector_type(4)));
typedef short bf16x8 __attribute__((ext_vector_type(8)));
typedef unsigned u32x4 __attribute__((ext_vector_type(4)));

__device__ __forceinline__ float bf2f(bf16 v) { return __uint_as_float(((unsigned)v) << 16); }
__device__ __forceinline__ unsigned f2bf(float f) { unsigned u = __float_as_uint(f); return (u + 0x7fffu + ((u >> 16) & 1u)) >> 16; }
template <int X> __device__ __forceinline__ float xor_lane(float v) {
    if constexpr (X < 32) return __int_as_float(__builtin_amdgcn_ds_swizzle(__float_as_int(v), (X << 10) | 0x1f));
    else { auto rr = __builtin_amdgcn_permlane32_swap(__float_as_uint(v), __float_as_uint(v), false, false); return __uint_as_float((threadIdx.x & 32) ? rr[0] : rr[1]); }
}
#define DPP_F(old, src, ctrl, rmask, bctl) __int_as_float(__builtin_amdgcn_update_dpp(__float_as_int(old), __float_as_int(src), ctrl, rmask, 0xf, bctl))
__device__ __forceinline__ float wave_sum(float v) {
    v += DPP_F(0.f, v, 0x111, 0xf, true); v += DPP_F(0.f, v, 0x112, 0xf, true); v += DPP_F(0.f, v, 0x114, 0xf, true); v += DPP_F(0.f, v, 0x118, 0xf, true);
    v += DPP_F(0.f, v, 0x142, 0xa, true); v += DPP_F(0.f, v, 0x143, 0xc, true);
    return __int_as_float(__builtin_amdgcn_readlane(__float_as_int(v), 63));
}
__device__ __forceinline__ float wave_max(float v) {
    v = fmaxf(v, DPP_F(v, v, 0x111, 0xf, false)); v = fmaxf(v, DPP_F(v, v, 0x112, 0xf, false)); v = fmaxf(v, DPP_F(v, v, 0x114, 0xf, false)); v = fmaxf(v, DPP_F(v, v, 0x118, 0xf, false));
    v = fmaxf(v, DPP_F(v, v, 0x142, 0xa, false)); v = fmaxf(v, DPP_F(v, v, 0x143, 0xc, false));
    return __int_as_float(__builtin_amdgcn_readlane(__float_as_int(v), 63));
}
__device__ __forceinline__ float wave_scan_sum(float v) {
    v += DPP_F(0.f, v, 0x111, 0xf, true); v += DPP_F(0.f, v, 0x112, 0xf, true); v += DPP_F(0.f, v, 0x114, 0xf, true); v += DPP_F(0.f, v, 0x118, 0xf, true);
    v += DPP_F(0.f, v, 0x142, 0xa, true); v += DPP_F(0.f, v, 0x143, 0xc, true);
    return v;
}
__device__ __forceinline__ float wave_scan_max(float v) {
    v = fmaxf(v, DPP_F(v, v, 0x111, 0xf, false)); v = fmaxf(v, DPP_F(v, v, 0x112, 0xf, false)); v = fmaxf(v, DPP_F(v, v, 0x114, 0xf, false)); v = fmaxf(v, DPP_F(v, v, 0x118, 0xf, false));
    v = fmaxf(v, DPP_F(v, v, 0x142, 0xa, false)); v = fmaxf(v, DPP_F(v, v, 0x143, 0xc, false));
    return v;
}
__device__ __forceinline__ float sum_q4(float v) { v += xor_lane<16>(v);
    auto rr = __builtin_amdgcn_permlane32_swap(__float_as_uint(v), __float_as_uint(v), false, false); return __uint_as_float(rr[0]) + __uint_as_float(rr[1]); }
__device__ __forceinline__ float lane_up(float v, int lane, int o) { return __int_as_float(__builtin_amdgcn_ds_bpermute((lane - o) << 2, __float_as_int(v))); }
__device__ __forceinline__ float sigmoidf_(float x) { return 1.f / (1.f + __expf(-x)); }
__device__ __forceinline__ float softplusf_(float x) { return fmaxf(x, 0.f) + log1pf(__expf(-fabsf(x))); }
__device__ __forceinline__ float softplus_fast(float x) { return fmaxf(x, 0.f) + 0.6931471805599453f * __builtin_amdgcn_logf(1.f + __builtin_amdgcn_exp2f(-1.4426950408889634f * fabsf(x))); }

constexpr size_t MiB = 1u << 20;
constexpr size_t WS_CTL = 0;
constexpr size_t WS_WIN = 1 * MiB;
constexpr size_t WS_WOUT = WS_WIN + 14 * MiB;
constexpr size_t WS_WUP = WS_WOUT + 4 * MiB;
constexpr size_t WS_WDN = WS_WUP + 16 * MiB;
constexpr size_t WS_XB = 51 * MiB;
constexpr size_t WS_PROJ = 115 * MiB;
constexpr size_t WS_MIX = 339 * MiB;
constexpr size_t WS_RWG = 403 * MiB, WS_RWH = 419 * MiB, WS_RWRH = 435 * MiB, WS_RWYL = 451 * MiB, WS_GATE = 467 * MiB, WS_BON = 483 * MiB;
constexpr size_t WS_SCR = 51 * MiB;
constexpr size_t WS_HID = 115 * MiB;
constexpr size_t WS_MLC = 484 * MiB, WS_MLN = 500 * MiB, WS_MLS = 501 * MiB;
constexpr size_t WS_SSQ = 502 * MiB;
constexpr size_t WS_END = 504 * MiB;

#ifndef LAS
#define LAS __attribute__((address_space(3)))
#endif
#define XB_TMO      128
#define XB_XCNT(j)  (256  + 64 * (j))
#define XB_XSUB(j)  (1280 + 64 * (j))
#define XB_XGEN(j)  (2304 + 64 * (j))
#define XB_TOP      3328
#define XB_TOPGEN   3392
#define XCD_BAR_WORDS 3456
#define XB_SPIN_CAP (1u << 18)

__device__ __forceinline__ unsigned xb_ld(unsigned* p)              { return __hip_atomic_load(p, __ATOMIC_RELAXED, __HIP_MEMORY_SCOPE_AGENT); }
__device__ __forceinline__ unsigned xb_add(unsigned* p, unsigned v) { return __hip_atomic_fetch_add(p, v, __ATOMIC_RELAXED, __HIP_MEMORY_SCOPE_AGENT); }
__device__ __forceinline__ unsigned xb_xcc_id() { return (unsigned)__builtin_amdgcn_s_getreg((3 << 11) | 20) & 0xFu; }
#define XB_SPIN(cond, bar) do { unsigned _sp = 0; while (cond) { __builtin_amdgcn_s_sleep(1); \
    if ((++_sp & 255u) == 0u) { if (xb_ld(&(bar)[XB_TMO])) break; if (_sp > XB_SPIN_CAP) { atomicAdd(&(bar)[XB_TMO], 1u); break; } } } } while (0)

struct XcdBarrier {
    unsigned* bar; unsigned x;
    volatile LAS unsigned* st;
};

__device__ __forceinline__ XcdBarrier xcd_barrier_post(unsigned* bar, volatile LAS unsigned* st) {
    XcdBarrier b; b.bar = bar; b.x = xb_xcc_id(); b.st = st;
    if (threadIdx.x == 0) (void)xb_add(&bar[XB_XCNT(b.x)], 1u);
    return b;
}
__device__ __forceinline__ void xcd_barrier_complete(unsigned* bar, unsigned x, unsigned& nloc, unsigned& nx) {
    const unsigned G = gridDim.x * gridDim.y * gridDim.z;
    unsigned sum, cnt, mine, sp = 0u;
    for (;;) {
        sum = 0u; cnt = 0u; mine = 0u;
#pragma unroll
        for (unsigned j = 0; j < 16; ++j) { const unsigned c = xb_ld(&bar[XB_XCNT(j)]); sum += c; cnt += (c > 0u) ? 1u : 0u; mine = (j == x) ? c : mine; }
        if (sum == G) break;
        __builtin_amdgcn_s_sleep(1);
        if ((++sp & 255u) == 0u) { if (xb_ld(&bar[XB_TMO])) break; if (sp > XB_SPIN_CAP) { atomicAdd(&bar[XB_TMO], 1u); break; } }
    }
    nloc = mine > 0u ? mine : 1u; nx = cnt > 0u ? cnt : 1u;
}

__device__ __forceinline__ void xcd_barrier(const XcdBarrier& b) {
    asm volatile("s_waitcnt vmcnt(0)" ::: "memory");
    __syncthreads();
    if (threadIdx.x == 0) {
        unsigned* bar = b.bar;
        __builtin_amdgcn_s_waitcnt(0);
        unsigned nloc = b.st[0], nx = b.st[1];
        if (nloc == 0u) { xcd_barrier_complete(bar, b.x, nloc, nx); b.st[0] = nloc; b.st[1] = nx; }
        const unsigned old = xb_add(&bar[XB_XSUB(b.x)], 1u);
        const unsigned gen = old / nloc;
        if (old + 1u == (gen + 1u) * nloc) {
            __builtin_amdgcn_fence(__ATOMIC_RELEASE, "agent");
            asm volatile("s_waitcnt vmcnt(0)" ::: "memory");
            const unsigned og = xb_add(&bar[XB_TOP], 1u);
            const unsigned tg = og / nx;
            if (og + 1u == (tg + 1u) * nx) xb_add(&bar[XB_TOPGEN], 1u);
            else XB_SPIN(xb_ld(&bar[XB_TOPGEN]) == tg, bar);
            __builtin_amdgcn_fence(__ATOMIC_ACQUIRE, "agent");
            xb_add(&bar[XB_XGEN(b.x)], 1u);
            asm volatile("s_waitcnt vmcnt(0)" ::: "memory");
        } else {
            XB_SPIN(xb_ld(&bar[XB_XGEN(b.x)]) == gen, bar);
            __builtin_amdgcn_fence(__ATOMIC_ACQUIRE, "agent");
            asm volatile("s_waitcnt vmcnt(0)" ::: "memory");
        }
    }
    __syncthreads();
}

namespace rw {
typedef __attribute__((address_space(3))) unsigned char lds_u8;
typedef __attribute__((address_space(3))) unsigned short lds_bf;
typedef __attribute__((address_space(3))) float lds_f32;
constexpr int TS = 72, TILE_B = 64 * TS * 2;
constexpr int MISC_OFF = 15 * TILE_B;
__device__ __forceinline__ lds_bf* slot(lds_u8* lds, int i) { return (lds_bf*)(lds + i * TILE_B); }
typedef float f32x2_t __attribute__((ext_vector_type(2))); typedef __bf16 bf16x2_t __attribute__((ext_vector_type(2)));
__device__ __forceinline__ unsigned pk(float lo, float hi) { f32x2_t v = {lo, hi}; bf16x2_t b = __builtin_convertvector(v, bf16x2_t); return __builtin_bit_cast(unsigned, b); }
__device__ __forceinline__ unsigned short bf1(float x) { return (unsigned short)pk(x, x); }
__device__ __forceinline__ f32x4 mma64(const lds_bf* A, const lds_bf* Bt, int mt, int nt, int lane, f32x4 acc) {
    const int r = lane & 15, q = lane >> 4;
    const lds_bf* ap = A + (mt * 16 + r) * TS + q * 8; const lds_bf* bp = Bt + (nt * 16 + r) * TS + q * 8;
    const bf16x8 a0 = *(const __attribute__((address_space(3))) bf16x8*)ap, a1 = *(const __attribute__((address_space(3))) bf16x8*)(ap + 32);
    const bf16x8 b0 = *(const __attribute__((address_space(3))) bf16x8*)bp, b1 = *(const __attribute__((address_space(3))) bf16x8*)(bp + 32);
    acc = __builtin_amdgcn_mfma_f32_16x16x32_bf16(a0, b0, acc, 0, 0, 0);
    acc = __builtin_amdgcn_mfma_f32_16x16x32_bf16(a1, b1, acc, 0, 0, 0);
    return acc;
}
__device__ __forceinline__ void st_nm(lds_bf* tile, int mt, int nt, int lane, f32x4 v) {
    typedef unsigned u32x2 __attribute__((ext_vector_type(2)));
    u32x2 w; w.x = pk(v[0], v[1]); w.y = pk(v[2], v[3]);
    *(__attribute__((address_space(3))) u32x2*)(tile + (nt * 16 + (lane & 15)) * TS + mt * 16 + (lane >> 4) * 4) = w;
}
__device__ __forceinline__ f32x4 ld_nm(const lds_bf* tile, int mt, int nt, int lane) {
    typedef unsigned u32x2 __attribute__((ext_vector_type(2)));
    const u32x2 w = *(const __attribute__((address_space(3))) u32x2*)(tile + (nt * 16 + (lane & 15)) * TS + mt * 16 + (lane >> 4) * 4);
    return (f32x4){__uint_as_float(w.x << 16), __uint_as_float(w.x & 0xffff0000u), __uint_as_float(w.y << 16), __uint_as_float(w.y & 0xffff0000u)};
}
__device__ __forceinline__ void st_mn(lds_bf* tile, int mt, int nt, int lane, f32x4 v) {
    lds_bf* p = tile + (mt * 16 + (lane >> 4) * 4) * TS + nt * 16 + (lane & 15);
    const unsigned w01 = pk(v[0], v[1]), w23 = pk(v[2], v[3]);
    p[0] = (unsigned short)w01; p[TS] = (unsigned short)(w01 >> 16); p[2 * TS] = (unsigned short)w23; p[3 * TS] = (unsigned short)(w23 >> 16);
}
struct W { const float *mu, *w0, *w_up, *a0, *a_up, *g_up, *k_k, *k_a, *r_k, *ln_g, *ln_b; };
struct Buf { bf16* G; bf16* H; bf16* RH; bf16* YL; bf16* GATE; float* BON; };

}
namespace ml {
struct P { const float *cw, *cb, *b_i, *b_f, *norm_g; };
struct Buf { bf16* C; float* N; float* SC; };
__device__ void m1_gates(rw::lds_u8* lds, int unit, int lane, float igv, float fgv, const Buf& o);
__device__ void m1_tiles(rw::lds_u8* lds, int lane, int wv, const float (&xk)[11], const float (&cwv)[5], const float (&vv)[8], int s0);
__device__ void m1_product(rw::lds_u8* lds, int unit, int lane, int wv, const Buf& o); }
namespace rw {
#define RW_SYNC() asm volatile("s_waitcnt lgkmcnt(0)\n\ts_barrier" ::: "memory")
struct R1W { float muA, wuv[4], auv[4], guv[8], mur, muk, muv, w0, a0, kkc, kac, rkc, cwv[5], gbi, gbf; };
__device__ __forceinline__ void r1_load_w(R1W& Q, int h, const W& w, const ml::P& mp) {
    int tid_ = threadIdx.x; asm volatile("" : "+v"(tid_));
    const int tid = tid_, lane = tid & 63, wv = __builtin_amdgcn_readfirstlane(tid >> 6), colA = tid & 127, hc = h * 64 + lane;
    Q.muA = w.mu[768 + colA];
#pragma unroll
    for (int i = 0; i < 4; ++i) { Q.wuv[i] = w.w_up[(wv + 8 * i) * 256 + hc]; Q.auv[i] = w.a_up[(wv + 8 * i) * 256 + hc]; }
#pragma unroll
    for (int i = 0; i < 8; ++i) Q.guv[i] = w.g_up[(wv + 8 * i) * 256 + hc];
    Q.mur = w.mu[hc]; Q.muk = w.mu[256 + hc]; Q.muv = w.mu[512 + hc]; Q.w0 = w.w0[hc]; Q.a0 = w.a0[hc]; Q.kkc = w.k_k[hc]; Q.kac = w.k_a[hc]; Q.rkc = w.r_k[hc];
#pragma unroll
    for (int i = 0; i < 4; ++i) Q.cwv[i] = mp.cw[i * 512 + 256 + hc];
    Q.cwv[4] = mp.cb[256 + hc]; Q.gbi = mp.b_i[h]; Q.gbf = mp.b_f[h];
}
__device__ __forceinline__ void r1_unit(lds_u8* lds, int unit, const R1W& Q, const bf16* __restrict__ proj, const W& w, const Buf& o, const ml::P& mp, const ml::Buf& mo) {
    int tid_ = threadIdx.x; asm volatile("" : "+v"(tid_));
    const int tid = tid_, lane = tid & 63, wv = __builtin_amdgcn_readfirstlane(tid >> 6);
    const int ch = unit & 63, bh = unit >> 6, h = bh & 3, b = bh >> 2;
    const size_t t0 = (size_t)b * SEQ + ch * 64;
    lds_bf* S0 = slot(lds, 0); lds_bf* S1 = slot(lds, 1); lds_bf* S2 = slot(lds, 2); lds_bf* S3 = slot(lds, 3); lds_bf* S4 = slot(lds, 4); lds_bf* S5 = slot(lds, 5); lds_bf* S6 = slot(lds, 6);
    lds_bf* S7 = slot(lds, 7); lds_bf* S8 = slot(lds, 8); lds_bf* S9 = slot(lds, 9); lds_bf* S10 = slot(lds, 10); lds_bf* S11 = slot(lds, 11); lds_bf* S12 = slot(lds, 12);
    lds_f32* gamL = (lds_f32*)(lds + MISC_OFF); lds_f32* part = gamL + 64;
    const bool first = (ch == 0);
    const int colA = tid & 127, tgA = tid >> 7;
    const bf16* pcA = proj + (t0 + tgA * 16) * NP + R0 + 768 + colA;
    bf16 rA[17];
    rA[0] = pcA[-(long)NP];
#pragma unroll
    for (int i = 0; i < 16; ++i) rA[1 + i] = pcA[(size_t)i * NP];
    const float muA = Q.muA;
    float igv = 0.f, fgv = 0.f;
    if (wv == 7) { const bf16* pr = proj + (t0 + lane) * NP; const bf16 gi = pr[MI + h], gf = pr[MF + h]; igv = bf2f(gi) + Q.gbi; fgv = bf2f(gf) + Q.gbf; }
    const int hc = h * 64 + lane;
    const bf16* pcC = proj + (t0 + wv * 8) * NP + R0 + hc;
    bf16 rC[9][3];
#pragma unroll
    for (int j = 0; j < 3; ++j) rC[0][j] = pcC[-(long)NP + 256 * j];
#pragma unroll
    for (int i = 0; i < 8; ++i)
#pragma unroll
        for (int j = 0; j < 3; ++j) rC[1 + i][j] = pcC[(size_t)i * NP + 256 * j];
    const float mur = Q.mur, muk = Q.muk, muv = Q.muv, w0 = Q.w0, a0 = Q.a0, kkc = Q.kkc, kac = Q.kac, rkc = Q.rkc;
    float xk[11], cwv[5], mvv[8];
    { const bf16* pk_ = proj + (t0 + wv * 8) * NP + MK + hc; const bf16* pv = proj + (t0 + wv * 8) * NP + MV + hc; bf16 rk[11], rv[8];
#pragma unroll
      for (int i = 0; i < 11; ++i) rk[i] = pk_[((long)i - 3) * NP];
#pragma unroll
      for (int i = 0; i < 8; ++i) rv[i] = pv[(size_t)i * NP];
#pragma unroll
      for (int i = 0; i < 5; ++i) cwv[i] = Q.cwv[i];
#pragma unroll
      for (int i = 0; i < 11; ++i) xk[i] = bf2f(rk[i]);
#pragma unroll
      for (int i = 0; i < 8; ++i) mvv[i] = bf2f(rv[i]); }
    constexpr int LS = 136;
    lds_bf* Lt = S0;
    lds_bf* Wu = (lds_bf*)(lds + 2 * TILE_B);
    lds_bf* Au = Wu + 64 * 40;
    lds_bf* Gu = Au + 64 * 40;
    { const int col = colA, tg = tgA; const float mu = muA; const float esc = col < 32 ? 2.885390081777927f : -1.4426950408889634f;
      float prev = (first && tg == 0) ? 0.f : bf2f(rA[0]);
#pragma unroll
      for (int i = 0; i < 16; ++i) { const float p = bf2f(rA[1 + i]); const float x = p + (prev - p) * mu; prev = p;
          const float rc = __builtin_amdgcn_rcpf(1.f + __builtin_amdgcn_exp2f(x * esc));
          const float y = col < 32 ? 1.f - 2.f * rc : (col < 64 ? x : rc);
          Lt[(tg * 16 + i) * LS + col] = bf1(y); }
      const int c = lane;
#pragma unroll
      for (int i = 0; i < 4; ++i) { const int k = wv + 8 * i; Wu[c * 40 + k] = (unsigned short)f2bf(Q.wuv[i]); Au[c * 40 + k] = (unsigned short)f2bf(Q.auv[i]); }
#pragma unroll
      for (int i = 0; i < 8; ++i) { const int k = wv + 8 * i; Gu[c * TS + k] = (unsigned short)f2bf(Q.guv[i]); } }
    if (wv == 7) ml::m1_gates(lds, unit, lane, igv, fgv, mo);
    RW_SYNC();
    lds_f32* Fw = (lds_f32*)(lds + 8 * TILE_B); lds_f32* Fa = Fw + 4096; lds_bf* Fg = (lds_bf*)(Fa + 4096);
    { const int r = lane & 15, q = lane >> 4, mt = wv >> 1;
#pragma unroll
      for (int tt = 0; tt < 2; ++tt) { const int nt = (wv & 1) * 2 + tt;
          const bf16x8 aw = *(const __attribute__((address_space(3))) bf16x8*)(Lt + (mt * 16 + r) * LS + q * 8);
          const bf16x8 aa = *(const __attribute__((address_space(3))) bf16x8*)(Lt + (mt * 16 + r) * LS + 32 + q * 8);
          const bf16x8 ag0 = *(const __attribute__((address_space(3))) bf16x8*)(Lt + (mt * 16 + r) * LS + 64 + q * 8);
          const bf16x8 ag1 = *(const __attribute__((address_space(3))) bf16x8*)(Lt + (mt * 16 + r) * LS + 96 + q * 8);
          const bf16x8 bw = *(const __attribute__((address_space(3))) bf16x8*)(Wu + (nt * 16 + r) * 40 + q * 8);
          const bf16x8 ba = *(const __attribute__((address_space(3))) bf16x8*)(Au + (nt * 16 + r) * 40 + q * 8);
          const bf16x8 bg0 = *(const __attribute__((address_space(3))) bf16x8*)(Gu + (nt * 16 + r) * TS + q * 8);
          const bf16x8 bg1 = *(const __attribute__((address_space(3))) bf16x8*)(Gu + (nt * 16 + r) * TS + 32 + q * 8);
          const f32x4 z = {0.f, 0.f, 0.f, 0.f};
          const f32x4 fw = __builtin_amdgcn_mfma_f32_16x16x32_bf16(aw, bw, z, 0, 0, 0);
          const f32x4 fa = __builtin_amdgcn_mfma_f32_16x16x32_bf16(aa, ba, z, 0, 0, 0);
          f32x4 fg = __builtin_amdgcn_mfma_f32_16x16x32_bf16(ag0, bg0, z, 0, 0, 0); fg = __builtin_amdgcn_mfma_f32_16x16x32_bf16(ag1, bg1, fg, 0, 0, 0);
#pragma unroll
          for (int e = 0; e < 4; ++e) { const int t = mt * 16 + q * 4 + e, c = nt * 16 + r; Fw[t * 64 + c] = fw[e]; Fa[t * 64 + c] = fa[e]; Fg[t * TS + c] = bf1(fg[e]); } } }
    RW_SYNC();
    ml::m1_tiles(lds, lane, wv, xk, cwv, mvv, ch * 64 + wv * 8);
    { const int c = lane, tg = wv;
      float pr, pk_, pv; if (first && tg == 0) { pr = 0.f; pk_ = 0.f; pv = 0.f; } else { pr = bf2f(rC[0][0]); pk_ = bf2f(rC[0][1]); pv = bf2f(rC[0][2]); }
      float rr[8], k2[8], vv[8], ap[8], bp[8], lw[8];
#pragma unroll
      for (int i = 0; i < 8; ++i) { const int t = tg * 8 + i;
          const float xr = bf2f(rC[1 + i][0]), xk_ = bf2f(rC[1 + i][1]), xv = bf2f(rC[1 + i][2]);
          const float r = xr + (pr - xr) * mur, k = xk_ + (pk_ - xk_) * muk, v = xv + (pv - xv) * muv; pr = xr; pk_ = xk_; pv = xv;
          lw[i] = -0.8750440158f * __builtin_amdgcn_rcpf(1.f + __builtin_amdgcn_exp2f(-1.4426950408889634f * (w0 + Fw[t * 64 + c])));
          const float a = __builtin_amdgcn_rcpf(1.f + __builtin_amdgcn_exp2f(-1.4426950408889634f * (a0 + Fa[t * 64 + c])));
          float kk = k * kkc; const float ss = wave_sum(kk * kk); kk = kk * __builtin_amdgcn_rsqf(fmaxf(ss, 1e-24f));
          const float kx = k * (1.f + (a - 1.f) * kac);
          const float bon = wave_sum(r * kx * rkc);
          rr[i] = r; k2[i] = kx; vv[i] = v; ap[i] = -kk; bp[i] = kk * a;
          o.GATE[(t0 + t) * 256 + hc] = Fg[t * TS + c];
          if (c == 0) o.BON[(t0 + t) * 4 + h] = bon; }
      float cl[8]; float run = 0.f;
#pragma unroll
      for (int i = 0; i < 8; ++i) { run += lw[i]; cl[i] = run; }
      part[tg * 64 + c] = run;
      RW_SYNC();
      float off = 0.f, tot = 0.f;
#pragma unroll
      for (int g = 0; g < 8; ++g) { const float pgv = part[g * 64 + c]; if (g < tg) off += pgv; tot += pgv; }
      const float gtot = __builtin_amdgcn_exp2f(tot);
      if (tg == 0) gamL[c] = gtot;
      typedef unsigned u32x4v __attribute__((ext_vector_type(4)));
      float at[8], vt[8], bb[8], kb[8];
      float gp = __builtin_amdgcn_exp2f(off);
#pragma unroll
      for (int i = 0; i < 8; ++i) { const int t = tg * 8 + i;
          const float g = __builtin_amdgcn_exp2f(off + cl[i]), ig = __builtin_amdgcn_rcpf(g), gl = gtot * ig;
          at[i] = ap[i] * gp; vt[i] = vv[i]; bb[i] = bp[i] * gl; kb[i] = k2[i] * gl; gp = g;
          const unsigned w01 = pk(bp[i] * ig, k2[i] * ig), w23 = pk(at[i], rr[i] * g);
          S0[t * TS + c] = (unsigned short)w01; S1[t * TS + c] = (unsigned short)(w01 >> 16); S2[t * TS + c] = (unsigned short)w23; S3[t * TS + c] = (unsigned short)(w23 >> 16); }
      u32x4v x;
      x.x = pk(at[0], at[1]); x.y = pk(at[2], at[3]); x.z = pk(at[4], at[5]); x.w = pk(at[6], at[7]); *(__attribute__((address_space(3))) u32x4v*)(S4 + c * TS + tg * 8) = x;
      x.x = pk(vt[0], vt[1]); x.y = pk(vt[2], vt[3]); x.z = pk(vt[4], vt[5]); x.w = pk(vt[6], vt[7]); *(__attribute__((address_space(3))) u32x4v*)(S5 + c * TS + tg * 8) = x;
      x.x = pk(bb[0], bb[1]); x.y = pk(bb[2], bb[3]); x.z = pk(bb[4], bb[5]); x.w = pk(bb[6], bb[7]); *(__attribute__((address_space(3))) u32x4v*)(S6 + c * TS + tg * 8) = x;
      x.x = pk(kb[0], kb[1]); x.y = pk(kb[2], kb[3]); x.z = pk(kb[4], kb[5]); x.w = pk(kb[6], kb[7]); *(__attribute__((address_space(3))) u32x4v*)(S7 + c * TS + tg * 8) = x; }
    RW_SYNC();
    const int mt = wv >> 1, r16 = lane & 15, q4 = lane >> 4;
    const f32x4 Z = {0.f, 0.f, 0.f, 0.f};
    f32x4 mab[2], mkb[2], mbr[2], mkr[2];
#pragma unroll
    for (int tt = 0; tt < 2; ++tt) { const int nt = (wv & 1) * 2 + tt;
        mab[tt] = mma64(S0, S2, mt, nt, lane, Z); mkb[tt] = mma64(S1, S2, mt, nt, lane, Z); mbr[tt] = mma64(S0, S3, mt, nt, lane, Z); mkr[tt] = mma64(S1, S3, mt, nt, lane, Z);
#pragma unroll
        for (int e = 0; e < 4; ++e) { const int s = mt * 16 + q4 * 4 + e, t = nt * 16 + r16; if (!(s < t)) { mab[tt][e] = 0.f; mkb[tt][e] = 0.f; } if (!(s <= t)) { mbr[tt][e] = 0.f; mkr[tt][e] = 0.f; } } }
    ml::m1_product(lds, unit, lane, wv, mo);
    lds_bf* SA = (lds_bf*)(lds + MISC_OFF + 4608);
#pragma unroll
    for (int tt = 0; tt < 2; ++tt) { const int nt = (wv & 1) * 2 + tt;
        st_mn(S11, mt, nt, lane, mab[tt]); st_nm(S12, mt, nt, lane, mab[tt]);
        f32x4 ti = mab[tt];
#pragma unroll
        for (int e = 0; e < 4; ++e) if (mt * 16 + q4 * 4 + e == nt * 16 + r16) ti[e] += 1.f;
        st_nm(SA, mt, nt, lane, ti); st_nm(S8, mt, nt, lane, mkb[tt]); st_nm(S9, mt, nt, lane, mbr[tt]); st_nm(S10, mt, nt, lane, mkr[tt]); }
    RW_SYNC();
    { f32x4 pp[2], tn[2];
#define R1_E_STEP(PA, PB, TI, QA, QB, TO, SQUARE) do { \
      _Pragma("unroll") for (int tt = 0; tt < 2; ++tt) { const int nt = (wv & 1) * 2 + tt; tn[tt] = mma64(PA, TI, mt, nt, lane, ld_nm(TI, mt, nt, lane)); if (SQUARE) pp[tt] = mma64(PA, PB, mt, nt, lane, Z); } \
      _Pragma("unroll") for (int tt = 0; tt < 2; ++tt) { const int nt = (wv & 1) * 2 + tt; st_nm(TO, mt, nt, lane, tn[tt]); if (SQUARE) { st_mn(QA, mt, nt, lane, pp[tt]); st_nm(QB, mt, nt, lane, pp[tt]); } } \
      RW_SYNC(); } while (0)
#pragma unroll
      for (int tt = 0; tt < 2; ++tt) pp[tt] = mma64(S11, S12, mt, (wv & 1) * 2 + tt, lane, Z);
#pragma unroll
      for (int tt = 0; tt < 2; ++tt) { st_mn(S0, mt, (wv & 1) * 2 + tt, lane, pp[tt]); st_nm(S1, mt, (wv & 1) * 2 + tt, lane, pp[tt]); }
      RW_SYNC();
      R1_E_STEP(S0, S1, SA, S11, S12, S2, true);
      R1_E_STEP(S11, S12, S2, S0, S1, SA, true);
      R1_E_STEP(S0, S1, SA, S11, S12, S2, true);
      R1_E_STEP(S11, S12, S2, S0, S1, SA, true);
      R1_E_STEP(S0, S1, SA, S11, S12, S2, false);
#undef R1_E_STEP
    }
#pragma unroll
    for (int tt = 0; tt < 2; ++tt) { const int nt = (wv & 1) * 2 + tt; st_nm(S11, mt, nt, lane, mma64(S2, S4, mt, nt, lane, Z)); st_nm(S0, mt, nt, lane, mma64(S8, S5, mt, nt, lane, Z)); }
    RW_SYNC();
    { bf16* gG = o.G + (size_t)unit * 4096; bf16* gRH = o.RH + (size_t)unit * 4096;
      typedef unsigned u32x2 __attribute__((ext_vector_type(2)));
#pragma unroll
      for (int tt = 0; tt < 2; ++tt) { const int nt = (wv & 1) * 2 + tt;
          st_nm(S12, mt, nt, lane, mma64(S2, S0, mt, nt, lane, Z));
          f32x4 rh = mma64(S11, S9, mt, nt, lane, ld_nm(S3, mt, nt, lane));
          { u32x2 wv2; wv2.x = pk(rh[0], rh[1]); wv2.y = pk(rh[2], rh[3]); *(u32x2*)(gRH + (nt * 16 + r16) * 64 + mt * 16 + q4 * 4) = wv2; }
          f32x4 g = mma64(S11, S6, mt, nt, lane, Z);
#pragma unroll
          for (int e = 0; e < 4; ++e) if (mt * 16 + q4 * 4 + e == nt * 16 + r16) g[e] += gamL[nt * 16 + r16];
          { u32x2 wv2; wv2.x = pk(g[0], g[1]); wv2.y = pk(g[2], g[3]); *(u32x2*)(gG + ((nt * 2 + (mt >> 1)) * 64 + lane) * 8 + (mt & 1) * 4) = wv2; } } }
    RW_SYNC();
    { bf16* gH = o.H + (size_t)unit * 4096; bf16* gYL = o.YL + (size_t)unit * 4096;
      typedef unsigned u32x2 __attribute__((ext_vector_type(2)));
#pragma unroll
      for (int tt = 0; tt < 2; ++tt) { const int nt = (wv & 1) * 2 + tt;
          f32x4 y = mma64(S12, S9, mt, nt, lane, Z); y = mma64(S5, S10, mt, nt, lane, y);
          { u32x2 wv2; wv2.x = pk(y[0], y[1]); wv2.y = pk(y[2], y[3]); *(u32x2*)(gYL + ((mt * 4 + nt) * 64 + lane) * 4) = wv2; }
          f32x4 hh = mma64(S6, S12, mt, nt, lane, Z); hh = mma64(S7, S5, mt, nt, lane, hh);
          { u32x2 wv2; wv2.x = pk(hh[0], hh[1]); wv2.y = pk(hh[2], hh[3]); *(u32x2*)(gH + ((mt * 4 + nt) * 64 + lane) * 4) = wv2; } } }
    RW_SYNC();
}

struct ScanStage { bf16x8 g[4][2]; unsigned hx[4], hy[4]; };
__device__ __forceinline__ void scan_load(ScanStage& st, const bf16* gG, const bf16* gH, int c, int nt, int lane) {
    typedef unsigned u32x2 __attribute__((ext_vector_type(2)));
    const bf16* gn = gG + (size_t)c * 4096; const bf16* hn = gH + (size_t)c * 4096;
#pragma unroll
    for (int m = 0; m < 4; ++m) { st.g[m][0] = *(const bf16x8*)(gn + ((m * 2 + 0) * 64 + lane) * 8); st.g[m][1] = *(const bf16x8*)(gn + ((m * 2 + 1) * 64 + lane) * 8);
        const u32x2 h = *(const u32x2*)(hn + ((m * 4 + nt) * 64 + lane) * 4); st.hx[m] = h.x; st.hy[m] = h.y; }
}
__device__ __forceinline__ void scan_step(const ScanStage& st, f32x4 (&acc)[4], bf16* gH, int c, int nt, int lane) {
    typedef unsigned u32x2 __attribute__((ext_vector_type(2))); typedef unsigned u32x4v __attribute__((ext_vector_type(4)));
    f32x4 hin[4];
#pragma unroll
    for (int m = 0; m < 4; ++m) hin[m] = (f32x4){__uint_as_float(st.hx[m] << 16), __uint_as_float(st.hx[m] & 0xffff0000u), __uint_as_float(st.hy[m] << 16), __uint_as_float(st.hy[m] & 0xffff0000u)};
    u32x4v b0, b1;
    b0.x = pk(acc[0][0], acc[0][1]); b0.y = pk(acc[0][2], acc[0][3]); b0.z = pk(acc[1][0], acc[1][1]); b0.w = pk(acc[1][2], acc[1][3]);
    b1.x = pk(acc[2][0], acc[2][1]); b1.y = pk(acc[2][2], acc[2][3]); b1.z = pk(acc[3][0], acc[3][1]); b1.w = pk(acc[3][2], acc[3][3]);
    bf16* hc = gH + (size_t)c * 4096;
    *(u32x2*)(hc + ((0 * 4 + nt) * 64 + lane) * 4) = (u32x2){b0.x, b0.y}; *(u32x2*)(hc + ((1 * 4 + nt) * 64 + lane) * 4) = (u32x2){b0.z, b0.w};
    *(u32x2*)(hc + ((2 * 4 + nt) * 64 + lane) * 4) = (u32x2){b1.x, b1.y}; *(u32x2*)(hc + ((3 * 4 + nt) * 64 + lane) * 4) = (u32x2){b1.z, b1.w};
    const bf16x8 bf0 = __builtin_bit_cast(bf16x8, b0), bf1 = __builtin_bit_cast(bf16x8, b1);
#pragma unroll
    for (int m = 0; m < 4; ++m) { f32x4 a = hin[m]; a = __builtin_amdgcn_mfma_f32_16x16x32_bf16(st.g[m][0], bf0, a, 0, 0, 0); a = __builtin_amdgcn_mfma_f32_16x16x32_bf16(st.g[m][1], bf1, a, 0, 0, 0); acc[m] = a; }
}
__device__ __forceinline__ void scan_bh(int bh, int nt, int lane, const Buf& o) {
    f32x4 acc[4];
#pragma unroll
    for (int m = 0; m < 4; ++m) acc[m] = (f32x4){0.f, 0.f, 0.f, 0.f};
    const bf16* gG = o.G + (size_t)bh * 64 * 4096; bf16* gH = o.H + (size_t)bh * 64 * 4096;
    ScanStage s0, s1, s2, s3;
    scan_load(s0, gG, gH, 0, nt, lane); scan_load(s1, gG, gH, 1, nt, lane); scan_load(s2, gG, gH, 2, nt, lane); scan_load(s3, gG, gH, 3, nt, lane);
#pragma unroll 1
    for (int c = 0; c < 64; c += 4) {
        scan_step(s0, acc, gH, c, nt, lane);     if (c + 4 < 64) scan_load(s0, gG, gH, c + 4, nt, lane);
        scan_step(s1, acc, gH, c + 1, nt, lane); if (c + 5 < 64) scan_load(s1, gG, gH, c + 5, nt, lane);
        scan_step(s2, acc, gH, c + 2, nt, lane); if (c + 6 < 64) scan_load(s2, gG, gH, c + 6, nt, lane);
        scan_step(s3, acc, gH, c + 3, nt, lane); if (c + 7 < 64) scan_load(s3, gG, gH, c + 7, nt, lane);
    }
}

typedef unsigned u32x2r __attribute__((ext_vector_type(2)));
struct R3Raw { u32x2r rh[4], s[16], yl[4], pv[4], pp[4], gt[4]; float bon; f32x4 lg[4], lb[4], mu[4]; };
__device__ __forceinline__ void r3_load(R3Raw& R, int unit, int nt, int lane, const bf16* __restrict__ proj, const W& w, const Buf& o) {
    const int ch = unit & 63, bh = unit >> 6, h = bh & 3, b = bh >> 2, r16 = lane & 15, q4 = lane >> 4;
    const size_t t0 = (size_t)b * SEQ + ch * 64; const int tl = nt * 16 + r16; const size_t t = t0 + tl;
    const bf16* gS = o.H + (size_t)unit * 4096; const bf16* gRH = o.RH + (size_t)unit * 4096; const bf16* gYL = o.YL + (size_t)unit * 4096;
#pragma unroll
    for (int i = 0; i < 4; ++i) R.rh[i] = *(const u32x2r*)(gRH + tl * 64 + q4 * 4 + 16 * i);
#pragma unroll
    for (int m = 0; m < 4; ++m) {
#pragma unroll
        for (int i = 0; i < 4; ++i) R.s[m * 4 + i] = *(const u32x2r*)(gS + ((i * 4 + m) * 64 + lane) * 4);
        R.yl[m] = *(const u32x2r*)(gYL + ((m * 4 + nt) * 64 + lane) * 4); }
    R.bon = o.BON[t * 4 + h];
#pragma unroll
    for (int m = 0; m < 4; ++m) { const int hc = h * 64 + m * 16 + q4 * 4;
        R.pv[m] = *(const u32x2r*)(proj + t * NP + R0 + 512 + hc); R.pp[m] = *(const u32x2r*)(proj + ((long)t - 1) * NP + R0 + 512 + hc);
        R.gt[m] = *(const u32x2r*)(o.GATE + t * 256 + hc);
        R.lg[m] = *(const f32x4*)(w.ln_g + hc); R.lb[m] = *(const f32x4*)(w.ln_b + hc); R.mu[m] = *(const f32x4*)(w.mu + 512 + hc); }
}
__device__ __forceinline__ void r3_compute(const R3Raw& R, int unit, int nt, int lane, bf16* __restrict__ mix, int pitch, int coloff) {
    const int ch = unit & 63, bh = unit >> 6, h = bh & 3, b = bh >> 2, r16 = lane & 15, q4 = lane >> 4;
    const size_t t0 = (size_t)b * SEQ + ch * 64; const int tl = nt * 16 + r16; const size_t t = t0 + tl;
    typedef unsigned u32x4v __attribute__((ext_vector_type(4)));
    const bf16x8 bq0 = __builtin_bit_cast(bf16x8, ((u32x4v){R.rh[0].x, R.rh[0].y, R.rh[1].x, R.rh[1].y})), bq1 = __builtin_bit_cast(bf16x8, ((u32x4v){R.rh[2].x, R.rh[2].y, R.rh[3].x, R.rh[3].y}));
    f32x4 y[4];
#pragma unroll
    for (int m = 0; m < 4; ++m) {
        const u32x2r s0 = R.s[m * 4 + 0], s1 = R.s[m * 4 + 1], s2 = R.s[m * 4 + 2], s3 = R.s[m * 4 + 3];
        const bf16x8 a0 = __builtin_bit_cast(bf16x8, ((u32x4v){s0.x, s0.y, s1.x, s1.y})), a1 = __builtin_bit_cast(bf16x8, ((u32x4v){s2.x, s2.y, s3.x, s3.y}));
        const u32x2r yl = R.yl[m];
        f32x4 a = {__uint_as_float(yl.x << 16), __uint_as_float(yl.x & 0xffff0000u), __uint_as_float(yl.y << 16), __uint_as_float(yl.y & 0xffff0000u)};
        a = __builtin_amdgcn_mfma_f32_16x16x32_bf16(a0, bq0, a, 0, 0, 0); a = __builtin_amdgcn_mfma_f32_16x16x32_bf16(a1, bq1, a, 0, 0, 0); y[m] = a; }
    float s = 0.f;
#pragma unroll
    for (int m = 0; m < 4; ++m) s += (y[m][0] + y[m][1]) + (y[m][2] + y[m][3]);
    s = sum_q4(s);
    const float mean = s * (1.f / 64.f); float v2 = 0.f;
#pragma unroll
    for (int m = 0; m < 4; ++m)
#pragma unroll
        for (int e = 0; e < 4; ++e) { const float d = y[m][e] - mean; v2 += d * d; }
    v2 = sum_q4(v2);
    const float rstd = rsqrtf(v2 * (1.f / 64.f) + 64e-5f);
    const float bon = R.bon;
    const bool first = (ch == 0 && tl == 0);
#pragma unroll
    for (int m = 0; m < 4; ++m) { const int i0 = m * 16 + q4 * 4, hc = h * 64 + i0;
        const u32x2r pv = R.pv[m]; u32x2r pp = R.pp[m]; if (first) { pp.x = 0u; pp.y = 0u; }
        const u32x2r gt = R.gt[m];
        const f32x4 lg = R.lg[m], lb = R.lb[m], mu = R.mu[m];
        const float xv[4] = {__uint_as_float(pv.x << 16), __uint_as_float(pv.x & 0xffff0000u), __uint_as_float(pv.y << 16), __uint_as_float(pv.y & 0xffff0000u)};
        const float xp[4] = {__uint_as_float(pp.x << 16), __uint_as_float(pp.x & 0xffff0000u), __uint_as_float(pp.y << 16), __uint_as_float(pp.y & 0xffff0000u)};
        const float gg[4] = {__uint_as_float(gt.x << 16), __uint_as_float(gt.x & 0xffff0000u), __uint_as_float(gt.y << 16), __uint_as_float(gt.y & 0xffff0000u)};
        float ov[4];
#pragma unroll
        for (int e = 0; e < 4; ++e) { const float v = xv[e] + (xp[e] - xv[e]) * mu[e]; ov[e] = ((y[m][e] - mean) * rstd * lg[e] + lb[e] + bon * v) * gg[e]; }
        u32x2r wv2; wv2.x = pk(ov[0], ov[1]); wv2.y = pk(ov[2], ov[3]); *(u32x2r*)(mix + t * pitch + coloff + hc) = wv2; }
}
struct R3Ctx { const bf16* proj; const W* w; const Buf* o; bf16* mix;
    __device__ __forceinline__ void load(R3Raw& R, int unit, int nt, int lane) const { r3_load(R, unit, nt, lane, proj, *w, *o); }
    __device__ __forceinline__ void run(const R3Raw& R, int unit, int nt, int lane) const { r3_compute(R, unit, nt, lane, mix, DM, 256); } };
#undef RW_SYNC
}
namespace ml {
using rw::lds_u8; using rw::lds_bf; using rw::lds_f32; using rw::TS; using rw::TILE_B; using rw::slot; using rw::pk; using rw::mma64; using rw::st_nm;
__device__ __forceinline__ float wave_incl_sum(float v, int) { return wave_scan_sum(v); }
__device__ __forceinline__ float wave_incl_max(float v, int) { return wave_scan_max(v); }
__device__ __forceinline__ void conv8(const bf16* __restrict__ proj, size_t trow, int s0, int col, const float* __restrict__ cw, const float* __restrict__ cb, float scale, float* out) {
    const float w0 = cw[col], w1 = cw[512 + col], w2 = cw[1024 + col], w3 = cw[1536 + col], bb = cb[col];
    const bf16* p = proj + trow * NP + MB0 + col;
    float x0 = s0 >= 3 ? bf2f(p[-3 * (long)NP]) : 0.f, x1 = s0 >= 2 ? bf2f(p[-2 * (long)NP]) : 0.f, x2 = s0 >= 1 ? bf2f(p[-(long)NP]) : 0.f;
#pragma unroll
    for (int i = 0; i < 8; ++i) { const float x3 = bf2f(p[(size_t)i * NP]); const float y = bb + w0 * x0 + w1 * x1 + w2 * x2 + w3 * x3; out[i] = y * sigmoidf_(y) * scale; x0 = x1; x1 = x2; x2 = x3; }
}
__device__ __forceinline__ void m1_gates(lds_u8* lds, int unit, int lane, float igv, float fgv, const Buf& o) {
    lds_f32* wkp = (lds_f32*)(lds + rw::MISC_OFF + 2304);
    const float ig = igv, lf = -softplus_fast(-fgv);
    const float bt = wave_incl_sum(lf, lane), bL = __int_as_float(__builtin_amdgcn_readlane(__float_as_int(bt), 63));
    const float ge = bL - bt + ig, gmax = wave_max(ge);
    wkp[lane] = __expf(ge - gmax);
    if (lane == 0) { o.SC[(size_t)unit * 4 + 0] = bL; o.SC[(size_t)unit * 4 + 1] = gmax; }
}
__device__ __forceinline__ void m1_tiles(lds_u8* lds, int lane, int wv, const float (&xk)[11], const float (&cwv)[5], const float (&vv)[8], int s0) {
    lds_bf* Kw = slot(lds, 13); lds_bf* Vt = slot(lds, 14); lds_f32* wkp = (lds_f32*)(lds + rw::MISC_OFF + 2304); lds_f32* part = wkp + 64;
    const int c = lane, tg = wv; float kc[8];
    { float x0 = s0 >= 3 ? xk[0] : 0.f, x1 = s0 >= 2 ? xk[1] : 0.f, x2 = s0 >= 1 ? xk[2] : 0.f;
#pragma unroll
      for (int i = 0; i < 8; ++i) { const float x3 = xk[3 + i]; const float y = cwv[4] + cwv[0] * x0 + cwv[1] * x1 + cwv[2] * x2 + cwv[3] * x3; kc[i] = y * sigmoidf_(y) * 0.125f; x0 = x1; x1 = x2; x2 = x3; } }
    typedef unsigned u32x4v __attribute__((ext_vector_type(4)));
    float kw[8], dn = 0.f;
#pragma unroll
    for (int i = 0; i < 8; ++i) { const float wk = wkp[tg * 8 + i]; kw[i] = kc[i] * wk; dn += kw[i]; }
    u32x4v x; x.x = pk(kw[0], kw[1]); x.y = pk(kw[2], kw[3]); x.z = pk(kw[4], kw[5]); x.w = pk(kw[6], kw[7]); *(__attribute__((address_space(3))) u32x4v*)(Kw + c * TS + tg * 8) = x;
    x.x = pk(vv[0], vv[1]); x.y = pk(vv[2], vv[3]); x.z = pk(vv[4], vv[5]); x.w = pk(vv[6], vv[7]); *(__attribute__((address_space(3))) u32x4v*)(Vt + c * TS + tg * 8) = x;
    part[tg * 64 + c] = dn;
}
__device__ __forceinline__ void m1_product(lds_u8* lds, int unit, int lane, int wv, const Buf& o) {
    lds_bf* Kw = slot(lds, 13); lds_bf* Vt = slot(lds, 14); lds_f32* part = (lds_f32*)(lds + rw::MISC_OFF + 2304) + 64;
    const f32x4 Z = {0.f, 0.f, 0.f, 0.f}; const int mt = wv >> 1; bf16* gC = o.C + (size_t)unit * 4096;
    typedef unsigned u32x2 __attribute__((ext_vector_type(2)));
#pragma unroll
    for (int tt = 0; tt < 2; ++tt) { const int nt = (wv & 1) * 2 + tt; const f32x4 a = mma64(Kw, Vt, mt, nt, lane, Z);
        u32x2 w2; w2.x = pk(a[0], a[1]); w2.y = pk(a[2], a[3]); *(u32x2*)(gC + (nt * 16 + (lane & 15)) * 64 + mt * 16 + (lane >> 4) * 4) = w2; }
    if (wv == 0) { float s = 0.f;
#pragma unroll
        for (int g = 0; g < 8; ++g) s += part[g * 64 + lane];
        o.N[(size_t)unit * 64 + lane] = s; }
}
struct ScanStage { unsigned d[8]; float dn, bL, gmax; };
__device__ __forceinline__ void scan_load(ScanStage& st, const bf16* gc, const Buf& o, size_t u, int c, int lane) {
    typedef unsigned u32x4v __attribute__((ext_vector_type(4)));
    const bf16* cn = gc + (size_t)c * 4096; const u32x4v d0 = *(const u32x4v*)cn, d1 = *(const u32x4v*)(cn + 8);
    st.d[0] = d0.x; st.d[1] = d0.y; st.d[2] = d0.z; st.d[3] = d0.w; st.d[4] = d1.x; st.d[5] = d1.y; st.d[6] = d1.z; st.d[7] = d1.w;
    st.dn = o.N[(u + c) * 64 + lane]; st.bL = o.SC[(u + c) * 4]; st.gmax = o.SC[(u + c) * 4 + 1];
}
__device__ __forceinline__ void scan_step(const ScanStage& st, float (&C)[16], float& n, float& m, bf16* gc, const Buf& o, size_t u, int c, int w, int lane) {
    typedef unsigned u32x4v __attribute__((ext_vector_type(4)));
    float dC[16];
#pragma unroll
    for (int i = 0; i < 8; ++i) { dC[2 * i] = __uint_as_float(st.d[i] << 16); dC[2 * i + 1] = __uint_as_float(st.d[i] & 0xffff0000u); }
    const float dnc = st.dn, bLc = st.bL, gmc = st.gmax;
    bf16* cc = gc + (size_t)c * 4096;
    u32x4v s0, s1; s0.x = pk(C[0], C[1]); s0.y = pk(C[2], C[3]); s0.z = pk(C[4], C[5]); s0.w = pk(C[6], C[7]); s1.x = pk(C[8], C[9]); s1.y = pk(C[10], C[11]); s1.z = pk(C[12], C[13]); s1.w = pk(C[14], C[15]);
    const float mn = fmaxf(bLc + m, gmc), cs = __expf(bLc + m - mn), ee = __expf(gmc - mn);
    float keep = dC[0] + dnc; asm volatile("" : "+v"(keep));
    *(u32x4v*)cc = s0; *(u32x4v*)(cc + 8) = s1;
    if (w == 0) { o.N[(u + c) * 64 + lane] = n; if (lane == 0) o.SC[(u + c) * 4 + 2] = m; }
    m = mn;
#pragma unroll
    for (int i = 0; i < 16; ++i) C[i] = cs * C[i] + ee * dC[i];
    n = cs * n + ee * dnc;
}
__device__ __forceinline__ void scan_bh(int bh, int w, int lane, const Buf& o) {
    float C[16]; float n = 0.f, m = 0.f;
#pragma unroll
    for (int i = 0; i < 16; ++i) C[i] = 0.f;
    const size_t u0 = (size_t)bh * 64;
    bf16* gc = o.C + u0 * 4096 + (w * 16 + (lane >> 2)) * 64 + (lane & 3) * 16;
    ScanStage s0, s1, s2, s3;
    scan_load(s0, gc, o, u0, 0, lane); scan_load(s1, gc, o, u0, 1, lane); scan_load(s2, gc, o, u0, 2, lane); scan_load(s3, gc, o, u0, 3, lane);
#pragma unroll 1
    for (int c = 0; c < 64; c += 4) {
        scan_step(s0, C, n, m, gc, o, u0, c, w, lane);     if (c + 4 < 64) scan_load(s0, gc, o, u0, c + 4, lane);
        scan_step(s1, C, n, m, gc, o, u0, c + 1, w, lane); if (c + 5 < 64) scan_load(s1, gc, o, u0, c + 5, lane);
        scan_step(s2, C, n, m, gc, o, u0, c + 2, w, lane); if (c + 6 < 64) scan_load(s2, gc, o, u0, c + 6, lane);
        scan_step(s3, C, n, m, gc, o, u0, c + 3, w, lane); if (c + 7 < 64) scan_load(s3, gc, o, u0, c + 7, lane);
    }
}
template <class R3F> __device__ __forceinline__ void m3_unit(lds_u8* lds, int unit, const bf16* __restrict__ proj, const P& p, const Buf& o, bf16* __restrict__ mix, const R3F& r3) {
    int tid_ = threadIdx.x; asm volatile("" : "+v"(tid_));
    const int tid = tid_, lane = tid & 63, wv = __builtin_amdgcn_readfirstlane(tid >> 6), r16 = lane & 15, q4 = lane >> 4;
    const int ch = unit & 63, bh = unit >> 6, h = bh & 3, b = bh >> 2;
    const size_t t0 = (size_t)b * SEQ + ch * 64;
    lds_bf* Qt = slot(lds, 0); lds_bf* Kt = slot(lds, 1); lds_bf* Vt = slot(lds, 2); lds_bf* Cp = slot(lds, 3); lds_bf* Pt = slot(lds, 4);
    lds_f32* abt = (lds_f32*)(lds + 5 * TILE_B); lds_f32* aat = abt + 64; lds_f32* amt = aat + 64; lds_f32* aiw = amt + 64; lds_f32* aem = aiw + 64; lds_f32* anp = aem + 64;
    typedef unsigned u32x4v __attribute__((ext_vector_type(4))); typedef unsigned u32x2 __attribute__((ext_vector_type(2)));
    const int hcl = h * 64 + lane;
    bf16 rq[11], rk[11], rv[8]; float cq[5], ck[5];
    { const bf16* pq = proj + (t0 + wv * 8) * NP + MQ + hcl; const bf16* pk_ = proj + (t0 + wv * 8) * NP + MK + hcl; const bf16* pv = proj + (t0 + wv * 8) * NP + MV + hcl;
#pragma unroll
      for (int i = 0; i < 11; ++i) { rq[i] = pq[((long)i - 3) * NP]; rk[i] = pk_[((long)i - 3) * NP]; }
#pragma unroll
      for (int i = 0; i < 8; ++i) rv[i] = pv[(size_t)i * NP];
#pragma unroll
      for (int i = 0; i < 4; ++i) { cq[i] = p.cw[i * 512 + hcl]; ck[i] = p.cw[i * 512 + 256 + hcl]; }
      cq[4] = p.cb[hcl]; ck[4] = p.cb[256 + hcl]; }
    const int ce = tid >> 3, cd8 = (tid & 7) * 8;
    const u32x4v cprev = *(const u32x4v*)(o.C + (size_t)unit * 4096 + ce * 64 + cd8);
    float igv = 0.f, fgv = 0.f, mprev = 0.f, npv = 0.f;
    if (wv == 0) { const bf16* pr = proj + (t0 + lane) * NP; const bf16 gi = pr[MI + h], gf = pr[MF + h]; const float bi = p.b_i[h], bf_ = p.b_f[h];
        mprev = o.SC[(size_t)unit * 4 + 2]; npv = o.N[(size_t)unit * 64 + lane]; igv = bf2f(gi) + bi; fgv = bf2f(gf) + bf_; }
    u32x2 ovr[4]; f32x4 ng[4]; rw::R3Raw R3;
    if (wv == 0) {
        const float ig = igv, lf = -softplus_fast(-fgv);
        const float bt = wave_incl_sum(lf, lane), at = ig - bt, cm = wave_incl_max(at, lane);
        const float mt = fmaxf(bt + mprev, bt + cm);
        abt[lane] = bt; aat[lane] = at; amt[lane] = mt; aiw[lane] = __expf(bt + mprev - mt); aem[lane] = __expf(-mt); anp[lane] = npv;
    }
    { const int c = lane, tg = wv; float qc[8], kc[8]; const int s0 = ch * 64 + tg * 8;
      { float x0 = s0 >= 3 ? bf2f(rq[0]) : 0.f, x1 = s0 >= 2 ? bf2f(rq[1]) : 0.f, x2 = s0 >= 1 ? bf2f(rq[2]) : 0.f;
#pragma unroll
        for (int i = 0; i < 8; ++i) { const float x3 = bf2f(rq[3 + i]); const float y = cq[4] + cq[0] * x0 + cq[1] * x1 + cq[2] * x2 + cq[3] * x3; qc[i] = y * sigmoidf_(y); x0 = x1; x1 = x2; x2 = x3; } }
      { float x0 = s0 >= 3 ? bf2f(rk[0]) : 0.f, x1 = s0 >= 2 ? bf2f(rk[1]) : 0.f, x2 = s0 >= 1 ? bf2f(rk[2]) : 0.f;
#pragma unroll
        for (int i = 0; i < 8; ++i) { const float x3 = bf2f(rk[3 + i]); const float y = ck[4] + ck[0] * x0 + ck[1] * x1 + ck[2] * x2 + ck[3] * x3; kc[i] = y * sigmoidf_(y) * 0.125f; x0 = x1; x1 = x2; x2 = x3; } }
      float vv[8];
#pragma unroll
      for (int i = 0; i < 8; ++i) { const int t = tg * 8 + i; { const unsigned wqk = pk(qc[i], kc[i]); Qt[t * TS + c] = (unsigned short)wqk; Kt[t * TS + c] = (unsigned short)(wqk >> 16); } vv[i] = bf2f(rv[i]); }
      u32x4v x; x.x = pk(vv[0], vv[1]); x.y = pk(vv[2], vv[3]); x.z = pk(vv[4], vv[5]); x.w = pk(vv[6], vv[7]); *(__attribute__((address_space(3))) u32x4v*)(Vt + c * TS + tg * 8) = x;
      *(__attribute__((address_space(3))) u32x4v*)(Cp + ce * TS + cd8) = cprev; }
    if (wv < 4) { const size_t tr = t0 + wv * 16 + r16;
#pragma unroll
        for (int m = 0; m < 4; ++m) { const int hc = h * 64 + m * 16 + q4 * 4; ovr[m] = *(const u32x2*)(proj + tr * NP + MO + hc); ng[m] = *(const f32x4*)(p.norm_g + hc); } }
    else r3.load(R3, unit, wv - 4, lane);
    asm volatile("s_waitcnt lgkmcnt(0)\n\ts_barrier" ::: "memory");
    { const f32x4 Z = {0.f, 0.f, 0.f, 0.f}; const int mt = wv >> 1;
#pragma unroll
      for (int tt = 0; tt < 2; ++tt) { const int nt = (wv & 1) * 2 + tt; f32x4 sT = mma64(Kt, Qt, mt, nt, lane, Z);
          const int t = nt * 16 + r16; const float bm = abt[t] - amt[t];
#pragma unroll
          for (int e = 0; e < 4; ++e) { const int s = mt * 16 + q4 * 4 + e; sT[e] = (s <= t) ? sT[e] * __expf(bm + aat[s]) : 0.f; }
          st_nm(Pt, mt, nt, lane, sT); } }
    asm volatile("s_waitcnt lgkmcnt(0)\n\ts_barrier" ::: "memory");
    if (wv < 4) { const int nt = wv, t = nt * 16 + r16; const f32x4 Z = {0.f, 0.f, 0.f, 0.f};
        const float iw = aiw[t];
        f32x4 num[4];
#pragma unroll
        for (int m = 0; m < 4; ++m) { f32x4 a = mma64(Cp, Qt, m, nt, lane, Z); a = a * iw; num[m] = mma64(Vt, Pt, m, nt, lane, a); }
        float qn = 0.f, ps = 0.f;
#pragma unroll
        for (int i = 0; i < 16; ++i) { const int d = q4 * 16 + i; qn += anp[d] * bf2f(Qt[t * TS + d]); ps += bf2f(Pt[t * TS + d]); }
        qn = sum_q4(qn); ps = sum_q4(ps);
        const float den = iw * qn + ps, rden = 1.f / fmaxf(fabsf(den), aem[t]);
        float ss = 0.f;
#pragma unroll
        for (int m = 0; m < 4; ++m) { num[m] = num[m] * rden; ss += (num[m][0] * num[m][0] + num[m][1] * num[m][1]) + (num[m][2] * num[m][2] + num[m][3] * num[m][3]); }
        ss = sum_q4(ss);
        const float rstd = rsqrtf(ss * (1.f / 64.f) + 1e-6f);
        const size_t tr = t0 + t;
#pragma unroll
        for (int m = 0; m < 4; ++m) { const int hc = h * 64 + m * 16 + q4 * 4;
            const u32x2 ov = ovr[m]; const f32x4 g = ng[m];
            const float o0 = sigmoidf_(__uint_as_float(ov.x << 16)), o1 = sigmoidf_(__uint_as_float(ov.x & 0xffff0000u)), o2 = sigmoidf_(__uint_as_float(ov.y << 16)), o3 = sigmoidf_(__uint_as_float(ov.y & 0xffff0000u));
            u32x2 w2; w2.x = pk(num[m][0] * rstd * g[0] * o0, num[m][1] * rstd * g[1] * o1); w2.y = pk(num[m][2] * rstd * g[2] * o2, num[m][3] * rstd * g[3] * o3);
            *(u32x2*)(mix + tr * DM + hc) = w2; } }
    else r3.run(R3, unit, wv - 4, lane);
    asm volatile("s_waitcnt lgkmcnt(0)\n\ts_barrier" ::: "memory");
}
}
namespace cg = cooperative_groups;
#define LAS __attribute__((address_space(3)))
#define GASQ __attribute__((address_space(1)))
struct Params { const GASQ float* in[29]; GASQ float* out; GASQ unsigned char* ws; };
struct Ctx { int tid, lane, wave, gw, ngw; unsigned char* lds; };

template <bool GAIN, bool PERM> __device__ __forceinline__ void wt_load(float (&v)[16], int tl, int tn, int t, const float* __restrict__ W, int N, const float* __restrict__ gain, int slo, int shi, float sc) {
    const int n0 = (tl % tn) * 64, k0 = (tl / tn) * 64;
    const int n = n0 + (t & 63); const int ns = PERM ? proj_src_col(n) : (n < N ? n : -1); const int nsc = ns < 0 ? 0 : ns;
    const float* src = W + (size_t)(k0 + (t >> 6)) * N + nsc;
#pragma unroll
    for (int j = 0; j < 16; ++j) v[j] = src[(size_t)(4 * j) * N];
    if (GAIN) {
#pragma unroll
        for (int j = 0; j < 16; ++j) v[j] *= gain[k0 + (t >> 6) + 4 * j]; }
    const float m = ns < 0 ? 0.f : ((n >= slo && n < shi) ? sc : 1.f);
#pragma unroll
    for (int j = 0; j < 16; ++j) v[j] *= m;
}
template <bool GAIN, bool PERM> __device__ __forceinline__ void ph_wt(const Ctx& c, const float* __restrict__ W, int K, int N, int Npad, bf16* __restrict__ Bt, const float* __restrict__ gain, int slo, int shi, float sc, int b0 = 0) {
    if ((int)blockIdx.x < b0) return;
    const int half = c.tid >> 8, t = c.tid & 255;
    LAS float* tile = (LAS float*)((LAS unsigned char*)c.lds + half * 16640);
    const int tn = Npad / 64, ntile = tn * (K / 64), stride = ((int)gridDim.x - b0) * 2;
    int it = ((int)blockIdx.x - b0) * 2;
    float v[16];
    if (it < ntile) wt_load<GAIN, PERM>(v, it + half, tn, t, W, N, gain, slo, shi, sc);
    while (it < ntile) {
        const int tl = it + half; const int n0 = (tl % tn) * 64, k0 = (tl / tn) * 64;
#pragma unroll
        for (int j = 0; j < 16; ++j) tile[((t >> 6) + 4 * j) * 65 + (t & 63)] = v[j];
        it += stride;
        if (it < ntile) wt_load<GAIN, PERM>(v, it + half, tn, t, W, N, gain, slo, shi, sc);
        asm volatile("s_waitcnt lgkmcnt(0)\n\ts_barrier" ::: "memory");
#pragma unroll
        for (int p = 0; p < 2; ++p) { const int n = p * 32 + (t >> 3), ks = (t & 7) * 8; const LAS float* s = tile + ks * 65 + n;
            u32x4 o; o.x = f2bf(s[0]) | (f2bf(s[65]) << 16); o.y = f2bf(s[2 * 65]) | (f2bf(s[3 * 65]) << 16); o.z = f2bf(s[4 * 65]) | (f2bf(s[5 * 65]) << 16); o.w = f2bf(s[6 * 65]) | (f2bf(s[7 * 65]) << 16);
            *(u32x4*)(Bt + (size_t)(n0 + n) * K + k0 + ks) = o; }
        asm volatile("s_waitcnt lgkmcnt(0)\n\ts_barrier" ::: "memory");
    }
}
__device__ __forceinline__ void ph_x2bf(const Ctx& c, const float* __restrict__ x, bf16* __restrict__ xb, unsigned long long* __restrict__ ssq) {
    for (int row = c.gw; row < T; row += 4 * c.ngw) {
        f32x4 v[4][4]; float s[4];
#pragma unroll
        for (int k = 0; k < 4; ++k) { const f32x4* xr = (const f32x4*)(x + (size_t)(row + k * c.ngw) * DM) + c.lane;
#pragma unroll
            for (int j = 0; j < 4; ++j) v[k][j] = xr[64 * j]; }
#pragma unroll
        for (int k = 0; k < 4; ++k) { s[k] = 0.f;
#pragma unroll
            for (int j = 0; j < 4; ++j) s[k] += (v[k][j].x * v[k][j].x + v[k][j].y * v[k][j].y) + (v[k][j].z * v[k][j].z + v[k][j].w * v[k][j].w);
            s[k] = wave_sum(s[k]); if (c.lane < 5) ssq[(size_t)c.lane * 32768 + row + k * c.ngw] = c.lane == 0 ? pg8::ssq_fix(s[k]) : 0ull;
            unsigned long long* o8 = (unsigned long long*)(xb + (size_t)(row + k * c.ngw) * DM) + c.lane;
#pragma unroll
            for (int j = 0; j < 4; ++j) o8[64 * j] = (unsigned long long)(f2bf(v[k][j].x) | (f2bf(v[k][j].y) << 16)) | ((unsigned long long)(f2bf(v[k][j].z) | (f2bf(v[k][j].w) << 16)) << 32); }
    }
}
__device__ __forceinline__ void ph_final_norm(const Ctx& c, float* __restrict__ out, const float* __restrict__ g, const bf16* __restrict__ xb, const unsigned long long* __restrict__ ssq) {
    typedef unsigned u32x2_t __attribute__((ext_vector_type(2)));
    const f32x4* gr = (const f32x4*)g + c.lane; f32x4 gv[4];
#pragma unroll
    for (int j = 0; j < 4; ++j) gv[j] = gr[64 * j];
    for (int row = c.gw; row < T; row += 4 * c.ngw) {
        u32x2_t v[4][4]; unsigned long long q[4];
#pragma unroll
        for (int k = 0; k < 4; ++k) { const u32x2_t* xr = (const u32x2_t*)(xb + (size_t)(row + k * c.ngw) * DM) + c.lane;
#pragma unroll
            for (int j = 0; j < 4; ++j) v[k][j] = xr[64 * j];
            q[k] = ssq[row + k * c.ngw]; }
#pragma unroll
        for (int k = 0; k < 4; ++k) { const float rstd = rsqrtf(pg8::ssq_val(q[k]) * (1.f / DM) + 1e-6f);
            f32x4* xo = (f32x4*)(out + (size_t)(row + k * c.ngw) * DM) + c.lane;
#pragma unroll
            for (int j = 0; j < 4; ++j) { f32x4 t; t.x = __uint_as_float(v[k][j].x << 16); t.y = __uint_as_float(v[k][j].x & 0xffff0000u); t.z = __uint_as_float(v[k][j].y << 16); t.w = __uint_as_float(v[k][j].y & 0xffff0000u);
                xo[64 * j] = t * rstd * gv[j]; } }
    }
}
__device__ __forceinline__ void ph_attn_combine(const Ctx& c, const bf16* __restrict__ ot, bf16* __restrict__ mix, const float* lq1, const float* lk1, const float* lq2, const float* lk2,
                                                const float* __restrict__ norm_g, float lam_init) {
    const int lane = c.lane;
    const float lam = __expf(wave_sum(lq1[lane] * lk1[lane])) - __expf(wave_sum(lq2[lane] * lk2[lane])) + lam_init;
    for (int u0 = c.gw; u0 < T * 4; u0 += 4 * c.ngw) {
        unsigned a[4], b[4];
#pragma unroll
        for (int k = 0; k < 4; ++k) { const int u = u0 + k * c.ngw; const int h = u & 3, t = u >> 2;
            const unsigned* p0 = (const unsigned*)(ot + (size_t)t * 1024 + h * 256); a[k] = p0[lane]; b[k] = p0[64 + lane]; }
#pragma unroll
        for (int k = 0; k < 4; ++k) { const int u = u0 + k * c.ngw; const int h = u & 3, t = u >> 2;
            const float o0 = __uint_as_float(a[k] << 16) - lam * __uint_as_float(b[k] << 16), o1 = __uint_as_float(a[k] & 0xffff0000u) - lam * __uint_as_float(b[k] & 0xffff0000u);
            const float r = rsqrtf(wave_sum(o0 * o0 + o1 * o1) * (1.f / 128.f) + 1e-5f) * (1.f - lam_init);
            const float g0 = norm_g[h * 128 + 2 * lane], g1 = norm_g[h * 128 + 2 * lane + 1];
            ((unsigned*)(mix + (size_t)t * DM + 512 + h * 128))[lane] = f2bf(o0 * r * g0) | (f2bf(o1 * r * g1) << 16); }
    }
}
template <class Epi> __device__ __forceinline__ void ph_gemm(const Ctx& c, const bf16* A, const bf16* Bt, int N, int K, const Epi& E) {
    asm volatile("" : "+s"(N), "+s"(K));
    pg8::Gemm g{A, Bt, T, N, K, 0};
    pg8::StaticOrder S; S.init(T, N, (int)gridDim.x, (int)blockIdx.x);
    pg8::gemm_phase<Epi, pg8::StaticOrder, true, true>((PG8_LAS unsigned char*)c.lds, g, S, E);
}

#define GSYNC() xcd_barrier(xbar)
#define GSYNC_CG() do { asm volatile("s_waitcnt vmcnt(0)" ::: "memory"); grid.sync(); } while (0)
#define FRESH() asm volatile("" : "+s"(kp) :: "memory"); Ctx c; { int t_ = threadIdx.x; asm volatile("" : "+v"(t_)); c.tid = t_; c.lane = t_ & 63; c.wave = __builtin_amdgcn_readfirstlane(t_ >> 6); c.gw = blockIdx.x * 8 + c.wave; c.ngw = gridDim.x * 8; c.lds = lds; }
#define IN(i) ((const float*)(kp->in[i]))
#define WSP(off) ((unsigned char*)(kp->ws + (off)))
#define OUTP ((float*)(kp->out))
#define SSQ(i) ((unsigned long long*)WSP(WS_SSQ + (size_t)(i) * 262144))
#define XBp ((bf16*)WSP(WS_XB))
#define OTp ((bf16*)WSP(WS_XB))
#define MIXp ((bf16*)WSP(WS_MIX))
#define PROJp ((bf16*)WSP(WS_PROJ))
#define HIDp ((bf16*)WSP(WS_HID))
#define SCRp ((float*)WSP(WS_SCR))

template <int l> __device__ __forceinline__ void layer_body(const Params*& kp, unsigned char* lds, cg::grid_group& grid, const XcdBarrier& xbar) {
        const float lam_init = 0.8f - 0.6f * __expf(-0.3f * (float)l);
        { FRESH(); ph_gemm(c, XBp, (bf16*)WSP(WS_WIN) + (size_t)l * NP * DM, NP, DM, pg8::EpiBf16S<0>{PROJp, SSQ(2 * l), NP, 0}); }
        GSYNC();
        {
            { FRESH(); (void)c; rw::W w{IN(8) + l * 896, IN(9) + l * 256, IN(10) + l * 32 * 256, IN(11) + l * 256, IN(12) + l * 32 * 256, IN(13) + l * 64 * 256, IN(14) + l * 256, IN(15) + l * 256, IN(16) + l * 256, IN(17) + l * 256, IN(18) + l * 256};
              rw::Buf o{(bf16*)WSP(WS_RWG), (bf16*)WSP(WS_RWH), (bf16*)WSP(WS_RWRH), (bf16*)WSP(WS_RWYL), (bf16*)WSP(WS_GATE), (float*)WSP(WS_BON)};
              ml::P mp{IN(3) + l * 4 * 512, IN(4) + l * 512, IN(5) + l * 4, IN(6) + l * 4, IN(7) + l * 256}; ml::Buf mo{(bf16*)WSP(WS_MLC), (float*)WSP(WS_MLN), (float*)WSP(WS_MLS)};
              const bool hfix = ((int)gridDim.x & 255) == 0;
              rw::R1W wts; rw::r1_load_w(wts, ((int)blockIdx.x >> 6) & 3, w, mp);
              for (int unit = blockIdx.x; unit < 2048; unit += gridDim.x) { if (!hfix) rw::r1_load_w(wts, (unit >> 6) & 3, w, mp); rw::r1_unit((rw::lds_u8*)lds, unit, wts, PROJp, w, o, mp, mo); } }
            GSYNC();
            { FRESH(); rw::Buf o{(bf16*)WSP(WS_RWG), (bf16*)WSP(WS_RWH), (bf16*)WSP(WS_RWRH), (bf16*)WSP(WS_RWYL), (bf16*)WSP(WS_GATE), (float*)WSP(WS_BON)};
              if (blockIdx.x < 32 && c.wave < 4) rw::scan_bh((int)blockIdx.x, c.wave, c.lane, o);
              ml::Buf mo{(bf16*)WSP(WS_MLC), (float*)WSP(WS_MLN), (float*)WSP(WS_MLS)};
              if (blockIdx.x >= 32 && blockIdx.x < 64 && c.wave < 4) ml::scan_bh((int)blockIdx.x - 32, c.wave, c.lane, mo); }
            __syncthreads();
        { FRESH(); const float lam = __expf(wave_sum(IN(19)[l * 64 + c.lane] * IN(20)[l * 64 + c.lane])) - __expf(wave_sum(IN(21)[l * 64 + c.lane] * IN(22)[l * 64 + c.lane])) + lam_init;
          attn_body::attn_phase<8>((char*)lds, (const attn_body::bf16*)PROJp, (unsigned short*)MIXp, AQ, AK, AV, lam, 1.f - lam_init, IN(23) + l * 512, attn_body::StaticOrder((int)gridDim.x, (int)blockIdx.x)); }
            __syncthreads();
            {
                { FRESH(); ph_wt<false, false>(c, IN(24) + (size_t)l * DM * DM, DM, DM, DM, (bf16*)WSP(WS_WOUT) + (size_t)l * DM * DM, nullptr, 0, 0, 1.f); }
                { FRESH(); ph_wt<true, false>(c, IN(26) + (size_t)l * DM * FF, DM, FF, FF, (bf16*)WSP(WS_WUP) + (size_t)l * FF * DM, IN(25) + l * DM, 0, 0, 1.f); }
                { FRESH(); ph_wt<false, false>(c, IN(27) + (size_t)l * FF * DM, FF, DM, DM, (bf16*)WSP(WS_WDN) + (size_t)l * DM * FF, nullptr, 0, 0, 1.f); }
                if (l + 1 < DEPTH) { FRESH(); ph_wt<true, true>(c, IN(2) + (size_t)(l + 1) * DM * NREAL, DM, NREAL, NP, (bf16*)WSP(WS_WIN) + (size_t)(l + 1) * NP * DM, IN(1) + (l + 1) * DM, AQ, AK, C2); }
            }
            GSYNC();
            { FRESH(); (void)c; rw::W w{IN(8) + l * 896, IN(9) + l * 256, IN(10) + l * 32 * 256, IN(11) + l * 256, IN(12) + l * 32 * 256, IN(13) + l * 64 * 256, IN(14) + l * 256, IN(15) + l * 256, IN(16) + l * 256, IN(17) + l * 256, IN(18) + l * 256};
              rw::Buf ro{(bf16*)WSP(WS_RWG), (bf16*)WSP(WS_RWH), (bf16*)WSP(WS_RWRH), (bf16*)WSP(WS_RWYL), (bf16*)WSP(WS_GATE), (float*)WSP(WS_BON)};
              ml::P p{IN(3) + l * 4 * 512, IN(4) + l * 512, IN(5) + l * 4, IN(6) + l * 4, IN(7) + l * 256}; ml::Buf o{(bf16*)WSP(WS_MLC), (float*)WSP(WS_MLN), (float*)WSP(WS_MLS)};
              const bf16* projp = PROJp; bf16* mixp = MIXp;
              const rw::R3Ctx r3{projp, &w, &ro, mixp};
              for (int unit = blockIdx.x; unit < 2048; unit += gridDim.x) ml::m3_unit((rw::lds_u8*)lds, unit, projp, p, o, mixp, r3); }
        }
        GSYNC();
        { FRESH(); ph_gemm(c, MIXp, (bf16*)WSP(WS_WOUT) + (size_t)l * DM * DM, DM, DM, pg8::EpiResBf{XBp, SSQ(2 * l + 1), DM, 0}); }
        GSYNC();
        { FRESH(); ph_gemm(c, XBp, (bf16*)WSP(WS_WUP) + (size_t)l * FF * DM, FF, DM, pg8::EpiBf16S<2>{HIDp, SSQ(2 * l + 1), FF, 0}); }
        GSYNC();
        { FRESH(); ph_gemm(c, HIDp, (bf16*)WSP(WS_WDN) + (size_t)l * DM * FF, DM, FF, pg8::EpiResBf{XBp, SSQ(2 * l + 2), DM, 0}); }
        GSYNC();
}

constexpr int LDS_BYTES = 163840;
__global__ void __launch_bounds__(512, 2) mega(Params p) {
    extern __shared__ __attribute__((aligned(16))) unsigned char lds[];
    cg::grid_group grid = cg::this_grid();
    volatile LAS unsigned* xst = (volatile LAS unsigned*)((LAS unsigned char*)lds + 163776);
    if (threadIdx.x < 2) xst[threadIdx.x] = 0u;
    __syncthreads();
    XcdBarrier xbar = xcd_barrier_post((unsigned*)(((const Params*)__builtin_amdgcn_kernarg_segment_ptr())->ws + 16384), xst);
    const Params* kp = (const Params*)__builtin_amdgcn_kernarg_segment_ptr();
    { FRESH(); ph_wt<true, true>(c, IN(2), DM, NREAL, NP, (bf16*)WSP(WS_WIN), IN(1), AQ, AK, C2); }
    { FRESH(); ph_x2bf(c, IN(0), XBp, SSQ(0)); }
    GSYNC_CG();
    layer_body<0>(kp, lds, grid, xbar);
    layer_body<1>(kp, lds, grid, xbar);
    { FRESH(); ph_final_norm(c, OUTP, IN(28), XBp, SSQ(2 * DEPTH)); }
}

extern "C" void kernel_launch(void* const* d_in, const int* in_sizes, int n_in, void* d_out, int out_size, void* d_ws, size_t ws_size, hipStream_t stream) {
    static int grid_blocks = 0;
    if (grid_blocks == 0) {
        if (n_in != 29 || out_size != T * DM || ws_size < WS_END) { fprintf(stderr, "kernel_launch: unexpected shapes n_in %d out %d ws %zu\n", n_in, out_size, ws_size); grid_blocks = -1; return; }
        int dev = 0, cus = 0, per_cu = 0;
        (void)hipGetDevice(&dev); (void)hipDeviceGetAttribute(&cus, hipDeviceAttributeMultiprocessorCount, dev);
        (void)hipFuncSetAttribute((const void*)mega, hipFuncAttributeMaxDynamicSharedMemorySize, LDS_BYTES);
        (void)hipOccupancyMaxActiveBlocksPerMultiprocessor(&per_cu, (const void*)mega, 512, LDS_BYTES);
        fprintf(stderr, "kernel_launch: cus %d per_cu %d ws %zu\n", cus, per_cu, ws_size);
        grid_blocks = (per_cu >= 1) ? cus : -1;
    }
    if (grid_blocks < 0) return;
    if (hipMemsetAsync(d_ws, 0, 1u << 17, stream) != hipSuccess) { fprintf(stderr, "kernel_launch: memset of the control words failed\n"); return; }
    Params p{};
    for (int i = 0; i < 29; ++i) p.in[i] = (const GASQ float*)d_in[i];
    p.out = (GASQ float*)d_out; p.ws = (GASQ unsigned char*)d_ws;
    void* args[] = {&p};
    hipError_t e = hipLaunchCooperativeKernel((void*)mega, dim3(grid_blocks), dim3(512), args, LDS_BYTES, stream);
    if (e != hipSuccess) fprintf(stderr, "cooperative launch failed: %s (grid %d)\n", hipGetErrorString(e), grid_blocks);
}
```

```cpp
#include <hip/hip_runtime.h>
#include <hip/hip_cooperative_groups.h>
#include <cstdio>
#include <cstdint>
#include <cmath>
namespace pg8 {
#define PG8_LAS __attribute__((address_space(3)))
typedef unsigned short bf16_t;
typedef short bf16x8 __attribute__((ext_vector_type(8)));
typedef float f32x4 __attribute__((ext_vector_type(4)));
typedef unsigned u32x4 __attribute__((ext_vector_type(4)));
constexpr int BM = 256, BK = 64, HALF = 128, HTB = HALF * BK * 2  , STAGE_BYTES = 8 * HTB, NXCD = 8, WGM = 8;

__host__ __device__ __forceinline__ int lds_byte(int r, int c) { const int st = (r >> 4) * 2 + (c >> 5), rr = r & 15, cc = c & 31, ob = rr * 64 + cc * 2; return st * 1024 + (ob ^ (((ob >> 9) & 1) << 5)); }
__host__ __device__ __forceinline__ void stage_rc(int b, int& R, int& C) { const int st = b / 1024, sb = b % 1024, swz = sb ^ (((sb >> 9) & 1) << 5); R = (st >> 1) * 16 + swz / 64; C = (st & 1) * 32 + (swz % 64) / 2; }
__host__ __device__ __forceinline__ int perm32(int rho) { const int n = rho >> 4, i = rho & 15; return 8 * (i >> 2) + 4 * n + (i & 3); }

struct Unit { int pm, pn; };
struct Gemm { const bf16_t* A; const bf16_t* Bt; int M, N, K, pad; };

struct StaticOrder {
    int nM, nN, nwg, G, c;
    __host__ __device__ void init(int M, int N, int G_, int c_) { nM = M / BM; nN = N / BM; nwg = nM * nN; G = G_; c = c_; }
    __host__ __device__ bool next(int i, Unit& u) const {
        const long L = (long)i * G + c; if (L >= nwg) return false;
        int wgid = (int)L; { const int q = nwg / NXCD, r = nwg % NXCD, xcd = wgid % NXCD, off = wgid / NXCD; wgid = (xcd < r ? xcd * (q + 1) : r * (q + 1) + (xcd - r) * q) + off; }
        const int nig = WGM * nN, gid = wgid / nig, fm = gid * WGM, gsz = (nM - fm) < WGM ? (nM - fm) : WGM;
        u.pm = fm + ((wgid % nig) % gsz); u.pn = (wgid % nig) / gsz; return true;
    }
    __device__ __forceinline__ void a_ready(const Unit&) const {}
    __device__ __forceinline__ void done(const Unit&) const {}
};

__device__ __forceinline__ unsigned cvt_pk_bf16(float lo, float hi) { unsigned r; asm volatile("v_cvt_pk_bf16_f32 %0, %1, %2" : "=v"(r) : "v"(lo), "v"(hi)); return r; }
typedef float f32x2 __attribute__((ext_vector_type(2)));
__device__ __forceinline__ unsigned long long ssq_fix(float s) { const float h = floorf(s); const unsigned hi = (unsigned)h; const unsigned lo = (unsigned)((s - h) * 4294967296.f); return ((unsigned long long)hi << 32) | lo; }
__device__ __forceinline__ float ssq_val(unsigned long long v) { return (float)(unsigned)(v >> 32) + (float)(unsigned)v * (1.f / 4294967296.f); }
template <int ACT> struct EpiBf16S {
    static constexpr bool PERM = true, AFTER_DRAIN = false;
    bf16_t* O; const unsigned long long* rowssq; int ldc; int pad;
    __device__ __forceinline__ void operator()(const f32x4 (&acc)[2][2][4][2], const Unit& u, int wr, int wc, int fr, int fq) const {
        const int row0 = u.pm * BM + wr * 64 + fr; const int col0 = u.pn * BM + wc * 32 + 8 * fq;
        unsigned long long rsv[2][4];
#pragma unroll
        for (int ai = 0; ai < 2; ++ai)
#pragma unroll
            for (int m = 0; m < 4; ++m) rsv[ai][m] = rowssq[row0 + ai * HALF + m * 16];
#pragma unroll
        for (int ai = 0; ai < 2; ++ai)
#pragma unroll
            for (int m = 0; m < 4; ++m) { const int row = row0 + ai * HALF + m * 16; const float rs = rsqrtf(ssq_val(rsv[ai][m]) * (1.f / 1024.f) + 1e-6f); bf16_t* rowp = O + (size_t)row * ldc + col0;
#pragma unroll
                for (int bj = 0; bj < 2; ++bj) { f32x4 v0 = acc[ai][bj][m][0] * rs, v1 = acc[ai][bj][m][1] * rs;
                    if (ACT == 2) {
#pragma unroll
                        for (int e = 0; e < 4; ++e) { float a = fmaxf(v0[e], 0.f), b = fmaxf(v1[e], 0.f); v0[e] = a * a; v1[e] = b * b; } }
                    u32x4 w; w.x = cvt_pk_bf16(v0[0], v0[1]); w.y = cvt_pk_bf16(v0[2], v0[3]); w.z = cvt_pk_bf16(v1[0], v1[1]); w.w = cvt_pk_bf16(v1[2], v1[3]);
                    *(u32x4*)(rowp + bj * HALF) = w; } }
    }
};
struct EpiResBf {
    static constexpr bool PERM = true, AFTER_DRAIN = false;
    bf16_t* xb; unsigned long long* ssq; int ldc; int pad;
    __device__ __forceinline__ void operator()(const f32x4 (&acc)[2][2][4][2], const Unit& u, int wr, int wc, int fr, int fq) const {
        const int row0 = u.pm * BM + wr * 64 + fr; const int col0 = u.pn * BM + wc * 32 + 8 * fq;
#pragma unroll
        for (int ai = 0; ai < 2; ++ai) {
            u32x4 bv[4][2];
#pragma unroll
            for (int m = 0; m < 4; ++m)
#pragma unroll
                for (int bj = 0; bj < 2; ++bj) bv[m][bj] = *(const u32x4*)(xb + (size_t)(row0 + ai * HALF + m * 16) * ldc + col0 + bj * HALF);
            asm volatile("" ::: "memory");
#pragma unroll
            for (int m = 0; m < 4; ++m) { const int row = row0 + ai * HALF + m * 16; bf16_t* rowp = xb + (size_t)row * ldc + col0; float s = 0.f;
#pragma unroll
                for (int bj = 0; bj < 2; ++bj) { const u32x4 b = bv[m][bj]; f32x4 v0 = acc[ai][bj][m][0], v1 = acc[ai][bj][m][1];
                    v0[0] += __uint_as_float(b.x << 16); v0[1] += __uint_as_float(b.x & 0xffff0000u); v0[2] += __uint_as_float(b.y << 16); v0[3] += __uint_as_float(b.y & 0xffff0000u);
                    v1[0] += __uint_as_float(b.z << 16); v1[1] += __uint_as_float(b.z & 0xffff0000u); v1[2] += __uint_as_float(b.w << 16); v1[3] += __uint_as_float(b.w & 0xffff0000u);
                    s += ((v0[0] * v0[0] + v0[1] * v0[1]) + (v0[2] * v0[2] + v0[3] * v0[3])) + ((v1[0] * v1[0] + v1[1] * v1[1]) + (v1[2] * v1[2] + v1[3] * v1[3]));
                    u32x4 w; w.x = cvt_pk_bf16(v0[0], v0[1]); w.y = cvt_pk_bf16(v0[2], v0[3]); w.z = cvt_pk_bf16(v1[0], v1[1]); w.w = cvt_pk_bf16(v1[2], v1[3]);
                    *(u32x4*)(rowp + bj * HALF) = w; }
                s += __int_as_float(__builtin_amdgcn_ds_swizzle(__float_as_int(s), (16 << 10) | 0x1f));
                { auto rr = __builtin_amdgcn_permlane32_swap(__float_as_uint(s), __float_as_uint(s), false, false); s = __uint_as_float(rr[0]) + __uint_as_float(rr[1]); }
                if (fq == 0) atomicAdd(ssq + row, ssq_fix(s)); }
            asm volatile("" ::: "memory"); }
    }
};
__device__ __forceinline__ const char* uni_ptr(const char* p) {
    const unsigned long long v = (unsigned long long)p; const unsigned lo = __builtin_amdgcn_readfirstlane((unsigned)v), hi = __builtin_amdgcn_readfirstlane((unsigned)(v >> 32));
    return (const char*)(((unsigned long long)hi << 32) | lo); }
template <class Epi, class Sched, bool ALIGN_EPI = false, bool SP2 = false>
__device__ __forceinline__ void gemm_phase(PG8_LAS unsigned char* lds, const Gemm g, const Sched& S, const Epi& E) {
    int tid_ = threadIdx.x; asm volatile("" : "+v"(tid_));
    const int tid = tid_, wid = __builtin_amdgcn_readfirstlane(tid >> 6), lane = tid & 63, wr = wid >> 2, wc = wid & 3, fr = lane & 15, fq = lane >> 4;
    const int K = g.K, nt = K / BK;
    unsigned voffA[2], voffB[2];
#pragma unroll
    for (int i = 0; i < 2; ++i) { int R, C; stage_rc(tid * 16 + i * 8192, R, C); const int Rb = Epi::PERM ? ((R & ~31) + perm32(R & 31)) : R;
        voffA[i] = (unsigned)(R * K + C) * 2u; voffB[i] = (unsigned)(Rb * K + C) * 2u; }
    const size_t kstep = (size_t)(BK * 2);
    const size_t hstep = (size_t)HALF * K * 2;
    const size_t tstep = 2 * hstep;
    const unsigned ldsw = (unsigned)wid * 1024u;
    const int aoff = lds_byte(wr * 64 + fr, fq * 8), boff = lds_byte(wc * 32 + fr, fq * 8);
#define PG8_SA(b, h) (((b) * 2 + (h)) * HTB)
#define PG8_SB(b, h) ((4 + (b) * 2 + (h)) * HTB)
#define PG8_STAGE(bufoff, gbase, voff) do { _Pragma("unroll") for (int _i = 0; _i < 2; ++_i) \
        __builtin_amdgcn_global_load_lds((const unsigned*)((const char*)(gbase) + (voff)[_i]), (PG8_LAS unsigned*)(lds + (bufoff) + ldsw + _i * 8192), 16, 0, 0); } while (0)
#define PG8_LDA(dst, b, h) do { _Pragma("unroll") for (int m = 0; m < 4; ++m) _Pragma("unroll") for (int k = 0; k < 2; ++k) dst[m][k] = *(const PG8_LAS bf16x8*)(lds + PG8_SA(b, h) + aoff + m * 2048 + k * 1024); } while (0)
#define PG8_LDB(dst, b, h) do { _Pragma("unroll") for (int n = 0; n < 2; ++n) _Pragma("unroll") for (int k = 0; k < 2; ++k) dst[n][k] = *(const PG8_LAS bf16x8*)(lds + PG8_SB(b, h) + boff + n * 2048 + k * 1024); } while (0)
#define PG8_MMA(ai, bj, At, Bt) do { __builtin_amdgcn_s_setprio(1); _Pragma("unroll") for (int m = 0; m < 4; ++m) _Pragma("unroll") for (int n = 0; n < 2; ++n) _Pragma("unroll") for (int k = 0; k < 2; ++k) \
        acc[ai][bj][m][n] = __builtin_amdgcn_mfma_f32_16x16x32_bf16(Bt[n][k], At[m][k], acc[ai][bj][m][n], 0, 0, 0); __builtin_amdgcn_s_setprio(0); } while (0)
#define PG8_WAIT_V(n) asm volatile("s_waitcnt vmcnt(" #n ")" ::: "memory")
#define PG8_WAIT_L(n) asm volatile("s_waitcnt lgkmcnt(" #n ")" ::: "memory")
#define PG8_BAR __builtin_amdgcn_s_barrier()
#define PG8_SCHED __builtin_amdgcn_sched_barrier(0)
    Unit cur, nxt; int ui = 0;
    if (!S.next(0, cur)) return;
    f32x4 acc[2][2][4][2];
#pragma unroll
    for (int a = 0; a < 2; ++a)
#pragma unroll
        for (int b = 0; b < 2; ++b)
#pragma unroll
            for (int m = 0; m < 4; ++m)
#pragma unroll
                for (int n = 0; n < 2; ++n) acc[a][b][m][n] = (f32x4){0.f, 0.f, 0.f, 0.f};
    bf16x8 At[4][2], B0[2][2], B1[2][2];
    const char* cA = uni_ptr((const char*)g.A + (size_t)cur.pm * tstep); const char* cB = uni_ptr((const char*)g.Bt + (size_t)cur.pn * tstep);
    S.a_ready(cur);
    if constexpr (SP2) {
        PG8_STAGE(PG8_SB(0, 0), cB, voffB); PG8_STAGE(PG8_SB(0, 1), cB + hstep, voffB); PG8_STAGE(PG8_SA(0, 0), cA, voffA); PG8_STAGE(PG8_SA(0, 1), cA + hstep, voffA);
        if (wr == 1) PG8_BAR;
        PG8_WAIT_V(2); PG8_BAR;
        PG8_STAGE(PG8_SB(1, 0), cB + kstep, voffB); PG8_STAGE(PG8_SA(1, 0), cA + kstep, voffA); PG8_STAGE(PG8_SB(1, 1), cB + hstep + kstep, voffB);
        PG8_WAIT_V(6); PG8_BAR;
    } else {
        PG8_STAGE(PG8_SB(0, 0), cB, voffB); PG8_STAGE(PG8_SA(0, 0), cA, voffA); PG8_STAGE(PG8_SB(0, 1), cB + hstep, voffB); PG8_STAGE(PG8_SA(0, 1), cA + hstep, voffA);
        if (wr == 1) PG8_BAR;
        PG8_WAIT_V(4); PG8_BAR;
        PG8_STAGE(PG8_SB(1, 0), cB + kstep, voffB); PG8_STAGE(PG8_SA(1, 0), cA + kstep, voffA); PG8_STAGE(PG8_SB(1, 1), cB + hstep + kstep, voffB);
        PG8_WAIT_V(6); PG8_BAR;
    }
    for (;;) {
        const bool has_next = S.next(ui + 1, nxt);
        const char* nA = uni_ptr(has_next ? (const char*)g.A + (size_t)nxt.pm * tstep : cA); const char* nB = uni_ptr(has_next ? (const char*)g.Bt + (size_t)nxt.pn * tstep : cB);
        for (int t = 0; t < nt; t += 2) {
            const bool last = (t == nt - 2);
            const char* a1 = cA + (size_t)(t + 1) * kstep;
            const char* a2 = last ? nA : cA + (size_t)(t + 2) * kstep; const char* b2 = last ? nB : cB + (size_t)(t + 2) * kstep;
            const char* a3 = a2 + kstep; const char* b3 = b2 + kstep;
            if (last && has_next) S.a_ready(nxt);
            if constexpr (SP2) {
            PG8_LDB(B0, 0, 0); PG8_LDB(B1, 0, 1); PG8_SCHED; PG8_LDA(At, 0, 0); PG8_STAGE(PG8_SA(1, 1), a1 + hstep, voffA);
            PG8_WAIT_V(8); PG8_WAIT_L(0); PG8_BAR; PG8_MMA(0, 0, At, B0); PG8_MMA(0, 1, At, B1); PG8_BAR; PG8_SCHED;
            PG8_LDA(At, 0, 1); PG8_STAGE(PG8_SB(0, 0), b2, voffB); PG8_STAGE(PG8_SB(0, 1), b2 + hstep, voffB); PG8_STAGE(PG8_SA(0, 0), a2, voffA);
            PG8_WAIT_V(8); PG8_WAIT_L(0); PG8_BAR; PG8_MMA(1, 0, At, B0); PG8_MMA(1, 1, At, B1); PG8_BAR; PG8_SCHED;
            PG8_LDB(B0, 1, 0); PG8_LDB(B1, 1, 1); PG8_SCHED; PG8_LDA(At, 1, 0); PG8_STAGE(PG8_SA(0, 1), a2 + hstep, voffA);
            PG8_WAIT_V(8); PG8_WAIT_L(0); PG8_BAR; PG8_MMA(0, 0, At, B0); PG8_MMA(0, 1, At, B1); PG8_BAR; PG8_SCHED;
            PG8_LDA(At, 1, 1); PG8_STAGE(PG8_SB(1, 0), b3, voffB); PG8_STAGE(PG8_SB(1, 1), b3 + hstep, voffB); PG8_STAGE(PG8_SA(1, 0), a3, voffA);
            PG8_WAIT_V(8); PG8_WAIT_L(0); PG8_BAR; PG8_MMA(1, 0, At, B0); PG8_MMA(1, 1, At, B1); PG8_BAR; PG8_SCHED;
            } else {
            PG8_LDB(B0, 0, 0); PG8_SCHED; PG8_LDA(At, 0, 0); PG8_STAGE(PG8_SA(1, 1), a1 + hstep, voffA);
            PG8_WAIT_L(8); PG8_BAR; PG8_WAIT_L(0); PG8_MMA(0, 0, At, B0); PG8_BAR; PG8_SCHED;
            PG8_LDB(B1, 0, 1); PG8_STAGE(PG8_SB(0, 0), b2, voffB);
            PG8_BAR; PG8_WAIT_L(0); PG8_MMA(0, 1, At, B1); PG8_BAR;
            PG8_LDA(At, 0, 1); PG8_STAGE(PG8_SA(0, 0), a2, voffA);
            PG8_BAR; PG8_WAIT_L(0); PG8_MMA(1, 0, At, B0); PG8_BAR; PG8_SCHED;
            PG8_STAGE(PG8_SB(0, 1), b2 + hstep, voffB);
            PG8_WAIT_V(6); PG8_BAR; PG8_MMA(1, 1, At, B1); PG8_BAR;
            PG8_LDB(B0, 1, 0); PG8_SCHED; PG8_LDA(At, 1, 0); PG8_STAGE(PG8_SA(0, 1), a2 + hstep, voffA);
            PG8_WAIT_L(8); PG8_BAR; PG8_WAIT_L(0); PG8_MMA(0, 0, At, B0); PG8_BAR; PG8_SCHED;
            PG8_LDB(B1, 1, 1); PG8_STAGE(PG8_SB(1, 0), b3, voffB);
            PG8_BAR; PG8_WAIT_L(0); PG8_MMA(0, 1, At, B1); PG8_BAR;
            PG8_LDA(At, 1, 1); PG8_STAGE(PG8_SA(1, 0), a3, voffA);
            PG8_BAR; PG8_WAIT_L(0); PG8_MMA(1, 0, At, B0); PG8_BAR; PG8_SCHED;
            PG8_STAGE(PG8_SB(1, 1), b3 + hstep, voffB);
            PG8_WAIT_V(6); PG8_BAR; PG8_MMA(1, 1, At, B1); PG8_BAR;
            }
        }
        if constexpr (ALIGN_EPI) { if (wr == 0) PG8_BAR; }
        if constexpr (!Epi::AFTER_DRAIN) { E(acc, cur, wr, wc, fr, fq); S.done(cur); }
        if (!has_next) break;
#pragma unroll
        for (int a = 0; a < 2; ++a)
#pragma unroll
            for (int b = 0; b < 2; ++b)
#pragma unroll
                for (int m = 0; m < 4; ++m)
#pragma unroll
                    for (int n = 0; n < 2; ++n) acc[a][b][m][n] = (f32x4){0.f, 0.f, 0.f, 0.f};
        cur = nxt; cA = nA; cB = nB; ++ui;
        if constexpr (ALIGN_EPI) { if (wr == 1) PG8_BAR; }
    }
    PG8_WAIT_V(0);
    if constexpr (!ALIGN_EPI) { if (wr == 0) PG8_BAR; }
    PG8_BAR;
    if constexpr (Epi::AFTER_DRAIN) { E.fused(acc, cur, wr, wc, fr, fq, lds, wid, lane); S.done(cur); }
#undef PG8_SA
#undef PG8_SB
#undef PG8_STAGE
#undef PG8_LDA
#undef PG8_LDB
#undef PG8_MMA
#undef PG8_WAIT_V
#undef PG8_WAIT_L
#undef PG8_BAR
#undef PG8_SCHED
}
}
#include <hip/hip_bf16.h>
#include <cmath>
namespace attn_body {
using bf16=__hip_bfloat16;
using bf16x8=__attribute__((ext_vector_type(8)))short;
using s16x4=__attribute__((ext_vector_type(4)))short;
using f32x16=__attribute__((ext_vector_type(16)))float;
using u32x4=__attribute__((ext_vector_type(4)))unsigned;
constexpr int SEQ=4096,D=64,PQ=3584,PO=1024;
constexpr int NW=8,QBLK=32,QB=QBLK*NW,KVBLK=64,NQB=SEQ/QB;
constexpr int ATTN_UNIT_ROWS=QB;
__device__ __forceinline__ int crow(int r,int hi){return (r&3)+8*(r>>2)+4*hi;}
#define SBAR() __builtin_amdgcn_sched_barrier(0)
__device__ __forceinline__ void cmask(f32x16&p0,f32x16&p1,int jb,int qrel,int hi){
  const float NEG=-INFINITY; int kb=64*jb+4*hi;
  #pragma unroll
  for(int r=0;r<16;++r){int kv=kb+(r&3)+8*(r>>2); if(kv>qrel)p0[r]=NEG; if(kv+32>qrel)p1[r]=NEG;}
}

constexpr int NSLOT=3, SLOTB=8192;
constexpr int VSLOTB=2*SLOTB;
constexpr int LDS_K=0, LDS_V=NSLOT*SLOTB, LDS_WS=LDS_V+NSLOT*VSLOTB, LDS_OST=LDS_WS+NW*64*4, LDS_BYTES=LDS_OST+NW*4096;
constexpr float C2=0.125f*1.4426950408889634f;
__device__ __forceinline__ void glds16(const void*gsrc,unsigned lds_dst){unsigned keep;
  asm volatile("s_mov_b32 %0, m0\n\ts_mov_b32 m0, %2\n\ts_nop 0\n\tglobal_load_lds_dwordx4 %1, off\n\ts_mov_b32 m0, %0":"=&s"(keep):"v"(gsrc),"s"(lds_dst):"memory");}
__device__ __forceinline__ float max3f(float a,float b,float c){float r;asm("v_max3_f32 %0, %1, %2, %3":"=v"(r):"v"(a),"v"(b),"v"(c));return r;}
__device__ __forceinline__ float max2f(float a,float b){float r;asm("v_max_f32_e32 %0, %1, %2":"=v"(r):"v"(a),"v"(b));return r;}
__device__ __forceinline__ float fadd_s(float a,float b){float r;asm("v_add_f32_e32 %0, %1, %2":"=v"(r):"v"(a),"v"(b));return r;}
__device__ __forceinline__ float fsub_s(float a,float b){float r;asm("v_sub_f32_e32 %0, %1, %2":"=v"(r):"v"(a),"v"(b));return r;}
typedef float f32x2_t __attribute__((ext_vector_type(2))); typedef __bf16 bf16x2_t __attribute__((ext_vector_type(2)));
__device__ __forceinline__ unsigned cvtpk_s(float lo,float hi){f32x2_t v={lo,hi};bf16x2_t b=__builtin_convertvector(v,bf16x2_t);return __builtin_bit_cast(unsigned,b);}
#define WAIT_BAR(N) asm volatile("s_waitcnt vmcnt(" #N ") lgkmcnt(0)\n\ts_barrier":::"memory")

__device__ __forceinline__ void qkt(f32x16&p0,f32x16&p1,const char*Kslot,const bf16x8*qr,const f32x16&negm,int r32,int hi){
  const char*kb=Kslot+hi*1024+r32*16;
  #pragma unroll
  for(int d0=0;d0<4;++d0){
    const bf16x8 b0=*reinterpret_cast<const bf16x8*>(kb+d0*2048);
    const bf16x8 b1=*reinterpret_cast<const bf16x8*>(kb+d0*2048+512);
    if(d0==0){p0=__builtin_amdgcn_mfma_f32_32x32x16_bf16(b0,qr[0],negm,0,0,0);p1=__builtin_amdgcn_mfma_f32_32x32x16_bf16(b1,qr[0],negm,0,0,0);}
    else{p0=__builtin_amdgcn_mfma_f32_32x32x16_bf16(b0,qr[d0],p0,0,0,0);p1=__builtin_amdgcn_mfma_f32_32x32x16_bf16(b1,qr[d0],p1,0,0,0);}}
}
typedef __attribute__((address_space(3))) const char* lds_cptr;
typedef short v4i16_t __attribute__((ext_vector_type(4)));
__device__ __forceinline__ void kload8(bf16x8*kf,lds_cptr kp){
  kf[0]=*(const __attribute__((address_space(3))) bf16x8*)(kp);      kf[1]=*(const __attribute__((address_space(3))) bf16x8*)(kp+512);
  kf[2]=*(const __attribute__((address_space(3))) bf16x8*)(kp+2048); kf[3]=*(const __attribute__((address_space(3))) bf16x8*)(kp+2560);
  kf[4]=*(const __attribute__((address_space(3))) bf16x8*)(kp+4096); kf[5]=*(const __attribute__((address_space(3))) bf16x8*)(kp+4608);
  kf[6]=*(const __attribute__((address_space(3))) bf16x8*)(kp+6144); kf[7]=*(const __attribute__((address_space(3))) bf16x8*)(kp+6656);
}
__device__ __forceinline__ void kload2(bf16x8*kf,lds_cptr kp,int j){ kf[2*j]=*(const __attribute__((address_space(3))) bf16x8*)(kp+j*2048); kf[2*j+1]=*(const __attribute__((address_space(3))) bf16x8*)(kp+j*2048+512); }
__device__ __forceinline__ s16x4 vtr(lds_cptr p){ return __builtin_bit_cast(s16x4,__builtin_amdgcn_ds_read_tr16_b64_v4i16((__attribute__((address_space(3))) v4i16_t*)p)); }
__device__ __forceinline__ float rowmax(const f32x16&p0,const f32x16&p1){
  float a=max3f(p0[0],p0[1],p1[0]),b=max3f(p0[2],p0[3],p1[1]);a=max3f(a,p1[2],p1[3]);
  #pragma unroll
  for(int r=4;r<16;r+=4){a=max3f(a,p0[r],p0[r+1]);b=max3f(b,p0[r+2],p0[r+3]);a=max3f(a,p1[r],p1[r+1]);b=max3f(b,p1[r+2],p1[r+3]);}
  const float m=max2f(a,b);
  auto rr=__builtin_amdgcn_permlane32_swap(__float_as_uint(m),__float_as_uint(m),false,false);
  return max2f(__uint_as_float(rr[0]),__uint_as_float(rr[1]));
}
__device__ __forceinline__ void pv(f32x16*o,int vb,bf16x8 pa0,bf16x8 pa1,bf16x8 pa2,bf16x8 pa3){
  #pragma unroll
  for(int d0=0;d0<4;++d0){s16x4 lo[4],hi[4];
    #pragma unroll
    for(int ks=0;ks<4;++ks){
      asm volatile("ds_read_b64_tr_b16 %0,%1 offset:%c2":"=&v"(lo[ks]):"v"(vb),"i"(d0*4096+ks*1024):"memory");
      asm volatile("ds_read_b64_tr_b16 %0,%1 offset:%c2":"=&v"(hi[ks]):"v"(vb),"i"(d0*4096+ks*1024+512):"memory");}
    asm volatile("s_waitcnt lgkmcnt(0)":::"memory");SBAR();
    #define PK(k) (bf16x8){lo[k][0],lo[k][1],lo[k][2],lo[k][3],hi[k][0],hi[k][1],hi[k][2],hi[k][3]}
    o[d0]=__builtin_amdgcn_mfma_f32_32x32x16_bf16(pa0,PK(0),o[d0],0,0,0);
    o[d0]=__builtin_amdgcn_mfma_f32_32x32x16_bf16(pa1,PK(1),o[d0],0,0,0);
    o[d0]=__builtin_amdgcn_mfma_f32_32x32x16_bf16(pa2,PK(2),o[d0],0,0,0);
    o[d0]=__builtin_amdgcn_mfma_f32_32x32x16_bf16(pa3,PK(3),o[d0],0,0,0);
    #undef PK
  }
}

#ifndef ATTN_STORE16
#define ATTN_STORE16(p,v) (*(__attribute__((address_space(1))) u32x4*)(unsigned long long)(p)=(v))
#endif
struct DiffEpi { float lam, oscale; const float* g; unsigned short* mixh; };
template<int THRL> __device__ __forceinline__ void attn_unit(long rowbase,int qb,const bf16*Q,const bf16*__restrict__ K,const bf16*__restrict__ V,int c_head,const DiffEpi&E,char*shm,bool pre,bool hasn,const bf16*Kn,const bf16*Vn,long rowbase_n){
  int tid_=threadIdx.x; asm volatile("":"+v"(tid_));
  const int tid=tid_,lane=tid&63,r32=lane&31,hi=lane>>5; const int wid=__builtin_amdgcn_readfirstlane(tid>>6);
  const int q0=qb*QB;
  const bf16*Qw=Q+(rowbase+q0+wid*QBLK)*PQ;
  const bf16*Kh=K+rowbase*PQ,*Vh=V+rowbase*PQ;
  const unsigned lds0=(unsigned)(uintptr_t)shm;
  float*wsf=(float*)(shm+LDS_WS)+wid*64;
  const bf16*ksrc=Kh+(long)lane*PQ+wid*8;
  const bf16*vsrc=Vh+(long)(16*(wid&3)+(lane>>2))*PQ+(wid>>2)*32+(lane&3)*8;
  const unsigned kdst=lds0+LDS_K+wid*1024, vdst=lds0+LDS_V+wid*1024;
  #define DMA_K(t,slot) glds16(ksrc+(long)(t)*KVBLK*PQ,(unsigned)__builtin_amdgcn_readfirstlane(kdst+(slot)))
  #define DMA_V(t,slot) do{ glds16(vsrc+(long)(t)*KVBLK*PQ,(unsigned)__builtin_amdgcn_readfirstlane(vdst+2*(slot))); glds16(vsrc+64+(long)(t)*KVBLK*PQ,(unsigned)__builtin_amdgcn_readfirstlane(vdst+2*(slot)+8192)); }while(0)
  const int vb0=(int)(lds0+LDS_V)+((lane>>4)&1)*32+(lane&3)*8+(4*hi+((lane&15)>>2))*64;
  const char*Kbase=shm+LDS_K; bf16x8 kf[8];
  const lds_cptr shm3=(lds_cptr)shm; const lds_cptr kp0=shm3+LDS_K+hi*1024+r32*16; const lds_cptr vp0=shm3+LDS_V+((lane>>4)&1)*32+(lane&3)*8+(4*hi+((lane&15)>>2))*64;
  const int NT=(q0+QB)/KVBLK;
  if(!pre){DMA_K(0,0);DMA_V(0,0);DMA_K(1,SLOTB);}
  bf16x8 qr[4];
  #pragma unroll
  for(int d0=0;d0<4;++d0)qr[d0]=*(const __attribute__((address_space(1))) bf16x8*)(unsigned long long)(&Qw[(long)r32*PQ+d0*16+hi*8]);
  float mhat=0.f,l_reg=0.f;f32x16 o[4];o[0]=f32x16{};o[1]=f32x16{};o[2]=f32x16{};o[3]=f32x16{};const f32x16 ZC=f32x16{};
  const int qrel=wid*QBLK+r32;
  #define CMASK(P0,P1,t) do{int jb_=(t)-(NT-4); if(jb_>=0)cmask(P0,P1,jb_,qrel,hi);}while(0)
  bool resc=false;
  #define START(P0,P1) do{ const float rm=rowmax(P0,P1); resc=false; \
    { const float dl=rm; mhat=fadd_s(mhat,dl); \
      _Pragma("unroll") for(int r=0;r<16;++r){P0[r]=fsub_s(P0[r],dl);P1[r]=fsub_s(P1[r],dl);} \
      } \
    _Pragma("unroll") for(int r=0;r<16;++r)P0[r]=__builtin_amdgcn_exp2f(P0[r]); }while(0)
  #define RESC() do{ if(resc){ asm volatile("s_waitcnt lgkmcnt(0)":::"memory"); \
      _Pragma("unroll") for(int d_=0;d_<4;++d_) _Pragma("unroll") for(int r=0;r<16;++r)o[d_][r]*=wsf[crow(r,hi)]; } }while(0)
  f32x16 pA0,pA1,pB0,pB1;
  int sl_prev=0,sl_cur=0,sl_next=SLOTB;
  #define ROT() do{sl_prev=sl_cur;sl_cur=sl_next;sl_next=(sl_next==(NSLOT-1)*SLOTB)?0:sl_next+SLOTB;}while(0)
  DMA_K(2,2*SLOTB);
  WAIT_BAR(4);
  qkt(pA0,pA1,Kbase,qr,ZC,r32,hi);asm volatile("s_nop 15\n\ts_nop 7":"+v"(pA0),"+v"(pA1));CMASK(pA0,pA1,0);
  START(pA0,pA1);
  _Pragma("unroll") for(int r=0;r<16;++r)pA1[r]=__builtin_amdgcn_exp2f(pA1[r]);
  WAIT_BAR(0);
  DMA_K(3,0);DMA_V(1,SLOTB);
  ROT();
  kload8(kf,kp0+sl_cur);
  WAIT_BAR(3);
  s16x4 vlo[4],vhi[4]; u32x4 pw0,pw1,pw2,pw3;
  #define PKW(P,B) cvtpk_s(P[B],P[B+1])
  #define PAF(k) __builtin_bit_cast(bf16x8,pw##k)
  #define VFR(i) (bf16x8){vlo[i][0],vlo[i][1],vlo[i][2],vlo[i][3],vhi[i][0],vhi[i][1],vhi[i][2],vhi[i][3]}
  #define PIN(x) asm volatile("":"+v"(x))
  #define MX3(a,b,c) __builtin_fmaxf(__builtin_fmaxf((a),(b)),(c))
  #define GAPA(MF,A0,A1,A2,A3,W0,W1,PW) do{ MF; sacc+=A0; sacc+=A1; sacc+=A2; sacc+=A3; PIN(sacc); W0; W1; PIN(PW); SBAR(); }while(0)
  #define EX(v) __builtin_amdgcn_exp2f(v)
  #define GAPB(MF,X,B) do{ MF; X[B]=EX(X[B]); X[B+1]=EX(X[B+1]); PIN(X); SBAR(); }while(0)
  #define VRD(i,s) do{ vlo[s]=vtr(vp_+(((i)>>2)*4096+((i)&3)*1024)); vhi[s]=vtr(vp_+(((i)>>2)*4096+((i)&3)*1024+512)); }while(0)
  #define KRD(G,j) do{ if(G){ kload2(kf,kp0+sl_next,j); SBAR(); } }while(0)
  #define PVM(n,i) o[(i)>>2]=__builtin_amdgcn_mfma_f32_32x32x16_bf16(PAF_((i)&3),VFR((n)&3),o[(i)>>2],0,0,0)
  #define PAF_(k) ((k)==0?PAF(0):(k)==1?PAF(1):(k)==2?PAF(2):PAF(3))
  #define STEP(C0,C1,P0,P1,t,GK,GV,GL) do{ SBAR(); \
    const lds_cptr vp_=vp0+2*sl_prev; \
    VRD(0,0); SBAR(); float sacc=(P0[0]+P0[1]); \
    GAPA(C0=__builtin_amdgcn_mfma_f32_32x32x16_bf16(kf[0],qr[0],ZC,0,0,0), P0[2],P0[3],P0[4],P0[5],     pw0[0]=PKW(P0,0), pw0[1]=PKW(P0,2), pw0); \
    GAPA(C1=__builtin_amdgcn_mfma_f32_32x32x16_bf16(kf[1],qr[0],ZC,0,0,0), P0[6],P0[7],P0[8],P0[9],     pw0[2]=PKW(P0,4), pw0[3]=PKW(P0,6), pw0); \
    VRD(4,1); SBAR(); GAPA(C0=__builtin_amdgcn_mfma_f32_32x32x16_bf16(kf[2],qr[1],C0,0,0,0),   P0[10],P0[11],P0[12],P0[13], pw1[0]=PKW(P0,8), pw1[1]=PKW(P0,10), pw1); \
    GAPA(C1=__builtin_amdgcn_mfma_f32_32x32x16_bf16(kf[3],qr[1],C1,0,0,0),   P0[14],P0[15],P1[0],P1[1],   pw1[2]=PKW(P0,12),pw1[3]=PKW(P0,14), pw1); \
    VRD(1,2); SBAR(); GAPA(C0=__builtin_amdgcn_mfma_f32_32x32x16_bf16(kf[4],qr[2],C0,0,0,0),   P1[2],P1[3],P1[4],P1[5],     pw2[0]=PKW(P1,0), pw2[1]=PKW(P1,2), pw2); \
    GAPA(C1=__builtin_amdgcn_mfma_f32_32x32x16_bf16(kf[5],qr[2],C1,0,0,0),   P1[6],P1[7],P1[8],P1[9],     pw2[2]=PKW(P1,4), pw2[3]=PKW(P1,6), pw2); \
    VRD(5,3); SBAR(); GAPA(C0=__builtin_amdgcn_mfma_f32_32x32x16_bf16(kf[6],qr[3],C0,0,0,0),   P1[10],P1[11],P1[12],P1[13], pw3[0]=PKW(P1,8), pw3[1]=PKW(P1,10), pw3); \
    GAPA(C1=__builtin_amdgcn_mfma_f32_32x32x16_bf16(kf[7],qr[3],C1,0,0,0),   P1[14],P1[15],0.f,0.f,       pw3[2]=PKW(P1,12),pw3[3]=PKW(P1,14), pw3); \
    l_reg+=sacc; \
    if(GK){DMA_K((t)+3,sl_cur);} if(GV){DMA_V((t)+1,sl_next);} \
    _Pragma("unroll") for(int r=0;r<16;++r){C0[r]-=mhat;C1[r]-=mhat;} \
    CMASK(C0,C1,t); \
    { float a=MX3(C0[0],C0[1],C1[0]),b=MX3(C0[2],C0[3],C1[1]); a=MX3(a,C1[2],C1[3]); \
      _Pragma("unroll") for(int r=4;r<16;r+=4){a=MX3(a,C0[r],C0[r+1]);b=MX3(b,C0[r+2],C0[r+3]);a=MX3(a,C1[r],C1[r+1]);b=MX3(b,C1[r+2],C1[r+3]);} \
      float rm=__builtin_fmaxf(a,b); { auto rr=__builtin_amdgcn_permlane32_swap(__float_as_uint(rm),__float_as_uint(rm),false,false); rm=__builtin_fmaxf(__uint_as_float(rr[0]),__uint_as_float(rr[1])); } \
      resc=false; \
      if(__builtin_expect(__any(rm>(float)THRL),0)){ const float dl=__builtin_fmaxf(rm,0.f); mhat+=dl; \
        _Pragma("unroll") for(int r=0;r<16;++r){C0[r]-=dl;C1[r]-=dl;} \
        const float f=__builtin_amdgcn_exp2f(-dl); l_reg*=f; if(hi==0)wsf[r32]=f; resc=true; } } \
    SBAR(); \
    GAPB(PVM(0,0),C0,0);   VRD(2,0); SBAR(); \
    GAPB(PVM(1,4),C0,2);   VRD(6,1); SBAR(); \
    KRD(GL,0); GAPB(PVM(2,1),C0,4);   VRD(3,2); SBAR(); \
    KRD(GL,1); GAPB(PVM(3,5),C0,6);   VRD(7,3); SBAR(); \
    KRD(GL,2); GAPB(PVM(4,2),C0,8);   VRD(8,0); SBAR(); \
    KRD(GL,3); GAPB(PVM(5,6),C0,10);  VRD(12,1); SBAR(); \
    GAPB(PVM(6,3),C0,12);  VRD(9,2); SBAR(); \
    GAPB(PVM(7,7),C0,14);  VRD(13,3); SBAR(); \
    GAPB(PVM(8,8),C1,0);   VRD(10,0); SBAR(); \
    GAPB(PVM(9,12),C1,2);  VRD(14,1); SBAR(); \
    GAPB(PVM(10,9),C1,4);  VRD(11,2); SBAR(); \
    GAPB(PVM(11,13),C1,6); VRD(15,3); SBAR(); \
    GAPB(PVM(12,10),C1,8); \
    GAPB(PVM(13,14),C1,10); \
    GAPB(PVM(14,11),C1,12); \
    GAPB(PVM(15,15),C1,14); \
    }while(0)
  int t=1;
  #undef CMASK
  #define CMASK(P0,P1,t) do{}while(0)
  for(;t+5<NT;t+=2){
    STEP(pB0,pB1,pA0,pA1,t,true,true,true);     WAIT_BAR(3); RESC(); ROT();
    STEP(pA0,pA1,pB0,pB1,t+1,true,true,true);   WAIT_BAR(3); RESC(); ROT();
  }
  #undef CMASK
  #define CMASK(P0,P1,t) do{int jb_=(t)-(NT-4); if(jb_>=0)cmask(P0,P1,jb_,qrel,hi);}while(0)
  #define ENDW(tt) do{ if((tt)+3<NT){WAIT_BAR(3);} else if((tt)+2<NT){WAIT_BAR(2);} else {WAIT_BAR(0);} }while(0)
  for(;t+1<NT;t+=2){
    STEP(pB0,pB1,pA0,pA1,t,(t+3<NT),(t+1<NT),(t+1<NT));       ENDW(t);   RESC(); ROT();
    STEP(pA0,pA1,pB0,pB1,t+1,(t+4<NT),(t+2<NT),(t+2<NT));     ENDW(t+1); RESC(); ROT();
  }
  STEP(pB0,pB1,pA0,pA1,NT-1,false,false,false); RESC();
  { float sacc=pB0[0]+pB0[1]; _Pragma("unroll") for(int r=2;r<16;++r)sacc+=pB0[r]; _Pragma("unroll") for(int r=0;r<16;++r)sacc+=pB1[r]; l_reg+=sacc;
    pw0=(u32x4){PKW(pB0,0),PKW(pB0,2),PKW(pB0,4),PKW(pB0,6)};pw1=(u32x4){PKW(pB0,8),PKW(pB0,10),PKW(pB0,12),PKW(pB0,14)};pw2=(u32x4){PKW(pB1,0),PKW(pB1,2),PKW(pB1,4),PKW(pB1,6)};pw3=(u32x4){PKW(pB1,8),PKW(pB1,10),PKW(pB1,12),PKW(pB1,14)};
    SBAR(); pv(o,vb0+2*sl_cur,PAF(0),PAF(1),PAF(2),PAF(3)); }
  #undef PKW
  #undef PAF
  #undef VFR
  #undef PIN
  #undef MX3
  #undef GAPA
  #undef GAPB
  #undef EX
  #undef VRD
  #undef PVM
  #undef PAF_
  #undef KRD
  #undef STEP
  #undef ENDW
  asm volatile("s_waitcnt lgkmcnt(0)\n\ts_barrier":::"memory");
  if(hasn){ const bf16*ksn=Kn+rowbase_n*PQ+(long)lane*PQ+wid*8; const bf16*vsn=Vn+rowbase_n*PQ+(long)(16*(wid&3)+(lane>>2))*PQ+(wid>>2)*32+(lane&3)*8;
    glds16(ksn,(unsigned)__builtin_amdgcn_readfirstlane(kdst)); glds16(vsn,(unsigned)__builtin_amdgcn_readfirstlane(vdst)); glds16(vsn+64,(unsigned)__builtin_amdgcn_readfirstlane(vdst+8192)); glds16(ksn+(long)KVBLK*PQ,(unsigned)__builtin_amdgcn_readfirstlane(kdst+SLOTB)); }
  {auto rr=__builtin_amdgcn_permlane32_swap(__float_as_uint(l_reg),__float_as_uint(l_reg),false,false);l_reg=__uint_as_float(rr[0])+__uint_as_float(rr[1]);}
  if(hi==0)wsf[32+r32]=l_reg;asm volatile("s_waitcnt lgkmcnt(0)":::"memory");
  float rli[16];
  #pragma unroll
  for(int r=0;r<16;++r)rli[r]=__builtin_amdgcn_rcpf(wsf[32+crow(r,hi)]);
  { bf16*stg=(bf16*)(shm+LDS_OST)+wid*2048;
    unsigned short*mbase=E.mixh+(rowbase+q0+wid*QBLK)*1024;
    if(c_head==0){
      #pragma unroll
      for(int hb=0;hb<2;++hb){
        #pragma unroll
        for(int r=0;r<16;++r){const int orow=crow(r,hi); stg[orow*64+r32]=__float2bfloat16(o[2*hb][r]*rli[r]); stg[orow*64+32+r32]=__float2bfloat16(o[2*hb+1][r]*rli[r]);}
        asm volatile("s_waitcnt lgkmcnt(0)":::"memory");
        #pragma unroll
        for(int i=0;i<4;++i){const int row=i*8+(lane>>3),ch=lane&7; const u32x4 v=*(const u32x4*)(stg+row*64+ch*8); ATTN_STORE16(mbase+(long)row*1024+hb*64+ch*8,v);}
        asm volatile("s_waitcnt lgkmcnt(0)":::"memory"); }
    } else {
      u32x4 v0[2][4];
      #pragma unroll
      for(int hb=0;hb<2;++hb)
        #pragma unroll
        for(int i=0;i<4;++i){const int row=i*8+(lane>>3),ch=lane&7; v0[hb][i]=*(const __attribute__((address_space(1))) u32x4*)(unsigned long long)(mbase+(long)row*1024+hb*64+ch*8);}
      float dv[2][4][8]; float ss[4]={0.f,0.f,0.f,0.f};
      #pragma unroll
      for(int hb=0;hb<2;++hb){
        #pragma unroll
        for(int r=0;r<16;++r){const int orow=crow(r,hi); stg[orow*64+r32]=__float2bfloat16(o[2*hb][r]*rli[r]); stg[orow*64+32+r32]=__float2bfloat16(o[2*hb+1][r]*rli[r]);}
        asm volatile("s_waitcnt lgkmcnt(0)":::"memory");
        #pragma unroll
        for(int i=0;i<4;++i){const int row=i*8+(lane>>3),ch=lane&7; const u32x4 v1=*(const u32x4*)(stg+row*64+ch*8);
          #pragma unroll
          for(int e=0;e<4;++e){const float dl=__uint_as_float(v0[hb][i][e]<<16)-E.lam*__uint_as_float(v1[e]<<16),dh=__uint_as_float(v0[hb][i][e]&0xffff0000u)-E.lam*__uint_as_float(v1[e]&0xffff0000u);
            dv[hb][i][2*e]=dl; dv[hb][i][2*e+1]=dh; ss[i]+=dl*dl+dh*dh;} }
        asm volatile("s_waitcnt lgkmcnt(0)":::"memory"); }
      #pragma unroll
      for(int i=0;i<4;++i){const int row=i*8+(lane>>3),ch=lane&7; float t=ss[i];
        t+=__int_as_float(__builtin_amdgcn_ds_swizzle(__float_as_int(t),(1<<10)|0x1f)); t+=__int_as_float(__builtin_amdgcn_ds_swizzle(__float_as_int(t),(2<<10)|0x1f)); t+=__int_as_float(__builtin_amdgcn_ds_swizzle(__float_as_int(t),(4<<10)|0x1f));
        const float rs=__builtin_amdgcn_rsqf(t*(1.f/128.f)+1e-5f)*E.oscale;
        #pragma unroll
        for(int hb=0;hb<2;++hb){const __attribute__((address_space(1))) float*gp=(const __attribute__((address_space(1))) float*)(unsigned long long)(E.g+hb*64+ch*8);
          u32x4 ov;
          #pragma unroll
          for(int e=0;e<4;++e)ov[e]=cvtpk_s(dv[hb][i][2*e]*rs*gp[2*e],dv[hb][i][2*e+1]*rs*gp[2*e+1]);
          ATTN_STORE16(mbase+(long)row*1024+hb*64+ch*8,ov);} } } }
  asm volatile("s_waitcnt lgkmcnt(0)":::"memory");
  #undef DMA_K
  #undef DMA_V
  #undef CMASK
  #undef START
  #undef RESC
  #undef ROT
}
constexpr int ATTN_LDS_BYTES=LDS_BYTES;
struct StaticOrder {
  int vcu; int grid;
  __device__ __forceinline__ explicit StaticOrder(int grid_,int block):vcu(__builtin_amdgcn_readfirstlane((grid_%8==0)?(block%8)*(grid_/8)+block/8:block)),grid(grid_){}
};
__device__ __forceinline__ unsigned long long uni64(unsigned long long v){ const unsigned lo=__builtin_amdgcn_readfirstlane((unsigned)v),hi=__builtin_amdgcn_readfirstlane((unsigned)(v>>32)); return ((unsigned long long)hi<<32)|lo; }
template<int THRL=8> __device__ __forceinline__ void attn_phase(char*lds,const bf16*proj_,unsigned short*mix_,int aq,int ak,int av,float lam,float oscale,const float*norm_g_,const StaticOrder&S){
  const bf16*proj=(const bf16*)uni64((unsigned long long)proj_); unsigned short*mix=(unsigned short*)uni64((unsigned long long)mix_); const float*norm_g=(const float*)uni64((unsigned long long)norm_g_);
  const bool bal=(S.grid==256); const int xcd=S.vcu>>5,j=S.vcu&31;
  const int ntrip=bal?2:(S.vcu<512?(512-S.vcu+S.grid-1)/S.grid:0);
  for(int i=0;i<ntrip;++i){ const int u=S.vcu+i*S.grid;
    const int T_=j>>2,k_=j&3; const int sx_=(T_==0)?13:(T_==1)?9:(T_<5)?18-T_:17-T_, sy_=(T_==0)?1:(T_==1)?5:(T_<5)?T_:T_+1;
    const int bh=bal?xcd*4+2*i+(k_>>1):(u>>4),qb=bal?(((i^(k_&1))?sy_:sx_)-1):(u&15),b=bh>>2,h=bh&3;
    DiffEpi E; E.lam=__uint_as_float(__builtin_amdgcn_readfirstlane(__float_as_uint(lam))); E.oscale=oscale; E.g=(const float*)uni64((unsigned long long)(norm_g+h*128)); E.mixh=(unsigned short*)uni64((unsigned long long)(mix+512+h*128));
    for(int c=0;c<2;++c){
      const int ni_=(c==0)?i:i+1; const bool hasn_=ni_<ntrip; const int un_=S.vcu+ni_*S.grid;
      const int nbh_=bal?xcd*4+2*ni_+(k_>>1):(un_>>4); const int nh_=nbh_&3; const long nrb_=(long)__builtin_amdgcn_readfirstlane((nbh_>>2)*SEQ);
      attn_unit<THRL>((long)__builtin_amdgcn_readfirstlane(b*SEQ),__builtin_amdgcn_readfirstlane(qb),(const bf16*)uni64((unsigned long long)(proj+aq+h*128+c*64)),(const bf16*)uni64((unsigned long long)(proj+ak+h*128+c*64)),(const bf16*)uni64((unsigned long long)(proj+av+h*128)),c,E,lds,
        !(i==0&&c==0),hasn_,(const bf16*)uni64((unsigned long long)(proj+ak+nh_*128+(c^1)*64)),(const bf16*)uni64((unsigned long long)(proj+av+nh_*128)),nrb_); } }
}
#undef SBAR
#undef WAIT_BAR
}
constexpr int BATCH = 8, SEQ = 4096, DM = 1024, DEPTH = 2, T = BATCH * SEQ, FF = 4096;
constexpr int NP = 3584;
constexpr int AQ = 0, AK = 512, AV = 1024;
constexpr int MB0 = 1536, MQ = MB0, MK = MB0 + 256, MV = MB0 + 512, MO = MB0 + 768, MI = MB0 + 1024, MF = MB0 + 1028;
constexpr int R0 = MB0 + 1032;
constexpr int NREAL = 3464;
__host__ __device__ __forceinline__ int proj_src_col(int n) { return n < 1536 ? 1928 + n : (n < 3464 ? n - 1536 : -1); }
constexpr float C2 = 0.125f * 1.4426950408889634f;
typedef unsigned short bf16;
typedef float f32x4 __attribute__((ext_vector_type(4)));
typedef short bf16x8 __attribute__((ext_vector_type(8)));
typedef unsigned u32x4 __attribute__((ext_vector_type(4)));

__device__ __forceinline__ float bf2f(bf16 v) { return __uint_as_float(((unsigned)v) << 16); }
__device__ __forceinline__ unsigned f2bf(float f) { unsigned u = __float_as_uint(f); return (u + 0x7fffu + ((u >> 16) & 1u)) >> 16; }
template <int X> __device__ __forceinline__ float xor_lane(float v) {
    if constexpr (X < 32) return __int_as_float(__builtin_amdgcn_ds_swizzle(__float_as_int(v), (X << 10) | 0x1f));
    else { auto rr = __builtin_amdgcn_permlane32_swap(__float_as_uint(v), __float_as_uint(v), false, false); return __uint_as_float((threadIdx.x & 32) ? rr[0] : rr[1]); }
}
#define DPP_F(old, src, ctrl, rmask, bctl) __int_as_float(__builtin_amdgcn_update_dpp(__float_as_int(old), __float_as_int(src), ctrl, rmask, 0xf, bctl))
__device__ __forceinline__ float wave_sum(float v) {
    v += DPP_F(0.f, v, 0x111, 0xf, true); v += DPP_F(0.f, v, 0x112, 0xf, true); v += DPP_F(0.f, v, 0x114, 0xf, true); v += DPP_F(0.f, v, 0x118, 0xf, true);
    v += DPP_F(0.f, v, 0x142, 0xa, true); v += DPP_F(0.f, v, 0x143, 0xc, true);
    return __int_as_float(__builtin_amdgcn_readlane(__float_as_int(v), 63));
}
__device__ __forceinline__ float wave_max(float v) {
    v = fmaxf(v, DPP_F(v, v, 0x111, 0xf, false)); v = fmaxf(v, DPP_F(v, v, 0x112, 0xf, false)); v = fmaxf(v, DPP_F(v, v, 0x114, 0xf, false)); v = fmaxf(v, DPP_F(v, v, 0x118, 0xf, false));
    v = fmaxf(v, DPP_F(v, v, 0x142, 0xa, false)); v = fmaxf(v, DPP_F(v, v, 0x143, 0xc, false));
    return __int_as_float(__builtin_amdgcn_readlane(__float_as_int(v), 63));
}
__device__ __forceinline__ float wave_scan_sum(float v) {
    v += DPP_F(0.f, v, 0x111, 0xf, true); v += DPP_F(0.f, v, 0x112, 0xf, true); v += DPP_F(0.f, v, 0x114, 0xf, true); v += DPP_F(0.f, v, 0x118, 0xf, true);
    v += DPP_F(0.f, v, 0x142, 0xa, true); v += DPP_F(0.f, v, 0x143, 0xc, true);
    return v;
}
__device__ __forceinline__ float wave_scan_max(float v) {
    v = fmaxf(v, DPP_F(v, v, 0x111, 0xf, false)); v = fmaxf(v, DPP_F(v, v, 0x112, 0xf, false)); v = fmaxf(v, DPP_F(v, v, 0x114, 0xf, false)); v = fmaxf(v, DPP_F(v, v, 0x118, 0xf, false));
    v = fmaxf(v, DPP_F(v, v, 0x142, 0xa, false)); v = fmaxf(v, DPP_F(v, v, 0x143, 0xc, false));
    return v;
}
__device__ __forceinline__ float sum_q4(float v) { v += xor_lane<16>(v);
    auto rr = __builtin_amdgcn_permlane32_swap(__float_as_uint(v), __float_as_uint(v), false, false); return __uint_as_float(rr[0]) + __uint_as_float(rr[1]); }
__device__ __forceinline__ float lane_up(float v, int lane, int o) { return __int_as_float(__builtin_amdgcn_ds_bpermute((lane - o) << 2, __float_as_int(v))); }
__device__ __forceinline__ float sigmoidf_(float x) { return 1.f / (1.f + __expf(-x)); }
__device__ __forceinline__ float softplusf_(float x) { return fmaxf(x, 0.f) + log1pf(__expf(-fabsf(x))); }
__device__ __forceinline__ float softplus_fast(float x) { return fmaxf(x, 0.f) + 0.6931471805599453f * __builtin_amdgcn_logf(1.f + __builtin_amdgcn_exp2f(-1.4426950408889634f * fabsf(x))); }

constexpr size_t MiB = 1u << 20;
constexpr size_t WS_CTL = 0;
constexpr size_t WS_WIN = 1 * MiB;
constexpr size_t WS_WOUT = WS_WIN + 14 * MiB;
constexpr size_t WS_WUP = WS_WOUT + 4 * MiB;
constexpr size_t WS_WDN = WS_WUP + 16 * MiB;
constexpr size_t WS_XB = 51 * MiB;
constexpr size_t WS_PROJ = 115 * MiB;
constexpr size_t WS_MIX = 339 * MiB;
constexpr size_t WS_RWG = 403 * MiB, WS_RWH = 419 * MiB, WS_RWRH = 435 * MiB, WS_RWYL = 451 * MiB, WS_GATE = 467 * MiB, WS_BON = 483 * MiB;
constexpr size_t WS_SCR = 51 * MiB;
constexpr size_t WS_HID = 115 * MiB;
constexpr size_t WS_MLC = 484 * MiB, WS_MLN = 500 * MiB, WS_MLS = 501 * MiB;
constexpr size_t WS_SSQ = 502 * MiB;
constexpr size_t WS_END = 504 * MiB;

#ifndef LAS
#define LAS __attribute__((address_space(3)))
#endif
#define XB_TMO      128
#define XB_XCNT(j)  (256  + 64 * (j))
#define XB_XSUB(j)  (1280 + 64 * (j))
#define XB_XGEN(j)  (2304 + 64 * (j))
#define XB_TOP      3328
#define XB_TOPGEN   3392
#define XCD_BAR_WORDS 3456
#define XB_SPIN_CAP (1u << 18)

__device__ __forceinline__ unsigned xb_ld(unsigned* p)              { return __hip_atomic_load(p, __ATOMIC_RELAXED, __HIP_MEMORY_SCOPE_AGENT); }
__device__ __forceinline__ unsigned xb_add(unsigned* p, unsigned v) { return __hip_atomic_fetch_add(p, v, __ATOMIC_RELAXED, __HIP_MEMORY_SCOPE_AGENT); }
__device__ __forceinline__ unsigned xb_xcc_id() { return (unsigned)__builtin_amdgcn_s_getreg((3 << 11) | 20) & 0xFu; }
#define XB_SPIN(cond, bar) do { unsigned _sp = 0; while (cond) { __builtin_amdgcn_s_sleep(1); \
    if ((++_sp & 255u) == 0u) { if (xb_ld(&(bar)[XB_TMO])) break; if (_sp > XB_SPIN_CAP) { atomicAdd(&(bar)[XB_TMO], 1u); break; } } } } while (0)

struct XcdBarrier {
    unsigned* bar; unsigned x;
    volatile LAS unsigned* st;
};

__device__ __forceinline__ XcdBarrier xcd_barrier_post(unsigned* bar, volatile LAS unsigned* st) {
    XcdBarrier b; b.bar = bar; b.x = xb_xcc_id(); b.st = st;
    if (threadIdx.x == 0) (void)xb_add(&bar[XB_XCNT(b.x)], 1u);
    return b;
}
__device__ __forceinline__ void xcd_barrier_complete(unsigned* bar, unsigned x, unsigned& nloc, unsigned& nx) {
    const unsigned G = gridDim.x * gridDim.y * gridDim.z;
    unsigned sum, cnt, mine, sp = 0u;
    for (;;) {
        sum = 0u; cnt = 0u; mine = 0u;
#pragma unroll
        for (unsigned j = 0; j < 16; ++j) { const unsigned c = xb_ld(&bar[XB_XCNT(j)]); sum += c; cnt += (c > 0u) ? 1u : 0u; mine = (j == x) ? c : mine; }
        if (sum == G) break;
        __builtin_amdgcn_s_sleep(1);
        if ((++sp & 255u) == 0u) { if (xb_ld(&bar[XB_TMO])) break; if (sp > XB_SPIN_CAP) { atomicAdd(&bar[XB_TMO], 1u); break; } }
    }
    nloc = mine > 0u ? mine : 1u; nx = cnt > 0u ? cnt : 1u;
}

__device__ __forceinline__ void xcd_barrier(const XcdBarrier& b) {
    asm volatile("s_waitcnt vmcnt(0)" ::: "memory");
    __syncthreads();
    if (threadIdx.x == 0) {
        unsigned* bar = b.bar;
        __builtin_amdgcn_s_waitcnt(0);
        unsigned nloc = b.st[0], nx = b.st[1];
        if (nloc == 0u) { xcd_barrier_complete(bar, b.x, nloc, nx); b.st[0] = nloc; b.st[1] = nx; }
        const unsigned old = xb_add(&bar[XB_XSUB(b.x)], 1u);
        const unsigned gen = old / nloc;
        if (old + 1u == (gen + 1u) * nloc) {
            __builtin_amdgcn_fence(__ATOMIC_RELEASE, "agent");
            asm volatile("s_waitcnt vmcnt(0)" ::: "memory");
            const unsigned og = xb_add(&bar[XB_TOP], 1u);
            const unsigned tg = og / nx;
            if (og + 1u == (tg + 1u) * nx) xb_add(&bar[XB_TOPGEN], 1u);
            else XB_SPIN(xb_ld(&bar[XB_TOPGEN]) == tg, bar);
            __builtin_amdgcn_fence(__ATOMIC_ACQUIRE, "agent");
            xb_add(&bar[XB_XGEN(b.x)], 1u);
            asm volatile("s_waitcnt vmcnt(0)" ::: "memory");
        } else {
            XB_SPIN(xb_ld(&bar[XB_XGEN(b.x)]) == gen, bar);
            __builtin_amdgcn_fence(__ATOMIC_ACQUIRE, "agent");
            asm volatile("s_waitcnt vmcnt(0)" ::: "memory");
        }
    }
    __syncthreads();
}

namespace rw {
typedef __attribute__((address_space(3))) unsigned char lds_u8;
typedef __attribute__((address_space(3))) unsigned short lds_bf;
typedef __attribute__((address_space(3))) float lds_f32;
constexpr int TS = 72, TILE_B = 64 * TS * 2;
constexpr int MISC_OFF = 15 * TILE_B;
__device__ __forceinline__ lds_bf* slot(lds_u8* lds, int i) { return (lds_bf*)(lds + i * TILE_B); }
typedef float f32x2_t __attribute__((ext_vector_type(2))); typedef __bf16 bf16x2_t __attribute__((ext_vector_type(2)));
__device__ __forceinline__ unsigned pk(float lo, float hi) { f32x2_t v = {lo, hi}; bf16x2_t b = __builtin_convertvector(v, bf16x2_t); return __builtin_bit_cast(unsigned, b); }
__device__ __forceinline__ unsigned short bf1(float x) { return (unsigned short)pk(x, x); }
__device__ __forceinline__ f32x4 mma64(const lds_bf* A, const lds_bf* Bt, int mt, int nt, int lane, f32x4 acc) {
    const int r = lane & 15, q = lane >> 4;
    const lds_bf* ap = A + (mt * 16 + r) * TS + q * 8; const lds_bf* bp = Bt + (nt * 16 + r) * TS + q * 8;
    const bf16x8 a0 = *(const __attribute__((address_space(3))) bf16x8*)ap, a1 = *(const __attribute__((address_space(3))) bf16x8*)(ap + 32);
    const bf16x8 b0 = *(const __attribute__((address_space(3))) bf16x8*)bp, b1 = *(const __attribute__((address_space(3))) bf16x8*)(bp + 32);
    acc = __builtin_amdgcn_mfma_f32_16x16x32_bf16(a0, b0, acc, 0, 0, 0);
    acc = __builtin_amdgcn_mfma_f32_16x16x32_bf16(a1, b1, acc, 0, 0, 0);
    return acc;
}
__device__ __forceinline__ void st_nm(lds_bf* tile, int mt, int nt, int lane, f32x4 v) {
    typedef unsigned u32x2 __attribute__((ext_vector_type(2)));
    u32x2 w; w.x = pk(v[0], v[1]); w.y = pk(v[2], v[3]);
    *(__attribute__((address_space(3))) u32x2*)(tile + (nt * 16 + (lane & 15)) * TS + mt * 16 + (lane >> 4) * 4) = w;
}
__device__ __forceinline__ f32x4 ld_nm(const lds_bf* tile, int mt, int nt, int lane) {
    typedef unsigned u32x2 __attribute__((ext_vector_type(2)));
    const u32x2 w = *(const __attribute__((address_space(3))) u32x2*)(tile + (nt * 16 + (lane & 15)) * TS + mt * 16 + (lane >> 4) * 4);
    return (f32x4){__uint_as_float(w.x << 16), __uint_as_float(w.x & 0xffff0000u), __uint_as_float(w.y << 16), __uint_as_float(w.y & 0xffff0000u)};
}
__device__ __forceinline__ void st_mn(lds_bf* tile, int mt, int nt, int lane, f32x4 v) {
    lds_bf* p = tile + (mt * 16 + (lane >> 4) * 4) * TS + nt * 16 + (lane & 15);
    const unsigned w01 = pk(v[0], v[1]), w23 = pk(v[2], v[3]);
    p[0] = (unsigned short)w01; p[TS] = (unsigned short)(w01 >> 16); p[2 * TS] = (unsigned short)w23; p[3 * TS] = (unsigned short)(w23 >> 16);
}
struct W { const float *mu, *w0, *w_up, *a0, *a_up, *g_up, *k_k, *k_a, *r_k, *ln_g, *ln_b; };
struct Buf { bf16* G; bf16* H; bf16* RH; bf16* YL; bf16* GATE; float* BON; };

}
namespace ml {
struct P { const float *cw, *cb, *b_i, *b_f, *norm_g; };
struct Buf { bf16* C; float* N; float* SC; };
__device__ void m1_gates(rw::lds_u8* lds, int unit, int lane, float igv, float fgv, const Buf& o);
__device__ void m1_tiles(rw::lds_u8* lds, int lane, int wv, const float (&xk)[11], const float (&cwv)[5], const float (&vv)[8], int s0);
__device__ void m1_product(rw::lds_u8* lds, int unit, int lane, int wv, const Buf& o); }
namespace rw {
#define RW_SYNC() asm volatile("s_waitcnt lgkmcnt(0)\n\ts_barrier" ::: "memory")
struct R1W { float muA, wuv[4], auv[4], guv[8], mur, muk, muv, w0, a0, kkc, kac, rkc, cwv[5], gbi, gbf; };
__device__ __forceinline__ void r1_load_w(R1W& Q, int h, const W& w, const ml::P& mp) {
    int tid_ = threadIdx.x; asm volatile("" : "+v"(tid_));
    const int tid = tid_, lane = tid & 63, wv = __builtin_amdgcn_readfirstlane(tid >> 6), colA = tid & 127, hc = h * 64 + lane;
    Q.muA = w.mu[768 + colA];
#pragma unroll
    for (int i = 0; i < 4; ++i) { Q.wuv[i] = w.w_up[(wv + 8 * i) * 256 + hc]; Q.auv[i] = w.a_up[(wv + 8 * i) * 256 + hc]; }
#pragma unroll
    for (int i = 0; i < 8; ++i) Q.guv[i] = w.g_up[(wv + 8 * i) * 256 + hc];
    Q.mur = w.mu[hc]; Q.muk = w.mu[256 + hc]; Q.muv = w.mu[512 + hc]; Q.w0 = w.w0[hc]; Q.a0 = w.a0[hc]; Q.kkc = w.k_k[hc]; Q.kac = w.k_a[hc]; Q.rkc = w.r_k[hc];
#pragma unroll
    for (int i = 0; i < 4; ++i) Q.cwv[i] = mp.cw[i * 512 + 256 + hc];
    Q.cwv[4] = mp.cb[256 + hc]; Q.gbi = mp.b_i[h]; Q.gbf = mp.b_f[h];
}
__device__ __forceinline__ void r1_unit(lds_u8* lds, int unit, const R1W& Q, const bf16* __restrict__ proj, const W& w, const Buf& o, const ml::P& mp, const ml::Buf& mo) {
    int tid_ = threadIdx.x; asm volatile("" : "+v"(tid_));
    const int tid = tid_, lane = tid & 63, wv = __builtin_amdgcn_readfirstlane(tid >> 6);
    const int ch = unit & 63, bh = unit >> 6, h = bh & 3, b = bh >> 2;
    const size_t t0 = (size_t)b * SEQ + ch * 64;
    lds_bf* S0 = slot(lds, 0); lds_bf* S1 = slot(lds, 1); lds_bf* S2 = slot(lds, 2); lds_bf* S3 = slot(lds, 3); lds_bf* S4 = slot(lds, 4); lds_bf* S5 = slot(lds, 5); lds_bf* S6 = slot(lds, 6);
    lds_bf* S7 = slot(lds, 7); lds_bf* S8 = slot(lds, 8); lds_bf* S9 = slot(lds, 9); lds_bf* S10 = slot(lds, 10); lds_bf* S11 = slot(lds, 11); lds_bf* S12 = slot(lds, 12);
    lds_f32* gamL = (lds_f32*)(lds + MISC_OFF); lds_f32* part = gamL + 64;
    const bool first = (ch == 0);
    const int colA = tid & 127, tgA = tid >> 7;
    const bf16* pcA = proj + (t0 + tgA * 16) * NP + R0 + 768 + colA;
    bf16 rA[17];
    rA[0] = pcA[-(long)NP];
#pragma unroll
    for (int i = 0; i < 16; ++i) rA[1 + i] = pcA[(size_t)i * NP];
    const float muA = Q.muA;
    float igv = 0.f, fgv = 0.f;
    if (wv == 7) { const bf16* pr = proj + (t0 + lane) * NP; const bf16 gi = pr[MI + h], gf = pr[MF + h]; igv = bf2f(gi) + Q.gbi; fgv = bf2f(gf) + Q.gbf; }
    const int hc = h * 64 + lane;
    const bf16* pcC = proj + (t0 + wv * 8) * NP + R0 + hc;
    bf16 rC[9][3];
#pragma unroll
    for (int j = 0; j < 3; ++j) rC[0][j] = pcC[-(long)NP + 256 * j];
#pragma unroll
    for (int i = 0; i < 8; ++i)
#pragma unroll
        for (int j = 0; j < 3; ++j) rC[1 + i][j] = pcC[(size_t)i * NP + 256 * j];
    const float mur = Q.mur, muk = Q.muk, muv = Q.muv, w0 = Q.w0, a0 = Q.a0, kkc = Q.kkc, kac = Q.kac, rkc = Q.rkc;
    float xk[11], cwv[5], mvv[8];
    { const bf16* pk_ = proj + (t0 + wv * 8) * NP + MK + hc; const bf16* pv = proj + (t0 + wv * 8) * NP + MV + hc; bf16 rk[11], rv[8];
#pragma unroll
      for (int i = 0; i < 11; ++i) rk[i] = pk_[((long)i - 3) * NP];
#pragma unroll
      for (int i = 0; i < 8; ++i) rv[i] = pv[(size_t)i * NP];
#pragma unroll
      for (int i = 0; i < 5; ++i) cwv[i] = Q.cwv[i];
#pragma unroll
      for (int i = 0; i < 11; ++i) xk[i] = bf2f(rk[i]);
#pragma unroll
      for (int i = 0; i < 8; ++i) mvv[i] = bf2f(rv[i]); }
    constexpr int LS = 136;
    lds_bf* Lt = S0;
    lds_bf* Wu = (lds_bf*)(lds + 2 * TILE_B);
    lds_bf* Au = Wu + 64 * 40;
    lds_bf* Gu = Au + 64 * 40;
    { const int col = colA, tg = tgA; const float mu = muA; const float esc = col < 32 ? 2.885390081777927f : -1.4426950408889634f;
      float prev = (first && tg == 0) ? 0.f : bf2f(rA[0]);
#pragma unroll
      for (int i = 0; i < 16; ++i) { const float p = bf2f(rA[1 + i]); const float x = p + (prev - p) * mu; prev = p;
          const float rc = __builtin_amdgcn_rcpf(1.f + __builtin_amdgcn_exp2f(x * esc));
          const float y = col < 32 ? 1.f - 2.f * rc : (col < 64 ? x : rc);
          Lt[(tg * 16 + i) * LS + col] = bf1(y); }
      const int c = lane;
#pragma unroll
      for (int i = 0; i < 4; ++i) { const int k = wv + 8 * i; Wu[c * 40 + k] = (unsigned short)f2bf(Q.wuv[i]); Au[c * 40 + k] = (unsigned short)f2bf(Q.auv[i]); }
#pragma unroll
      for (int i = 0; i < 8; ++i) { const int k = wv + 8 * i; Gu[c * TS + k] = (unsigned short)f2bf(Q.guv[i]); } }
    if (wv == 7) ml::m1_gates(lds, unit, lane, igv, fgv, mo);
    RW_SYNC();
    lds_f32* Fw = (lds_f32*)(lds + 8 * TILE_B); lds_f32* Fa = Fw + 4096; lds_bf* Fg = (lds_bf*)(Fa + 4096);
    { const int r = lane & 15, q = lane >> 4, mt = wv >> 1;
#pragma unroll
      for (int tt = 0; tt < 2; ++tt) { const int nt = (wv & 1) * 2 + tt;
          const bf16x8 aw = *(const __attribute__((address_space(3))) bf16x8*)(Lt + (mt * 16 + r) * LS + q * 8);
          const bf16x8 aa = *(const __attribute__((address_space(3))) bf16x8*)(Lt + (mt * 16 + r) * LS + 32 + q * 8);
          const bf16x8 ag0 = *(const __attribute__((address_space(3))) bf16x8*)(Lt + (mt * 16 + r) * LS + 64 + q * 8);
          const bf16x8 ag1 = *(const __attribute__((address_space(3))) bf16x8*)(Lt + (mt * 16 + r) * LS + 96 + q * 8);
          const bf16x8 bw = *(const __attribute__((address_space(3))) bf16x8*)(Wu + (nt * 16 + r) * 40 + q * 8);
          const bf16x8 ba = *(const __attribute__((address_space(3))) bf16x8*)(Au + (nt * 16 + r) * 40 + q * 8);
          const bf16x8 bg0 = *(const __attribute__((address_space(3))) bf16x8*)(Gu + (nt * 16 + r) * TS + q * 8);
          const bf16x8 bg1 = *(const __attribute__((address_space(3))) bf16x8*)(Gu + (nt * 16 + r) * TS + 32 + q * 8);
          const f32x4 z = {0.f, 0.f, 0.f, 0.f};
          const f32x4 fw = __builtin_amdgcn_mfma_f32_16x16x32_bf16(aw, bw, z, 0, 0, 0);
          const f32x4 fa = __builtin_amdgcn_mfma_f32_16x16x32_bf16(aa, ba, z, 0, 0, 0);
          f32x4 fg = __builtin_amdgcn_mfma_f32_16x16x32_bf16(ag0, bg0, z, 0, 0, 0); fg = __builtin_amdgcn_mfma_f32_16x16x32_bf16(ag1, bg1, fg, 0, 0, 0);
#pragma unroll
          for (int e = 0; e < 4; ++e) { const int t = mt * 16 + q * 4 + e, c = nt * 16 + r; Fw[t * 64 + c] = fw[e]; Fa[t * 64 + c] = fa[e]; Fg[t * TS + c] = bf1(fg[e]); } } }
    RW_SYNC();
    ml::m1_tiles(lds, lane, wv, xk, cwv, mvv, ch * 64 + wv * 8);
    { const int c = lane, tg = wv;
      float pr, pk_, pv; if (first && tg == 0) { pr = 0.f; pk_ = 0.f; pv = 0.f; } else { pr = bf2f(rC[0][0]); pk_ = bf2f(rC[0][1]); pv = bf2f(rC[0][2]); }
      float rr[8], k2[8], vv[8], ap[8], bp[8], lw[8];
#pragma unroll
      for (int i = 0; i < 8; ++i) { const int t = tg * 8 + i;
          const float xr = bf2f(rC[1 + i][0]), xk_ = bf2f(rC[1 + i][1]), xv = bf2f(rC[1 + i][2]);
          const float r = xr + (pr - xr) * mur, k = xk_ + (pk_ - xk_) * muk, v = xv + (pv - xv) * muv; pr = xr; pk_ = xk_; pv = xv;
          lw[i] = -0.8750440158f * __builtin_amdgcn_rcpf(1.f + __builtin_amdgcn_exp2f(-1.4426950408889634f * (w0 + Fw[t * 64 + c])));
          const float a = __builtin_amdgcn_rcpf(1.f + __builtin_amdgcn_exp2f(-1.4426950408889634f * (a0 + Fa[t * 64 + c])));
          float kk = k * kkc; const float ss = wave_sum(kk * kk); kk = kk * __builtin_amdgcn_rsqf(fmaxf(ss, 1e-24f));
          const float kx = k * (1.f + (a - 1.f) * kac);
          const float bon = wave_sum(r * kx * rkc);
          rr[i] = r; k2[i] = kx; vv[i] = v; ap[i] = -kk; bp[i] = kk * a;
          o.GATE[(t0 + t) * 256 + hc] = Fg[t * TS + c];
          if (c == 0) o.BON[(t0 + t) * 4 + h] = bon; }
      float cl[8]; float run = 0.f;
#pragma unroll
      for (int i = 0; i < 8; ++i) { run += lw[i]; cl[i] = run; }
      part[tg * 64 + c] = run;
      RW_SYNC();
      float off = 0.f, tot = 0.f;
#pragma unroll
      for (int g = 0; g < 8; ++g) { const float pgv = part[g * 64 + c]; if (g < tg) off += pgv; tot += pgv; }
      const float gtot = __builtin_amdgcn_exp2f(tot);
      if (tg == 0) gamL[c] = gtot;
      typedef unsigned u32x4v __attribute__((ext_vector_type(4)));
      float at[8], vt[8], bb[8], kb[8];
      float gp = __builtin_amdgcn_exp2f(off);
#pragma unroll
      for (int i = 0; i < 8; ++i) { const int t = tg * 8 + i;
          const float g = __builtin_amdgcn_exp2f(off + cl[i]), ig = __builtin_amdgcn_rcpf(g), gl = gtot * ig;
          at[i] = ap[i] * gp; vt[i] = vv[i]; bb[i] = bp[i] * gl; kb[i] = k2[i] * gl; gp = g;
          const unsigned w01 = pk(bp[i] * ig, k2[i] * ig), w23 = pk(at[i], rr[i] * g);
          S0[t * TS + c] = (unsigned short)w01; S1[t * TS + c] = (unsigned short)(w01 >> 16); S2[t * TS + c] = (unsigned short)w23; S3[t * TS + c] = (unsigned short)(w23 >> 16); }
      u32x4v x;
      x.x = pk(at[0], at[1]); x.y = pk(at[2], at[3]); x.z = pk(at[4], at[5]); x.w = pk(at[6], at[7]); *(__attribute__((address_space(3))) u32x4v*)(S4 + c * TS + tg * 8) = x;
      x.x = pk(vt[0], vt[1]); x.y = pk(vt[2], vt[3]); x.z = pk(vt[4], vt[5]); x.w = pk(vt[6], vt[7]); *(__attribute__((address_space(3))) u32x4v*)(S5 + c * TS + tg * 8) = x;
      x.x = pk(bb[0], bb[1]); x.y = pk(bb[2], bb[3]); x.z = pk(bb[4], bb[5]); x.w = pk(bb[6], bb[7]); *(__attribute__((address_space(3))) u32x4v*)(S6 + c * TS + tg * 8) = x;
      x.x = pk(kb[0], kb[1]); x.y = pk(kb[2], kb[3]); x.z = pk(kb[4], kb[5]); x.w = pk(kb[6], kb[7]); *(__attribute__((address_space(3))) u32x4v*)(S7 + c * TS + tg * 8) = x; }
    RW_SYNC();
    const int mt = wv >> 1, r16 = lane & 15, q4 = lane >> 4;
    const f32x4 Z = {0.f, 0.f, 0.f, 0.f};
    f32x4 mab[2], mkb[2], mbr[2], mkr[2];
#pragma unroll
    for (int tt = 0; tt < 2; ++tt) { const int nt = (wv & 1) * 2 + tt;
        mab[tt] = mma64(S0, S2, mt, nt, lane, Z); mkb[tt] = mma64(S1, S2, mt, nt, lane, Z); mbr[tt] = mma64(S0, S3, mt, nt, lane, Z); mkr[tt] = mma64(S1, S3, mt, nt, lane, Z);
#pragma unroll
        for (int e = 0; e < 4; ++e) { const int s = mt * 16 + q4 * 4 + e, t = nt * 16 + r16; if (!(s < t)) { mab[tt][e] = 0.f; mkb[tt][e] = 0.f; } if (!(s <= t)) { mbr[tt][e] = 0.f; mkr[tt][e] = 0.f; } } }
    ml::m1_product(lds, unit, lane, wv, mo);
    lds_bf* SA = (lds_bf*)(lds + MISC_OFF + 4608);
#pragma unroll
    for (int tt = 0; tt < 2; ++tt) { const int nt = (wv & 1) * 2 + tt;
        st_mn(S11, mt, nt, lane, mab[tt]); st_nm(S12, mt, nt, lane, mab[tt]);
        f32x4 ti = mab[tt];
#pragma unroll
        for (int e = 0; e < 4; ++e) if (mt * 16 + q4 * 4 + e == nt * 16 + r16) ti[e] += 1.f;
        st_nm(SA, mt, nt, lane, ti); st_nm(S8, mt, nt, lane, mkb[tt]); st_nm(S9, mt, nt, lane, mbr[tt]); st_nm(S10, mt, nt, lane, mkr[tt]); }
    RW_SYNC();
    { f32x4 pp[2], tn[2];
#define R1_E_STEP(PA, PB, TI, QA, QB, TO, SQUARE) do { \
      _Pragma("unroll") for (int tt = 0; tt < 2; ++tt) { const int nt = (wv & 1) * 2 + tt; tn[tt] = mma64(PA, TI, mt, nt, lane, ld_nm(TI, mt, nt, lane)); if (SQUARE) pp[tt] = mma64(PA, PB, mt, nt, lane, Z); } \
      _Pragma("unroll") for (int tt = 0; tt < 2; ++tt) { const int nt = (wv & 1) * 2 + tt; st_nm(TO, mt, nt, lane, tn[tt]); if (SQUARE) { st_mn(QA, mt, nt, lane, pp[tt]); st_nm(QB, mt, nt, lane, pp[tt]); } } \
      RW_SYNC(); } while (0)
#pragma unroll
      for (int tt = 0; tt < 2; ++tt) pp[tt] = mma64(S11, S12, mt, (wv & 1) * 2 + tt, lane, Z);
#pragma unroll
      for (int tt = 0; tt < 2; ++tt) { st_mn(S0, mt, (wv & 1) * 2 + tt, lane, pp[tt]); st_nm(S1, mt, (wv & 1) * 2 + tt, lane, pp[tt]); }
      RW_SYNC();
      R1_E_STEP(S0, S1, SA, S11, S12, S2, true);
      R1_E_STEP(S11, S12, S2, S0, S1, SA, true);
      R1_E_STEP(S0, S1, SA, S11, S12, S2, true);
      R1_E_STEP(S11, S12, S2, S0, S1, SA, true);
      R1_E_STEP(S0, S1, SA, S11, S12, S2, false);
#undef R1_E_STEP
    }
#pragma unroll
    for (int tt = 0; tt < 2; ++tt) { const int nt = (wv & 1) * 2 + tt; st_nm(S11, mt, nt, lane, mma64(S2, S4, mt, nt, lane, Z)); st_nm(S0, mt, nt, lane, mma64(S8, S5, mt, nt, lane, Z)); }
    RW_SYNC();
    { bf16* gG = o.G + (size_t)unit * 4096; bf16* gRH = o.RH + (size_t)unit * 4096;
      typedef unsigned u32x2 __attribute__((ext_vector_type(2)));
#pragma unroll
      for (int tt = 0; tt < 2; ++tt) { const int nt = (wv & 1) * 2 + tt;
          st_nm(S12, mt, nt, lane, mma64(S2, S0, mt, nt, lane, Z));
          f32x4 rh = mma64(S11, S9, mt, nt, lane, ld_nm(S3, mt, nt, lane));
          { u32x2 wv2; wv2.x = pk(rh[0], rh[1]); wv2.y = pk(rh[2], rh[3]); *(u32x2*)(gRH + (nt * 16 + r16) * 64 + mt * 16 + q4 * 4) = wv2; }
          f32x4 g = mma64(S11, S6, mt, nt, lane, Z);
#pragma unroll
          for (int e = 0; e < 4; ++e) if (mt * 16 + q4 * 4 + e == nt * 16 + r16) g[e] += gamL[nt * 16 + r16];
          { u32x2 wv2; wv2.x = pk(g[0], g[1]); wv2.y = pk(g[2], g[3]); *(u32x2*)(gG + ((nt * 2 + (mt >> 1)) * 64 + lane) * 8 + (mt & 1) * 4) = wv2; } } }
    RW_SYNC();
    { bf16* gH = o.H + (size_t)unit * 4096; bf16* gYL = o.YL + (size_t)unit * 4096;
      typedef unsigned u32x2 __attribute__((ext_vector_type(2)));
#pragma unroll
      for (int tt = 0; tt < 2; ++tt) { const int nt = (wv & 1) * 2 + tt;
          f32x4 y = mma64(S12, S9, mt, nt, lane, Z); y = mma64(S5, S10, mt, nt, lane, y);
          { u32x2 wv2; wv2.x = pk(y[0], y[1]); wv2.y = pk(y[2], y[3]); *(u32x2*)(gYL + ((mt * 4 + nt) * 64 + lane) * 4) = wv2; }
          f32x4 hh = mma64(S6, S12, mt, nt, lane, Z); hh = mma64(S7, S5, mt, nt, lane, hh);
          { u32x2 wv2; wv2.x = pk(hh[0], hh[1]); wv2.y = pk(hh[2], hh[3]); *(u32x2*)(gH + ((mt * 4 + nt) * 64 + lane) * 4) = wv2; } } }
    RW_SYNC();
}

struct ScanStage { bf16x8 g[4][2]; unsigned hx[4], hy[4]; };
__device__ __forceinline__ void scan_load(ScanStage& st, const bf16* gG, const bf16* gH, int c, int nt, int lane) {
    typedef unsigned u32x2 __attribute__((ext_vector_type(2)));
    const bf16* gn = gG + (size_t)c * 4096; const bf16* hn = gH + (size_t)c * 4096;
#pragma unroll
    for (int m = 0; m < 4; ++m) { st.g[m][0] = *(const bf16x8*)(gn + ((m * 2 + 0) * 64 + lane) * 8); st.g[m][1] = *(const bf16x8*)(gn + ((m * 2 + 1) * 64 + lane) * 8);
        const u32x2 h = *(const u32x2*)(hn + ((m * 4 + nt) * 64 + lane) * 4); st.hx[m] = h.x; st.hy[m] = h.y; }
}
__device__ __forceinline__ void scan_step(const ScanStage& st, f32x4 (&acc)[4], bf16* gH, int c, int nt, int lane) {
    typedef unsigned u32x2 __attribute__((ext_vector_type(2))); typedef unsigned u32x4v __attribute__((ext_vector_type(4)));
    f32x4 hin[4];
#pragma unroll
    for (int m = 0; m < 4; ++m) hin[m] = (f32x4){__uint_as_float(st.hx[m] << 16), __uint_as_float(st.hx[m] & 0xffff0000u), __uint_as_float(st.hy[m] << 16), __uint_as_float(st.hy[m] & 0xffff0000u)};
    u32x4v b0, b1;
    b0.x = pk(acc[0][0], acc[0][1]); b0.y = pk(acc[0][2], acc[0][3]); b0.z = pk(acc[1][0], acc[1][1]); b0.w = pk(acc[1][2], acc[1][3]);
    b1.x = pk(acc[2][0], acc[2][1]); b1.y = pk(acc[2][2], acc[2][3]); b1.z = pk(acc[3][0], acc[3][1]); b1.w = pk(acc[3][2], acc[3][3]);
    bf16* hc = gH + (size_t)c * 4096;
    *(u32x2*)(hc + ((0 * 4 + nt) * 64 + lane) * 4) = (u32x2){b0.x, b0.y}; *(u32x2*)(hc + ((1 * 4 + nt) * 64 + lane) * 4) = (u32x2){b0.z, b0.w};
    *(u32x2*)(hc + ((2 * 4 + nt) * 64 + lane) * 4) = (u32x2){b1.x, b1.y}; *(u32x2*)(hc + ((3 * 4 + nt) * 64 + lane) * 4) = (u32x2){b1.z, b1.w};
    const bf16x8 bf0 = __builtin_bit_cast(bf16x8, b0), bf1 = __builtin_bit_cast(bf16x8, b1);
#pragma unroll
    for (int m = 0; m < 4; ++m) { f32x4 a = hin[m]; a = __builtin_amdgcn_mfma_f32_16x16x32_bf16(st.g[m][0], bf0, a, 0, 0, 0); a = __builtin_amdgcn_mfma_f32_16x16x32_bf16(st.g[m][1], bf1, a, 0, 0, 0); acc[m] = a; }
}
__device__ __forceinline__ void scan_bh(int bh, int nt, int lane, const Buf& o) {
    f32x4 acc[4];
#pragma unroll
    for (int m = 0; m < 4; ++m) acc[m] = (f32x4){0.f, 0.f, 0.f, 0.f};
    const bf16* gG = o.G + (size_t)bh * 64 * 4096; bf16* gH = o.H + (size_t)bh * 64 * 4096;
    ScanStage s0, s1, s2, s3;
    scan_load(s0, gG, gH, 0, nt, lane); scan_load(s1, gG, gH, 1, nt, lane); scan_load(s2, gG, gH, 2, nt, lane); scan_load(s3, gG, gH, 3, nt, lane);
#pragma unroll 1
    for (int c = 0; c < 64; c += 4) {
        scan_step(s0, acc, gH, c, nt, lane);     if (c + 4 < 64) scan_load(s0, gG, gH, c + 4, nt, lane);
        scan_step(s1, acc, gH, c + 1, nt, lane); if (c + 5 < 64) scan_load(s1, gG, gH, c + 5, nt, lane);
        scan_step(s2, acc, gH, c + 2, nt, lane); if (c + 6 < 64) scan_load(s2, gG, gH, c + 6, nt, lane);
        scan_step(s3, acc, gH, c + 3, nt, lane); if (c + 7 < 64) scan_load(s3, gG, gH, c + 7, nt, lane);
    }
}

typedef unsigned u32x2r __attribute__((ext_vector_type(2)));
struct R3Raw { u32x2r rh[4], s[16], yl[4], pv[4], pp[4], gt[4]; float bon; f32x4 lg[4], lb[4], mu[4]; };
__device__ __forceinline__ void r3_load(R3Raw& R, int unit, int nt, int lane, const bf16* __restrict__ proj, const W& w, const Buf& o) {
    const int ch = unit & 63, bh = unit >> 6, h = bh & 3, b = bh >> 2, r16 = lane & 15, q4 = lane >> 4;
    const size_t t0 = (size_t)b * SEQ + ch * 64; const int tl = nt * 16 + r16; const size_t t = t0 + tl;
    const bf16* gS = o.H + (size_t)unit * 4096; const bf16* gRH = o.RH + (size_t)unit * 4096; const bf16* gYL = o.YL + (size_t)unit * 4096;
#pragma unroll
    for (int i = 0; i < 4; ++i) R.rh[i] = *(const u32x2r*)(gRH + tl * 64 + q4 * 4 + 16 * i);
#pragma unroll
    for (int m = 0; m < 4; ++m) {
#pragma unroll
        for (int i = 0; i < 4; ++i) R.s[m * 4 + i] = *(const u32x2r*)(gS + ((i * 4 + m) * 64 + lane) * 4);
        R.yl[m] = *(const u32x2r*)(gYL + ((m * 4 + nt) * 64 + lane) * 4); }
    R.bon = o.BON[t * 4 + h];
#pragma unroll
    for (int m = 0; m < 4; ++m) { const int hc = h * 64 + m * 16 + q4 * 4;
        R.pv[m] = *(const u32x2r*)(proj + t * NP + R0 + 512 + hc); R.pp[m] = *(const u32x2r*)(proj + ((long)t - 1) * NP + R0 + 512 + hc);
        R.gt[m] = *(const u32x2r*)(o.GATE + t * 256 + hc);
        R.lg[m] = *(const f32x4*)(w.ln_g + hc); R.lb[m] = *(const f32x4*)(w.ln_b + hc); R.mu[m] = *(const f32x4*)(w.mu + 512 + hc); }
}
__device__ __forceinline__ void r3_compute(const R3Raw& R, int unit, int nt, int lane, bf16* __restrict__ mix, int pitch, int coloff) {
    const int ch = unit & 63, bh = unit >> 6, h = bh & 3, b = bh >> 2, r16 = lane & 15, q4 = lane >> 4;
    const size_t t0 = (size_t)b * SEQ + ch * 64; const int tl = nt * 16 + r16; const size_t t = t0 + tl;
    typedef unsigned u32x4v __attribute__((ext_vector_type(4)));
    const bf16x8 bq0 = __builtin_bit_cast(bf16x8, ((u32x4v){R.rh[0].x, R.rh[0].y, R.rh[1].x, R.rh[1].y})), bq1 = __builtin_bit_cast(bf16x8, ((u32x4v){R.rh[2].x, R.rh[2].y, R.rh[3].x, R.rh[3].y}));
    f32x4 y[4];
#pragma unroll
    for (int m = 0; m < 4; ++m) {
        const u32x2r s0 = R.s[m * 4 + 0], s1 = R.s[m * 4 + 1], s2 = R.s[m * 4 + 2], s3 = R.s[m * 4 + 3];
        const bf16x8 a0 = __builtin_bit_cast(bf16x8, ((u32x4v){s0.x, s0.y, s1.x, s1.y})), a1 = __builtin_bit_cast(bf16x8, ((u32x4v){s2.x, s2.y, s3.x, s3.y}));
        const u32x2r yl = R.yl[m];
        f32x4 a = {__uint_as_float(yl.x << 16), __uint_as_float(yl.x & 0xffff0000u), __uint_as_float(yl.y << 16), __uint_as_float(yl.y & 0xffff0000u)};
        a = __builtin_amdgcn_mfma_f32_16x16x32_bf16(a0, bq0, a, 0, 0, 0); a = __builtin_amdgcn_mfma_f32_16x16x32_bf16(a1, bq1, a, 0, 0, 0); y[m] = a; }
    float s = 0.f;
#pragma unroll
    for (int m = 0; m < 4; ++m) s += (y[m][0] + y[m][1]) + (y[m][2] + y[m][3]);
    s = sum_q4(s);
    const float mean = s * (1.f / 64.f); float v2 = 0.f;
#pragma unroll
    for (int m = 0; m < 4; ++m)
#pragma unroll
        for (int e = 0; e < 4; ++e) { const float d = y[m][e] - mean; v2 += d * d; }
    v2 = sum_q4(v2);
    const float rstd = rsqrtf(v2 * (1.f / 64.f) + 64e-5f);
    const float bon = R.bon;
    const bool first = (ch == 0 && tl == 0);
#pragma unroll
    for (int m = 0; m < 4; ++m) { const int i0 = m * 16 + q4 * 4, hc = h * 64 + i0;
        const u32x2r pv = R.pv[m]; u32x2r pp = R.pp[m]; if (first) { pp.x = 0u; pp.y = 0u; }
        const u32x2r gt = R.gt[m];
        const f32x4 lg = R.lg[m], lb = R.lb[m], mu = R.mu[m];
        const float xv[4] = {__uint_as_float(pv.x << 16), __uint_as_float(pv.x & 0xffff0000u), __uint_as_float(pv.y << 16), __uint_as_float(pv.y & 0xffff0000u)};
        const float xp[4] = {__uint_as_float(pp.x << 16), __uint_as_float(pp.x & 0xffff0000u), __uint_as_float(pp.y << 16), __uint_as_float(pp.y & 0xffff0000u)};
        const float gg[4] = {__uint_as_float(gt.x << 16), __uint_as_float(gt.x & 0xffff0000u), __uint_as_float(gt.y << 16), __uint_as_float(gt.y & 0xffff0000u)};
        float ov[4];
#pragma unroll
        for (int e = 0; e < 4; ++e) { const float v = xv[e] + (xp[e] - xv[e]) * mu[e]; ov[e] = ((y[m][e] - mean) * rstd * lg[e] + lb[e] + bon * v) * gg[e]; }
        u32x2r wv2; wv2.x = pk(ov[0], ov[1]); wv2.y = pk(ov[2], ov[3]); *(u32x2r*)(mix + t * pitch + coloff + hc) = wv2; }
}
struct R3Ctx { const bf16* proj; const W* w; const Buf* o; bf16* mix;
    __device__ __forceinline__ void load(R3Raw& R, int unit, int nt, int lane) const { r3_load(R, unit, nt, lane, proj, *w, *o); }
    __device__ __forceinline__ void run(const R3Raw& R, int unit, int nt, int lane) const { r3_compute(R, unit, nt, lane, mix, DM, 256); } };
#undef RW_SYNC
}
namespace ml {
using rw::lds_u8; using rw::lds_bf; using rw::lds_f32; using rw::TS; using rw::TILE_B; using rw::slot; using rw::pk; using rw::mma64; using rw::st_nm;
__device__ __forceinline__ float wave_incl_sum(float v, int) { return wave_scan_sum(v); }
__device__ __forceinline__ float wave_incl_max(float v, int) { return wave_scan_max(v); }
__device__ __forceinline__ void conv8(const bf16* __restrict__ proj, size_t trow, int s0, int col, const float* __restrict__ cw, const float* __restrict__ cb, float scale, float* out) {
    const float w0 = cw[col], w1 = cw[512 + col], w2 = cw[1024 + col], w3 = cw[1536 + col], bb = cb[col];
    const bf16* p = proj + trow * NP + MB0 + col;
    float x0 = s0 >= 3 ? bf2f(p[-3 * (long)NP]) : 0.f, x1 = s0 >= 2 ? bf2f(p[-2 * (long)NP]) : 0.f, x2 = s0 >= 1 ? bf2f(p[-(long)NP]) : 0.f;
#pragma unroll
    for (int i = 0; i < 8; ++i) { const float x3 = bf2f(p[(size_t)i * NP]); const float y = bb + w0 * x0 + w1 * x1 + w2 * x2 + w3 * x3; out[i] = y * sigmoidf_(y) * scale; x0 = x1; x1 = x2; x2 = x3; }
}
__device__ __forceinline__ void m1_gates(lds_u8* lds, int unit, int lane, float igv, float fgv, const Buf& o) {
    lds_f32* wkp = (lds_f32*)(lds + rw::MISC_OFF + 2304);
    const float ig = igv, lf = -softplus_fast(-fgv);
    const float bt = wave_incl_sum(lf, lane), bL = __int_as_float(__builtin_amdgcn_readlane(__float_as_int(bt), 63));
    const float ge = bL - bt + ig, gmax = wave_max(ge);
    wkp[lane] = __expf(ge - gmax);
    if (lane == 0) { o.SC[(size_t)unit * 4 + 0] = bL; o.SC[(size_t)unit * 4 + 1] = gmax; }
}
__device__ __forceinline__ void m1_tiles(lds_u8* lds, int lane, int wv, const float (&xk)[11], const float (&cwv)[5], const float (&vv)[8], int s0) {
    lds_bf* Kw = slot(lds, 13); lds_bf* Vt = slot(lds, 14); lds_f32* wkp = (lds_f32*)(lds + rw::MISC_OFF + 2304); lds_f32* part = wkp + 64;
    const int c = lane, tg = wv; float kc[8];
    { float x0 = s0 >= 3 ? xk[0] : 0.f, x1 = s0 >= 2 ? xk[1] : 0.f, x2 = s0 >= 1 ? xk[2] : 0.f;
#pragma unroll
      for (int i = 0; i < 8; ++i) { const float x3 = xk[3 + i]; const float y = cwv[4] + cwv[0] * x0 + cwv[1] * x1 + cwv[2] * x2 + cwv[3] * x3; kc[i] = y * sigmoidf_(y) * 0.125f; x0 = x1; x1 = x2; x2 = x3; } }
    typedef unsigned u32x4v __attribute__((ext_vector_type(4)));
    float kw[8], dn = 0.f;
#pragma unroll
    for (int i = 0; i < 8; ++i) { const float wk = wkp[tg * 8 + i]; kw[i] = kc[i] * wk; dn += kw[i]; }
    u32x4v x; x.x = pk(kw[0], kw[1]); x.y = pk(kw[2], kw[3]); x.z = pk(kw[4], kw[5]); x.w = pk(kw[6], kw[7]); *(__attribute__((address_space(3))) u32x4v*)(Kw + c * TS + tg * 8) = x;
    x.x = pk(vv[0], vv[1]); x.y = pk(vv[2], vv[3]); x.z = pk(vv[4], vv[5]); x.w = pk(vv[6], vv[7]); *(__attribute__((address_space(3))) u32x4v*)(Vt + c * TS + tg * 8) = x;
    part[tg * 64 + c] = dn;
}
__device__ __forceinline__ void m1_product(lds_u8* lds, int unit, int lane, int wv, const Buf& o) {
    lds_bf* Kw = slot(lds, 13); lds_bf* Vt = slot(lds, 14); lds_f32* part = (lds_f32*)(lds + rw::MISC_OFF + 2304) + 64;
    const f32x4 Z = {0.f, 0.f, 0.f, 0.f}; const int mt = wv >> 1; bf16* gC = o.C + (size_t)unit * 4096;
    typedef unsigned u32x2 __attribute__((ext_vector_type(2)));
#pragma unroll
    for (int tt = 0; tt < 2; ++tt) { const int nt = (wv & 1) * 2 + tt; const f32x4 a = mma64(Kw, Vt, mt, nt, lane, Z);
        u32x2 w2; w2.x = pk(a[0], a[1]); w2.y = pk(a[2], a[3]); *(u32x2*)(gC + (nt * 16 + (lane & 15)) * 64 + mt * 16 + (lane >> 4) * 4) = w2; }
    if (wv == 0) { float s = 0.f;
#pragma unroll
        for (int g = 0; g < 8; ++g) s += part[g * 64 + lane];
        o.N[(size_t)unit * 64 + lane] = s; }
}
struct ScanStage { unsigned d[8]; float dn, bL, gmax; };
__device__ __forceinline__ void scan_load(ScanStage& st, const bf16* gc, const Buf& o, size_t u, int c, int lane) {
    typedef unsigned u32x4v __attribute__((ext_vector_type(4)));
    const bf16* cn = gc + (size_t)c * 4096; const u32x4v d0 = *(const u32x4v*)cn, d1 = *(const u32x4v*)(cn + 8);
    st.d[0] = d0.x; st.d[1] = d0.y; st.d[2] = d0.z; st.d[3] = d0.w; st.d[4] = d1.x; st.d[5] = d1.y; st.d[6] = d1.z; st.d[7] = d1.w;
    st.dn = o.N[(u + c) * 64 + lane]; st.bL = o.SC[(u + c) * 4]; st.gmax = o.SC[(u + c) * 4 + 1];
}
__device__ __forceinline__ void scan_step(const ScanStage& st, float (&C)[16], float& n, float& m, bf16* gc, const Buf& o, size_t u, int c, int w, int lane) {
    typedef unsigned u32x4v __attribute__((ext_vector_type(4)));
    float dC[16];
#pragma unroll
    for (int i = 0; i < 8; ++i) { dC[2 * i] = __uint_as_float(st.d[i] << 16); dC[2 * i + 1] = __uint_as_float(st.d[i] & 0xffff0000u); }
    const float dnc = st.dn, bLc = st.bL, gmc = st.gmax;
    bf16* cc = gc + (size_t)c * 4096;
    u32x4v s0, s1; s0.x = pk(C[0], C[1]); s0.y = pk(C[2], C[3]); s0.z = pk(C[4], C[5]); s0.w = pk(C[6], C[7]); s1.x = pk(C[8], C[9]); s1.y = pk(C[10], C[11]); s1.z = pk(C[12], C[13]); s1.w = pk(C[14], C[15]);
    const float mn = fmaxf(bLc + m, gmc), cs = __expf(bLc + m - mn), ee = __expf(gmc - mn);
    float keep = dC[0] + dnc; asm volatile("" : "+v"(keep));
    *(u32x4v*)cc = s0; *(u32x4v*)(cc + 8) = s1;
    if (w == 0) { o.N[(u + c) * 64 + lane] = n; if (lane == 0) o.SC[(u + c) * 4 + 2] = m; }
    m = mn;
#pragma unroll
    for (int i = 0; i < 16; ++i) C[i] = cs * C[i] + ee * dC[i];
    n = cs * n + ee * dnc;
}
__device__ __forceinline__ void scan_bh(int bh, int w, int lane, const Buf& o) {
    float C[16]; float n = 0.f, m = 0.f;
#pragma unroll
    for (int i = 0; i < 16; ++i) C[i] = 0.f;
    const size_t u0 = (size_t)bh * 64;
    bf16* gc = o.C + u0 * 4096 + (w * 16 + (lane >> 2)) * 64 + (lane & 3) * 16;
    ScanStage s0, s1, s2, s3;
    scan_load(s0, gc, o, u0, 0, lane); scan_load(s1, gc, o, u0, 1, lane); scan_load(s2, gc, o, u0, 2, lane); scan_load(s3, gc, o, u0, 3, lane);
#pragma unroll 1
    for (int c = 0; c < 64; c += 4) {
        scan_step(s0, C, n, m, gc, o, u0, c, w, lane);     if (c + 4 < 64) scan_load(s0, gc, o, u0, c + 4, lane);
        scan_step(s1, C, n, m, gc, o, u0, c + 1, w, lane); if (c + 5 < 64) scan_load(s1, gc, o, u0, c + 5, lane);
        scan_step(s2, C, n, m, gc, o, u0, c + 2, w, lane); if (c + 6 < 64) scan_load(s2, gc, o, u0, c + 6, lane);
        scan_step(s3, C, n, m, gc, o, u0, c + 3, w, lane); if (c + 7 < 64) scan_load(s3, gc, o, u0, c + 7, lane);
    }
}
template <class R3F> __device__ __forceinline__ void m3_unit(lds_u8* lds, int unit, const bf16* __restrict__ proj, const P& p, const Buf& o, bf16* __restrict__ mix, const R3F& r3) {
    int tid_ = threadIdx.x; asm volatile("" : "+v"(tid_));
    const int tid = tid_, lane = tid & 63, wv = __builtin_amdgcn_readfirstlane(tid >> 6), r16 = lane & 15, q4 = lane >> 4;
    const int ch = unit & 63, bh = unit >> 6, h = bh & 3, b = bh >> 2;
    const size_t t0 = (size_t)b * SEQ + ch * 64;
    lds_bf* Qt = slot(lds, 0); lds_bf* Kt = slot(lds, 1); lds_bf* Vt = slot(lds, 2); lds_bf* Cp = slot(lds, 3); lds_bf* Pt = slot(lds, 4);
    lds_f32* abt = (lds_f32*)(lds + 5 * TILE_B); lds_f32* aat = abt + 64; lds_f32* amt = aat + 64; lds_f32* aiw = amt + 64; lds_f32* aem = aiw + 64; lds_f32* anp = aem + 64;
    typedef unsigned u32x4v __attribute__((ext_vector_type(4))); typedef unsigned u32x2 __attribute__((ext_vector_type(2)));
    const int hcl = h * 64 + lane;
    bf16 rq[11], rk[11], rv[8]; float cq[5], ck[5];
    { const bf16* pq = proj + (t0 + wv * 8) * NP + MQ + hcl; const bf16* pk_ = proj + (t0 + wv * 8) * NP + MK + hcl; const bf16* pv = proj + (t0 + wv * 8) * NP + MV + hcl;
#pragma unroll
      for (int i = 0; i < 11; ++i) { rq[i] = pq[((long)i - 3) * NP]; rk[i] = pk_[((long)i - 3) * NP]; }
#pragma unroll
      for (int i = 0; i < 8; ++i) rv[i] = pv[(size_t)i * NP];
#pragma unroll
      for (int i = 0; i < 4; ++i) { cq[i] = p.cw[i * 512 + hcl]; ck[i] = p.cw[i * 512 + 256 + hcl]; }
      cq[4] = p.cb[hcl]; ck[4] = p.cb[256 + hcl]; }
    const int ce = tid >> 3, cd8 = (tid & 7) * 8;
    const u32x4v cprev = *(const u32x4v*)(o.C + (size_t)unit * 4096 + ce * 64 + cd8);
    float igv = 0.f, fgv = 0.f, mprev = 0.f, npv = 0.f;
    if (wv == 0) { const bf16* pr = proj + (t0 + lane) * NP; const bf16 gi = pr[MI + h], gf = pr[MF + h]; const float bi = p.b_i[h], bf_ = p.b_f[h];
        mprev = o.SC[(size_t)unit * 4 + 2]; npv = o.N[(size_t)unit * 64 + lane]; igv = bf2f(gi) + bi; fgv = bf2f(gf) + bf_; }
    u32x2 ovr[4]; f32x4 ng[4]; rw::R3Raw R3;
    if (wv == 0) {
        const float ig = igv, lf = -softplus_fast(-fgv);
        const float bt = wave_incl_sum(lf, lane), at = ig - bt, cm = wave_incl_max(at, lane);
        const float mt = fmaxf(bt + mprev, bt + cm);
        abt[lane] = bt; aat[lane] = at; amt[lane] = mt; aiw[lane] = __expf(bt + mprev - mt); aem[lane] = __expf(-mt); anp[lane] = npv;
    }
    { const int c = lane, tg = wv; float qc[8], kc[8]; const int s0 = ch * 64 + tg * 8;
      { float x0 = s0 >= 3 ? bf2f(rq[0]) : 0.f, x1 = s0 >= 2 ? bf2f(rq[1]) : 0.f, x2 = s0 >= 1 ? bf2f(rq[2]) : 0.f;
#pragma unroll
        for (int i = 0; i < 8; ++i) { const float x3 = bf2f(rq[3 + i]); const float y = cq[4] + cq[0] * x0 + cq[1] * x1 + cq[2] * x2 + cq[3] * x3; qc[i] = y * sigmoidf_(y); x0 = x1; x1 = x2; x2 = x3; } }
      { float x0 = s0 >= 3 ? bf2f(rk[0]) : 0.f, x1 = s0 >= 2 ? bf2f(rk[1]) : 0.f, x2 = s0 >= 1 ? bf2f(rk[2]) : 0.f;
#pragma unroll
        for (int i = 0; i < 8; ++i) { const float x3 = bf2f(rk[3 + i]); const float y = ck[4] + ck[0] * x0 + ck[1] * x1 + ck[2] * x2 + ck[3] * x3; kc[i] = y * sigmoidf_(y) * 0.125f; x0 = x1; x1 = x2; x2 = x3; } }
      float vv[8];
#pragma unroll
      for (int i = 0; i < 8; ++i) { const int t = tg * 8 + i; { const unsigned wqk = pk(qc[i], kc[i]); Qt[t * TS + c] = (unsigned short)wqk; Kt[t * TS + c] = (unsigned short)(wqk >> 16); } vv[i] = bf2f(rv[i]); }
      u32x4v x; x.x = pk(vv[0], vv[1]); x.y = pk(vv[2], vv[3]); x.z = pk(vv[4], vv[5]); x.w = pk(vv[6], vv[7]); *(__attribute__((address_space(3))) u32x4v*)(Vt + c * TS + tg * 8) = x;
      *(__attribute__((address_space(3))) u32x4v*)(Cp + ce * TS + cd8) = cprev; }
    if (wv < 4) { const size_t tr = t0 + wv * 16 + r16;
#pragma unroll
        for (int m = 0; m < 4; ++m) { const int hc = h * 64 + m * 16 + q4 * 4; ovr[m] = *(const u32x2*)(proj + tr * NP + MO + hc); ng[m] = *(const f32x4*)(p.norm_g + hc); } }
    else r3.load(R3, unit, wv - 4, lane);
    asm volatile("s_waitcnt lgkmcnt(0)\n\ts_barrier" ::: "memory");
    { const f32x4 Z = {0.f, 0.f, 0.f, 0.f}; const int mt = wv >> 1;
#pragma unroll
      for (int tt = 0; tt < 2; ++tt) { const int nt = (wv & 1) * 2 + tt; f32x4 sT = mma64(Kt, Qt, mt, nt, lane, Z);
          const int t = nt * 16 + r16; const float bm = abt[t] - amt[t];
#pragma unroll
          for (int e = 0; e < 4; ++e) { const int s = mt * 16 + q4 * 4 + e; sT[e] = (s <= t) ? sT[e] * __expf(bm + aat[s]) : 0.f; }
          st_nm(Pt, mt, nt, lane, sT); } }
    asm volatile("s_waitcnt lgkmcnt(0)\n\ts_barrier" ::: "memory");
    if (wv < 4) { const int nt = wv, t = nt * 16 + r16; const f32x4 Z = {0.f, 0.f, 0.f, 0.f};
        const float iw = aiw[t];
        f32x4 num[4];
#pragma unroll
        for (int m = 0; m < 4; ++m) { f32x4 a = mma64(Cp, Qt, m, nt, lane, Z); a = a * iw; num[m] = mma64(Vt, Pt, m, nt, lane, a); }
        float qn = 0.f, ps = 0.f;
#pragma unroll
        for (int i = 0; i < 16; ++i) { const int d = q4 * 16 + i; qn += anp[d] * bf2f(Qt[t * TS + d]); ps += bf2f(Pt[t * TS + d]); }
        qn = sum_q4(qn); ps = sum_q4(ps);
        const float den = iw * qn + ps, rden = 1.f / fmaxf(fabsf(den), aem[t]);
        float ss = 0.f;
#pragma unroll
        for (int m = 0; m < 4; ++m) { num[m] = num[m] * rden; ss += (num[m][0] * num[m][0] + num[m][1] * num[m][1]) + (num[m][2] * num[m][2] + num[m][3] * num[m][3]); }
        ss = sum_q4(ss);
        const float rstd = rsqrtf(ss * (1.f / 64.f) + 1e-6f);
        const size_t tr = t0 + t;
#pragma unroll
        for (int m = 0; m < 4; ++m) { const int hc = h * 64 + m * 16 + q4 * 4;
            const u32x2 ov = ovr[m]; const f32x4 g = ng[m];
            const float o0 = sigmoidf_(__uint_as_float(ov.x << 16)), o1 = sigmoidf_(__uint_as_float(ov.x & 0xffff0000u)), o2 = sigmoidf_(__uint_as_float(ov.y << 16)), o3 = sigmoidf_(__uint_as_float(ov.y & 0xffff0000u));
            u32x2 w2; w2.x = pk(num[m][0] * rstd * g[0] * o0, num[m][1] * rstd * g[1] * o1); w2.y = pk(num[m][2] * rstd * g[2] * o2, num[m][3] * rstd * g[3] * o3);
            *(u32x2*)(mix + tr * DM + hc) = w2; } }
    else r3.run(R3, unit, wv - 4, lane);
    asm volatile("s_waitcnt lgkmcnt(0)\n\ts_barrier" ::: "memory");
}
}
namespace cg = cooperative_groups;
#define LAS __attribute__((address_space(3)))
#define GASQ __attribute__((address_space(1)))
struct Params { const GASQ float* in[29]; GASQ float* out; GASQ unsigned char* ws; };
struct Ctx { int tid, lane, wave, gw, ngw; unsigned char* lds; };

template <bool GAIN, bool PERM> __device__ __forceinline__ void wt_load(float (&v)[16], int tl, int tn, int t, const float* __restrict__ W, int N, const float* __restrict__ gain, int slo, int shi, float sc) {
    const int n0 = (tl % tn) * 64, k0 = (tl / tn) * 64;
    const int n = n0 + (t & 63); const int ns = PERM ? proj_src_col(n) : (n < N ? n : -1); const int nsc = ns < 0 ? 0 : ns;
    const float* src = W + (size_t)(k0 + (t >> 6)) * N + nsc;
#pragma unroll
    for (int j = 0; j < 16; ++j) v[j] = src[(size_t)(4 * j) * N];
    if (GAIN) {
#pragma unroll
        for (int j = 0; j < 16; ++j) v[j] *= gain[k0 + (t >> 6) + 4 * j]; }
    const float m = ns < 0 ? 0.f : ((n >= slo && n < shi) ? sc : 1.f);
#pragma unroll
    for (int j = 0; j < 16; ++j) v[j] *= m;
}
template <bool GAIN, bool PERM> __device__ __forceinline__ void ph_wt(const Ctx& c, const float* __restrict__ W, int K, int N, int Npad, bf16* __restrict__ Bt, const float* __restrict__ gain, int slo, int shi, float sc, int b0 = 0) {
    if ((int)blockIdx.x < b0) return;
    const int half = c.tid >> 8, t = c.tid & 255;
    LAS float* tile = (LAS float*)((LAS unsigned char*)c.lds + half * 16640);
    const int tn = Npad / 64, ntile = tn * (K / 64), stride = ((int)gridDim.x - b0) * 2;
    int it = ((int)blockIdx.x - b0) * 2;
    float v[16];
    if (it < ntile) wt_load<GAIN, PERM>(v, it + half, tn, t, W, N, gain, slo, shi, sc);
    while (it < ntile) {
        const int tl = it + half; const int n0 = (tl % tn) * 64, k0 = (tl / tn) * 64;
#pragma unroll
        for (int j = 0; j < 16; ++j) tile[((t >> 6) + 4 * j) * 65 + (t & 63)] = v[j];
        it += stride;
        if (it < ntile) wt_load<GAIN, PERM>(v, it + half, tn, t, W, N, gain, slo, shi, sc);
        asm volatile("s_waitcnt lgkmcnt(0)\n\ts_barrier" ::: "memory");
#pragma unroll
        for (int p = 0; p < 2; ++p) { const int n = p * 32 + (t >> 3), ks = (t & 7) * 8; const LAS float* s = tile + ks * 65 + n;
            u32x4 o; o.x = f2bf(s[0]) | (f2bf(s[65]) << 16); o.y = f2bf(s[2 * 65]) | (f2bf(s[3 * 65]) << 16); o.z = f2bf(s[4 * 65]) | (f2bf(s[5 * 65]) << 16); o.w = f2bf(s[6 * 65]) | (f2bf(s[7 * 65]) << 16);
            *(u32x4*)(Bt + (size_t)(n0 + n) * K + k0 + ks) = o; }
        asm volatile("s_waitcnt lgkmcnt(0)\n\ts_barrier" ::: "memory");
    }
}
__device__ __forceinline__ void ph_x2bf(const Ctx& c, const float* __restrict__ x, bf16* __restrict__ xb, unsigned long long* __restrict__ ssq) {
    for (int row = c.gw; row < T; row += 4 * c.ngw) {
        f32x4 v[4][4]; float s[4];
#pragma unroll
        for (int k = 0; k < 4; ++k) { const f32x4* xr = (const f32x4*)(x + (size_t)(row + k * c.ngw) * DM) + c.lane;
#pragma unroll
            for (int j = 0; j < 4; ++j) v[k][j] = xr[64 * j]; }
#pragma unroll
        for (int k = 0; k < 4; ++k) { s[k] = 0.f;
#pragma unroll
            for (int j = 0; j < 4; ++j) s[k] += (v[k][j].x * v[k][j].x + v[k][j].y * v[k][j].y) + (v[k][j].z * v[k][j].z + v[k][j].w * v[k][j].w);
            s[k] = wave_sum(s[k]); if (c.lane < 5) ssq[(size_t)c.lane * 32768 + row + k * c.ngw] = c.lane == 0 ? pg8::ssq_fix(s[k]) : 0ull;
            unsigned long long* o8 = (unsigned long long*)(xb + (size_t)(row + k * c.ngw) * DM) + c.lane;
#pragma unroll
            for (int j = 0; j < 4; ++j) o8[64 * j] = (unsigned long long)(f2bf(v[k][j].x) | (f2bf(v[k][j].y) << 16)) | ((unsigned long long)(f2bf(v[k][j].z) | (f2bf(v[k][j].w) << 16)) << 32); }
    }
}
__device__ __forceinline__ void ph_final_norm(const Ctx& c, float* __restrict__ out, const float* __restrict__ g, const bf16* __restrict__ xb, const unsigned long long* __restrict__ ssq) {
    typedef unsigned u32x2_t __attribute__((ext_vector_type(2)));
    const f32x4* gr = (const f32x4*)g + c.lane; f32x4 gv[4];
#pragma unroll
    for (int j = 0; j < 4; ++j) gv[j] = gr[64 * j];
    for (int row = c.gw; row < T; row += 4 * c.ngw) {
        u32x2_t v[4][4]; unsigned long long q[4];
#pragma unroll
        for (int k = 0; k < 4; ++k) { const u32x2_t* xr = (const u32x2_t*)(xb + (size_t)(row + k * c.ngw) * DM) + c.lane;
#pragma unroll
            for (int j = 0; j < 4; ++j) v[k][j] = xr[64 * j];
            q[k] = ssq[row + k * c.ngw]; }
#pragma unroll
        for (int k = 0; k < 4; ++k) { const float rstd = rsqrtf(pg8::ssq_val(q[k]) * (1.f / DM) + 1e-6f);
            f32x4* xo = (f32x4*)(out + (size_t)(row + k * c.ngw) * DM) + c.lane;
#pragma unroll
            for (int j = 0; j < 4; ++j) { f32x4 t; t.x = __uint_as_float(v[k][j].x << 16); t.y = __uint_as_float(v[k][j].x & 0xffff0000u); t.z = __uint_as_float(v[k][j].y << 16); t.w = __uint_as_float(v[k][j].y & 0xffff0000u);
                xo[64 * j] = t * rstd * gv[j]; } }
    }
}
__device__ __forceinline__ void ph_attn_combine(const Ctx& c, const bf16* __restrict__ ot, bf16* __restrict__ mix, const float* lq1, const float* lk1, const float* lq2, const float* lk2,
                                                const float* __restrict__ norm_g, float lam_init) {
    const int lane = c.lane;
    const float lam = __expf(wave_sum(lq1[lane] * lk1[lane])) - __expf(wave_sum(lq2[lane] * lk2[lane])) + lam_init;
    for (int u0 = c.gw; u0 < T * 4; u0 += 4 * c.ngw) {
        unsigned a[4], b[4];
#pragma unroll
        for (int k = 0; k < 4; ++k) { const int u = u0 + k * c.ngw; const int h = u & 3, t = u >> 2;
            const unsigned* p0 = (const unsigned*)(ot + (size_t)t * 1024 + h * 256); a[k] = p0[lane]; b[k] = p0[64 + lane]; }
#pragma unroll
        for (int k = 0; k < 4; ++k) { const int u = u0 + k * c.ngw; const int h = u & 3, t = u >> 2;
            const float o0 = __uint_as_float(a[k] << 16) - lam * __uint_as_float(b[k] << 16), o1 = __uint_as_float(a[k] & 0xffff0000u) - lam * __uint_as_float(b[k] & 0xffff0000u);
            const float r = rsqrtf(wave_sum(o0 * o0 + o1 * o1) * (1.f / 128.f) + 1e-5f) * (1.f - lam_init);
            const float g0 = norm_g[h * 128 + 2 * lane], g1 = norm_g[h * 128 + 2 * lane + 1];
            ((unsigned*)(mix + (size_t)t * DM + 512 + h * 128))[lane] = f2bf(o0 * r * g0) | (f2bf(o1 * r * g1) << 16); }
    }
}
template <class Epi> __device__ __forceinline__ void ph_gemm(const Ctx& c, const bf16* A, const bf16* Bt, int N, int K, const Epi& E) {
    asm volatile("" : "+s"(N), "+s"(K));
    pg8::Gemm g{A, Bt, T, N, K, 0};
    pg8::StaticOrder S; S.init(T, N, (int)gridDim.x, (int)blockIdx.x);
    pg8::gemm_phase<Epi, pg8::StaticOrder, true, true>((PG8_LAS unsigned char*)c.lds, g, S, E);
}

#define GSYNC() xcd_barrier(xbar)
#define GSYNC_CG() do { asm volatile("s_waitcnt vmcnt(0)" ::: "memory"); grid.sync(); } while (0)
#define FRESH() asm volatile("" : "+s"(kp) :: "memory"); Ctx c; { int t_ = threadIdx.x; asm volatile("" : "+v"(t_)); c.tid = t_; c.lane = t_ & 63; c.wave = __builtin_amdgcn_readfirstlane(t_ >> 6); c.gw = blockIdx.x * 8 + c.wave; c.ngw = gridDim.x * 8; c.lds = lds; }
#define IN(i) ((const float*)(kp->in[i]))
#define WSP(off) ((unsigned char*)(kp->ws + (off)))
#define OUTP ((float*)(kp->out))
#define SSQ(i) ((unsigned long long*)WSP(WS_SSQ + (size_t)(i) * 262144))
#define XBp ((bf16*)WSP(WS_XB))
#define OTp ((bf16*)WSP(WS_XB))
#define MIXp ((bf16*)WSP(WS_MIX))
#define PROJp ((bf16*)WSP(WS_PROJ))
#define HIDp ((bf16*)WSP(WS_HID))
#define SCRp ((float*)WSP(WS_SCR))

template <int l> __device__ __forceinline__ void layer_body(const Params*& kp, unsigned char* lds, cg::grid_group& grid, const XcdBarrier& xbar) {
        const float lam_init = 0.8f - 0.6f * __expf(-0.3f * (float)l);
        { FRESH(); ph_gemm(c, XBp, (bf16*)WSP(WS_WIN) + (size_t)l * NP * DM, NP, DM, pg8::EpiBf16S<0>{PROJp, SSQ(2 * l), NP, 0}); }
        GSYNC();
        {
            { FRESH(); (void)c; rw::W w{IN(8) + l * 896, IN(9) + l * 256, IN(10) + l * 32 * 256, IN(11) + l * 256, IN(12) + l * 32 * 256, IN(13) + l * 64 * 256, IN(14) + l * 256, IN(15) + l * 256, IN(16) + l * 256, IN(17) + l * 256, IN(18) + l * 256};
              rw::Buf o{(bf16*)WSP(WS_RWG), (bf16*)WSP(WS_RWH), (bf16*)WSP(WS_RWRH), (bf16*)WSP(WS_RWYL), (bf16*)WSP(WS_GATE), (float*)WSP(WS_BON)};
              ml::P mp{IN(3) + l * 4 * 512, IN(4) + l * 512, IN(5) + l * 4, IN(6) + l * 4, IN(7) + l * 256}; ml::Buf mo{(bf16*)WSP(WS_MLC), (float*)WSP(WS_MLN), (float*)WSP(WS_MLS)};
              const bool hfix = ((int)gridDim.x & 255) == 0;
              rw::R1W wts; rw::r1_load_w(wts, ((int)blockIdx.x >> 6) & 3, w, mp);
              for (int unit = blockIdx.x; unit < 2048; unit += gridDim.x) { if (!hfix) rw::r1_load_w(wts, (unit >> 6) & 3, w, mp); rw::r1_unit((rw::lds_u8*)lds, unit, wts, PROJp, w, o, mp, mo); } }
            GSYNC();
            { FRESH(); rw::Buf o{(bf16*)WSP(WS_RWG), (bf16*)WSP(WS_RWH), (bf16*)WSP(WS_RWRH), (bf16*)WSP(WS_RWYL), (bf16*)WSP(WS_GATE), (float*)WSP(WS_BON)};
              if (blockIdx.x < 32 && c.wave < 4) rw::scan_bh((int)blockIdx.x, c.wave, c.lane, o);
              ml::Buf mo{(bf16*)WSP(WS_MLC), (float*)WSP(WS_MLN), (float*)WSP(WS_MLS)};
              if (blockIdx.x >= 32 && blockIdx.x < 64 && c.wave < 4) ml::scan_bh((int)blockIdx.x - 32, c.wave, c.lane, mo); }
            __syncthreads();
        { FRESH(); const float lam = __expf(wave_sum(IN(19)[l * 64 + c.lane] * IN(20)[l * 64 + c.lane])) - __expf(wave_sum(IN(21)[l * 64 + c.lane] * IN(22)[l * 64 + c.lane])) + lam_init;
          attn_body::attn_phase<8>((char*)lds, (const attn_body::bf16*)PROJp, (unsigned short*)MIXp, AQ, AK, AV, lam, 1.f - lam_init, IN(23) + l * 512, attn_body::StaticOrder((int)gridDim.x, (int)blockIdx.x)); }
            __syncthreads();
            {
                { FRESH(); ph_wt<false, false>(c, IN(24) + (size_t)l * DM * DM, DM, DM, DM, (bf16*)WSP(WS_WOUT) + (size_t)l * DM * DM, nullptr, 0, 0, 1.f); }
                { FRESH(); ph_wt<true, false>(c, IN(26) + (size_t)l * DM * FF, DM, FF, FF, (bf16*)WSP(WS_WUP) + (size_t)l * FF * DM, IN(25) + l * DM, 0, 0, 1.f); }
                { FRESH(); ph_wt<false, false>(c, IN(27) + (size_t)l * FF * DM, FF, DM, DM, (bf16*)WSP(WS_WDN) + (size_t)l * DM * FF, nullptr, 0, 0, 1.f); }
                if (l + 1 < DEPTH) { FRESH(); ph_wt<true, true>(c, IN(2) + (size_t)(l + 1) * DM * NREAL, DM, NREAL, NP, (bf16*)WSP(WS_WIN) + (size_t)(l + 1) * NP * DM, IN(1) + (l + 1) * DM, AQ, AK, C2); }
            }
            GSYNC();
            { FRESH(); (void)c; rw::W w{IN(8) + l * 896, IN(9) + l * 256, IN(10) + l * 32 * 256, IN(11) + l * 256, IN(12) + l * 32 * 256, IN(13) + l * 64 * 256, IN(14) + l * 256, IN(15) + l * 256, IN(16) + l * 256, IN(17) + l * 256, IN(18) + l * 256};
              rw::Buf ro{(bf16*)WSP(WS_RWG), (bf16*)WSP(WS_RWH), (bf16*)WSP(WS_RWRH), (bf16*)WSP(WS_RWYL), (bf16*)WSP(WS_GATE), (float*)WSP(WS_BON)};
              ml::P p{IN(3) + l * 4 * 512, IN(4) + l * 512, IN(5) + l * 4, IN(6) + l * 4, IN(7) + l * 256}; ml::Buf o{(bf16*)WSP(WS_MLC), (float*)WSP(WS_MLN), (float*)WSP(WS_MLS)};
              const bf16* projp = PROJp; bf16* mixp = MIXp;
              const rw::R3Ctx r3{projp, &w, &ro, mixp};
              for (int unit = blockIdx.x; unit < 2048; unit += gridDim.x) ml::m3_unit((rw::lds_u8*)lds, unit, projp, p, o, mixp, r3); }
        }
        GSYNC();
        { FRESH(); ph_gemm(c, MIXp, (bf16*)WSP(WS_WOUT) + (size_t)l * DM * DM, DM, DM, pg8::EpiResBf{XBp, SSQ(2 * l + 1), DM, 0}); }
        GSYNC();
        { FRESH(); ph_gemm(c, XBp, (bf16*)WSP(WS_WUP) + (size_t)l * FF * DM, FF, DM, pg8::EpiBf16S<2>{HIDp, SSQ(2 * l + 1), FF, 0}); }
        GSYNC();
        { FRESH(); ph_gemm(c, HIDp, (bf16*)WSP(WS_WDN) + (size_t)l * DM * FF, DM, FF, pg8::EpiResBf{XBp, SSQ(2 * l + 2), DM, 0}); }
        GSYNC();
}

constexpr int LDS_BYTES = 163840;
__global__ void __launch_bounds__(512, 2) mega(Params p) {
    extern __shared__ __attribute__((aligned(16))) unsigned char lds[];
    cg::grid_group grid = cg::this_grid();
    volatile LAS unsigned* xst = (volatile LAS unsigned*)((LAS unsigned char*)lds + 163776);
    if (threadIdx.x < 2) xst[threadIdx.x] = 0u;
    __syncthreads();
    XcdBarrier xbar = xcd_barrier_post((unsigned*)(((const Params*)__builtin_amdgcn_kernarg_segment_ptr())->ws + 16384), xst);
    const Params* kp = (const Params*)__builtin_amdgcn_kernarg_segment_ptr();
    { FRESH(); ph_wt<true, true>(c, IN(2), DM, NREAL, NP, (bf16*)WSP(WS_WIN), IN(1), AQ, AK, C2); }
    { FRESH(); ph_x2bf(c, IN(0), XBp, SSQ(0)); }
    GSYNC_CG();
    layer_body<0>(kp, lds, grid, xbar);
    layer_body<1>(kp, lds, grid, xbar);
    { FRESH(); ph_final_norm(c, OUTP, IN(28), XBp, SSQ(2 * DEPTH)); }
}

extern "C" void kernel_launch(void* const* d_in, const int* in_sizes, int n_in, void* d_out, int out_size, void* d_ws, size_t ws_size, hipStream_t stream) {
    static int grid_blocks = 0;
    if (grid_blocks == 0) {
        if (n_in != 29 || out_size != T * DM || ws_size < WS_END) { fprintf(stderr, "kernel_launch: unexpected shapes n_in %d out %d ws %zu\n", n_in, out_size, ws_size); grid_blocks = -1; return; }
        int dev = 0, cus = 0, per_cu = 0;
        (void)hipGetDevice(&dev); (void)hipDeviceGetAttribute(&cus, hipDeviceAttributeMultiprocessorCount, dev);
        (void)hipFuncSetAttribute((const void*)mega, hipFuncAttributeMaxDynamicSharedMemorySize, LDS_BYTES);
        (void)hipOccupancyMaxActiveBlocksPerMultiprocessor(&per_cu, (const void*)mega, 512, LDS_BYTES);
        fprintf(stderr, "kernel_launch: cus %d per_cu %d ws %zu\n", cus, per_cu, ws_size);
        grid_blocks = (per_cu >= 1) ? cus : -1;
    }
    if (grid_blocks < 0) return;
    if (hipMemsetAsync(d_ws, 0, 1u << 17, stream) != hipSuccess) { fprintf(stderr, "kernel_launch: memset of the control words failed\n"); return; }
    Params p{};
    for (int i = 0; i < 29; ++i) p.in[i] = (const GASQ float*)d_in[i];
    p.out = (GASQ float*)d_out; p.ws = (GASQ unsigned char*)d_ws;
    void* args[] = {&p};
    hipError_t e = hipLaunchCooperativeKernel((void*)mega, dim3(grid_blocks), dim3(512), args, LDS_BYTES, stream);
    if (e != hipSuccess) fprintf(stderr, "cooperative launch failed: %s (grid %d)\n", hipGetErrorString(e), grid_blocks);
}
```
